# Optimizing an MI355X kernel written in HIP

```python
import jax, jax.numpy as jnp
from jax import lax
import numpy as np

D_MODEL = 2048
BATCH = 1
SEQ = 8192
DEPTH = 4

HEAD_DIM = 128
ROPE_THETA = 10000.0
Q_CHUNK = 128
LN_EPS = 1e-5
RMS_EPS = 1e-6

MOBA_HEADS = 4
MOBA_BLOCK = 256
MOBA_TOPK = 3

MLA_HEADS = 4
MLA_Q_RANK = 512
MLA_KV_RANK = 512
MLA_NOPE = 128
MLA_ROPE = 64
MLA_V = 128

NSA_HEADS = 4
NSA_CMP_STRIDE = 16
NSA_CMP_LEN = 2 * NSA_CMP_STRIDE
NSA_SEL_BLOCK = 64
NSA_SEL_TOPK = 16
NSA_WINDOW = 512
NSA_BRANCH_KV = 6

DSA_HEADS = 4
DSA_IDX_HEADS = 16
DSA_IDX_DIM = 64
DSA_TOPK = 256

MEM_LEN = 256
MEM_HEADS = 4

D_FF = 5632
D_MIX = (MOBA_HEADS + MLA_HEADS + NSA_HEADS + DSA_HEADS) * HEAD_DIM
DN_ALPHA = (2 * DEPTH) ** 0.25
DN_BETA = (8 * DEPTH) ** -0.25

IN_SIZES = (
    MOBA_HEADS * HEAD_DIM, MOBA_HEADS * HEAD_DIM, MOBA_HEADS * HEAD_DIM,
    MLA_Q_RANK, MLA_KV_RANK, MLA_ROPE,
    NSA_HEADS * HEAD_DIM, NSA_BRANCH_KV * HEAD_DIM, 3 * NSA_HEADS,
    DSA_HEADS * HEAD_DIM, DSA_HEADS * HEAD_DIM, DSA_HEADS * HEAD_DIM,
    DSA_IDX_HEADS * DSA_IDX_DIM, DSA_IDX_DIM, DSA_IDX_HEADS,
)
D_IN = sum(IN_SIZES)

kernel_name = 'hybrid_parallel_sparse_attention_trunk'


def layer_norm(x, g, b):
    xf = x.astype(jnp.float32)
    mu = jnp.mean(xf, -1, keepdims=True)
    var = jnp.mean(jnp.square(xf - mu), -1, keepdims=True)
    return ((xf - mu) * lax.rsqrt(var + LN_EPS) * g + b).astype(x.dtype)


def rms_norm(x, g):
    xf = x.astype(jnp.float32)
    return (xf * lax.rsqrt(jnp.mean(xf * xf, -1, keepdims=True) + RMS_EPS) * g).astype(x.dtype)


def rope(x, pos):
    d = x.shape[-1]
    inv = ROPE_THETA ** (-jnp.arange(0, d, 2, dtype=jnp.float32) / d)
    ang = pos.astype(jnp.float32)[..., None] * inv
    cos, sin = jnp.cos(ang)[:, :, None, :], jnp.sin(ang)[:, :, None, :]
    x1, x2 = jnp.split(x.astype(jnp.float32), 2, axis=-1)
    return jnp.concatenate([x1 * cos - x2 * sin, x1 * sin + x2 * cos], -1).astype(x.dtype)


def masked_softmax(logits, mask):
    lf = jnp.where(mask, logits.astype(jnp.float32), -jnp.inf)
    m = jnp.max(lf, -1, keepdims=True)
    m = jnp.where(jnp.isfinite(m), m, 0.0)
    e = jnp.where(mask, jnp.exp(lf - m), 0.0)
    s = jnp.sum(e, -1, keepdims=True)
    return e / jnp.where(s > 0, s, 1.0)


def to_chunks(t):
    b, s = t.shape[:2]
    return jnp.moveaxis(t.reshape((b, s // Q_CHUNK, Q_CHUNK) + t.shape[2:]), 1, 0)


def from_chunks(t):
    t = jnp.moveaxis(t, 0, 1)
    return t.reshape((t.shape[0], -1) + t.shape[3:])


def swiglu(x, w_gu, w_down):
    g, u = jnp.split(x @ w_gu, 2, axis=-1)
    return (jax.nn.silu(g) * u) @ w_down


def moba_attention(q, k, v, pos):
    B, S, H, D = q.shape
    q, k = rope(q, pos), rope(k, pos)
    nb = -(-S // MOBA_BLOCK)
    pad = ((0, 0), (0, nb * MOBA_BLOCK - S), (0, 0), (0, 0))
    kb = jnp.pad(k, pad).reshape(B, nb, MOBA_BLOCK, H, D).transpose(0, 3, 1, 2, 4)
    vb = jnp.pad(v, pad).reshape(B, nb, MOBA_BLOCK, H, D).transpose(0, 3, 1, 2, 4)
    k_mean = jnp.mean(kb.astype(jnp.float32), axis=3)
    n_sel = min(MOBA_TOPK, nb - 1)
    scale = D ** -0.5
    b_ix = jnp.arange(B)[:, None, None, None]
    h_ix = jnp.arange(H)[None, :, None, None]

    def block(args):
        qc, c = args
        qc = qc.transpose(0, 2, 1, 3)
        qpos = c * Q_CHUNK + jnp.arange(Q_CHUNK)
        cur = qpos[0] // MOBA_BLOCK
        k_own = lax.dynamic_index_in_dim(kb, cur, axis=2, keepdims=False)
        v_own = lax.dynamic_index_in_dim(vb, cur, axis=2, keepdims=False)
        own_pos = cur * MOBA_BLOCK + jnp.arange(MOBA_BLOCK)
        logits = [jnp.einsum('bhqd,bhkd->bhqk', qc, k_own)]
        masks = [jnp.broadcast_to(own_pos[None, :] <= qpos[:, None], (B, H, Q_CHUNK, MOBA_BLOCK))]
        if n_sel > 0:
            gate = jnp.einsum('bhqd,bhnd->bhqn', qc.astype(jnp.float32), k_mean)
            gate = jnp.where(jnp.arange(nb) < cur, gate, -jnp.inf)
            _, idx = lax.top_k(gate, n_sel)
            k_sel = kb[b_ix, h_ix, idx]
            v_sel = vb[b_ix, h_ix, idx]
            logits.append(jnp.einsum('bhqd,bhqnkd->bhqnk', qc, k_sel).reshape(B, H, Q_CHUNK, n_sel * MOBA_BLOCK))
            sel_ok = jnp.broadcast_to((idx < cur)[..., None], idx.shape + (MOBA_BLOCK,))
            masks.append(sel_ok.reshape(B, H, Q_CHUNK, n_sel * MOBA_BLOCK))
        p = masked_softmax(jnp.concatenate(logits, -1) * scale, jnp.concatenate(masks, -1)).astype(v.dtype)
        out = jnp.einsum('bhqk,bhkd->bqhd', p[..., :MOBA_BLOCK], v_own)
        if n_sel > 0:
            p_sel = p[..., MOBA_BLOCK:].reshape(B, H, Q_CHUNK, n_sel, MOBA_BLOCK)
            out = out + jnp.einsum('bhqnk,bhqnkd->bqhd', p_sel, v_sel)
        return out

    out = lax.map(block, (to_chunks(q), jnp.arange(S // Q_CHUNK)))
    return from_chunks(out).reshape(B, S, H * D)


def mla_attention(c_q, c_kv, k_rope, g_cq, g_ckv, w_uq, w_ukv, pos):
    B, S, _ = c_q.shape
    q = (rms_norm(c_q, g_cq) @ w_uq).reshape(B, S, MLA_HEADS, MLA_NOPE + MLA_ROPE)
    q_nope, q_rope = q[..., :MLA_NOPE], rope(q[..., MLA_NOPE:], pos)
    kv = (rms_norm(c_kv, g_ckv) @ w_ukv).reshape(B, S, MLA_HEADS, MLA_NOPE + MLA_V)
    k_nope, v = kv[..., :MLA_NOPE], kv[..., MLA_NOPE:]
    k_r = rope(k_rope[:, :, None, :], pos)[:, :, 0]
    scale = (MLA_NOPE + MLA_ROPE) ** -0.5
    kpos = jnp.arange(S)

    def block(args):
        qn, qr, c = args
        qpos = c * Q_CHUNK + jnp.arange(Q_CHUNK)
        logits = (jnp.einsum('bqhd,bkhd->bhqk', qn, k_nope) + jnp.einsum('bqhd,bkd->bhqk', qr, k_r)) * scale
        p = masked_softmax(logits, kpos[None, :] <= qpos[:, None]).astype(v.dtype)
        return jnp.einsum('bhqk,bkhd->bqhd', p, v)

    out = lax.map(block, (to_chunks(q_nope), to_chunks(q_rope), jnp.arange(S // Q_CHUNK)))
    return from_chunks(out).reshape(B, S, MLA_HEADS * MLA_V)


def nsa_attention(q, kv, gate_logits, cmp_pe, cmp_w1, cmp_w2, pos):
    B, S, H, D = q.shape
    k_cmp, v_cmp, k_slc, v_slc, k_win, v_win = (kv[:, :, i] for i in range(NSA_BRANCH_KV))
    scale = D ** -0.5
    t_pos = jnp.arange(S)

    n_cmp = S // NSA_CMP_STRIDE - 1

    def compress(t, i):
        tw = t.reshape(B, S // NSA_CMP_STRIDE, NSA_CMP_STRIDE, D)
        blocks = jnp.concatenate([tw[:, :-1], tw[:, 1:]], axis=2) + cmp_pe[i]
        return jax.nn.gelu(blocks.reshape(B, n_cmp, NSA_CMP_LEN * D) @ cmp_w1[i]) @ cmp_w2[i]

    kc, vc = compress(k_cmp, 0), compress(v_cmp, 1)
    cmp_end = jnp.arange(n_cmp) * NSA_CMP_STRIDE + NSA_CMP_LEN - 1
    p_cmp = masked_softmax(jnp.einsum('bshd,bnd->bhsn', q, kc) * scale, cmp_end[None, :] <= t_pos[:, None])
    o_cmp = jnp.einsum('bhsn,bnd->bshd', p_cmp.astype(vc.dtype), vc)

    ratio = NSA_SEL_BLOCK // NSA_CMP_STRIDE
    lead = NSA_CMP_LEN // NSA_CMP_STRIDE - 1
    n_blk = S // NSA_SEL_BLOCK
    pp = jnp.pad(jnp.sum(p_cmp, axis=1), ((0, 0), (0, 0), (lead, ratio * n_blk - n_cmp)))
    imp = sum(pp[..., r:r + ratio * n_blk:ratio] for r in range(ratio + lead))
    blk = jnp.arange(n_blk)
    cur = (t_pos // NSA_SEL_BLOCK)[:, None]
    forced = (blk == 0) | (blk == cur) | (blk == cur - 1)
    imp = jnp.where(blk > cur, -jnp.inf, jnp.where(forced, jnp.inf, imp))
    k_top = min(NSA_SEL_TOPK, n_blk)
    _, sel_idx = lax.top_k(imp, k_top)
    sel_valid = sel_idx <= cur

    q_r = rope(q, pos)
    k_slc = rope(k_slc[:, :, None], pos)[:, :, 0]
    k_win = rope(k_win[:, :, None], pos)[:, :, 0]
    ksb = k_slc.reshape(B, n_blk, NSA_SEL_BLOCK, D)
    vsb = v_slc.reshape(B, n_blk, NSA_SEL_BLOCK, D)
    kwp = jnp.pad(k_win, ((0, 0), (NSA_WINDOW, 0), (0, 0)))
    vwp = jnp.pad(v_win, ((0, 0), (NSA_WINDOW, 0), (0, 0)))
    b_ix = jnp.arange(B)[:, None, None]

    def block(args):
        qc, idx, valid, c = args
        qpos = c * Q_CHUNK + jnp.arange(Q_CHUNK)
        k_sel = ksb[b_ix, idx].reshape(B, Q_CHUNK, k_top * NSA_SEL_BLOCK, D)
        v_sel = vsb[b_ix, idx].reshape(B, Q_CHUNK, k_top * NSA_SEL_BLOCK, D)
        kpos = (idx[..., None] * NSA_SEL_BLOCK + jnp.arange(NSA_SEL_BLOCK)).reshape(B, Q_CHUNK, -1)
        m_sel = (kpos <= qpos[None, :, None]) & jnp.repeat(valid, NSA_SEL_BLOCK, axis=-1)
        p = masked_softmax(jnp.einsum('bqhd,bqkd->bhqk', qc, k_sel) * scale, m_sel[:, None])
        o_slc = jnp.einsum('bhqk,bqkd->bqhd', p.astype(v_sel.dtype), v_sel)
        start = c * Q_CHUNK
        k_w = lax.dynamic_slice_in_dim(kwp, start, NSA_WINDOW + Q_CHUNK, axis=1)
        v_w = lax.dynamic_slice_in_dim(vwp, start, NSA_WINDOW + Q_CHUNK, axis=1)
        wpos = start - NSA_WINDOW + jnp.arange(NSA_WINDOW + Q_CHUNK)
        diff = qpos[:, None] - wpos[None, :]
        m_win = (wpos[None, :] >= 0) & (diff >= 0) & (diff < NSA_WINDOW)
        p = masked_softmax(jnp.einsum('bqhd,bkd->bhqk', qc, k_w) * scale, m_win)
        o_win = jnp.einsum('bhqk,bkd->bqhd', p.astype(v_w.dtype), v_w)
        return o_slc, o_win

    o_slc, o_win = lax.map(block, (to_chunks(q_r), to_chunks(sel_idx), to_chunks(sel_valid), jnp.arange(S // Q_CHUNK)))
    o_slc, o_win = from_chunks(o_slc), from_chunks(o_win)
    g = jax.nn.sigmoid(gate_logits.astype(jnp.float32)).reshape(B, S, H, 3).astype(q.dtype)
    out = g[..., 0:1] * o_cmp + g[..., 1:2] * o_slc + g[..., 2:3] * o_win
    return out.reshape(B, S, H * D)


def dsa_attention(q, k, v, iq, ik, iw, pos):
    B, S, H, D = q.shape
    q, k = rope(q, pos), rope(k, pos)
    iq = rope(iq.reshape(B, S, DSA_IDX_HEADS, DSA_IDX_DIM), pos)
    ik = rope(ik[:, :, None], pos)[:, :, 0]
    keep = min(DSA_TOPK, S // 4)
    scale = D ** -0.5
    b_ix = jnp.arange(B)[:, None, None]
    kpos = jnp.arange(S)

    def block(args):
        qc, iqc, wc, c = args
        qpos = c * Q_CHUNK + jnp.arange(Q_CHUNK)
        dots = jnp.einsum('bqhd,bkd->bqhk', iqc, ik).astype(jnp.float32) * (DSA_IDX_DIM ** -0.5)
        score = jnp.einsum('bqhk,bqh->bqk', jax.nn.relu(dots), wc.astype(jnp.float32) * (DSA_IDX_HEADS ** -0.5))
        score = jnp.where(kpos[None, :] <= qpos[:, None], score, -jnp.inf)
        _, idx = lax.top_k(score, keep)
        valid = idx <= qpos[None, :, None]
        k_sel = k[b_ix, idx]
        v_sel = v[b_ix, idx]
        p = masked_softmax(jnp.einsum('bqhd,bqkhd->bhqk', qc, k_sel) * scale, valid[:, None])
        return jnp.einsum('bhqk,bqkhd->bqhd', p.astype(v_sel.dtype), v_sel)

    out = lax.map(block, (to_chunks(q), to_chunks(iq), to_chunks(iw), jnp.arange(S // Q_CHUNK)))
    return from_chunks(out).reshape(B, S, H * D)


def hybrid_mixer(x, pos, w_in, w_out, g_cq, g_ckv, w_uq, w_ukv, cmp_pe, cmp_w1, cmp_w2):
    B, S, _ = x.shape
    h = x @ w_in
    splits = np.cumsum(IN_SIZES)[:-1].tolist()
    (a_q, a_k, a_v, b_cq, b_ckv, b_kr, c_q, c_kv, c_g,
     d_q, d_k, d_v, d_iq, d_ik, d_iw) = jnp.split(h, splits, axis=-1)
    heads = lambda t, n: t.reshape(B, S, n, -1)
    o_a = moba_attention(heads(a_q, MOBA_HEADS), heads(a_k, MOBA_HEADS), heads(a_v, MOBA_HEADS), pos)
    o_b = mla_attention(b_cq, b_ckv, b_kr, g_cq, g_ckv, w_uq, w_ukv, pos)
    o_c = nsa_attention(heads(c_q, NSA_HEADS), heads(c_kv, NSA_BRANCH_KV), c_g, cmp_pe, cmp_w1, cmp_w2, pos)
    o_d = dsa_attention(heads(d_q, DSA_HEADS), heads(d_k, DSA_HEADS), heads(d_v, DSA_HEADS), d_iq, d_ik, d_iw, pos)
    return jnp.concatenate([o_a, o_b, o_c, o_d], axis=-1) @ w_out


def memory_cross_attention(x, mem, wq, wkv, wo):
    B, S, _ = x.shape
    M = mem.shape[1]
    q = (x @ wq).reshape(B, S, MEM_HEADS, HEAD_DIM)
    k, v = jnp.split((mem @ wkv).reshape(B, M, 2 * MEM_HEADS, HEAD_DIM), 2, axis=2)
    logits = jnp.einsum('bshd,bmhd->bhsm', q, k) * (HEAD_DIM ** -0.5)
    p = jax.nn.softmax(logits.astype(jnp.float32), axis=-1).astype(v.dtype)
    return jnp.einsum('bhsm,bmhd->bshd', p, v).reshape(B, S, MEM_HEADS * HEAD_DIM) @ wo


def setup_inputs(seed: int = 0) -> dict:
    key = jax.random.key(seed)
    ks = jax.random.split(key, 20)

    def w(k, shape, fan_in, scale=1.0):
        return jax.random.normal(k, shape, jnp.float32) * (scale * fan_in ** -0.5)

    hd = HEAD_DIM
    return {
        'x': jax.random.normal(ks[0], (BATCH, SEQ, D_MODEL), jnp.float32),
        'mem': jax.random.normal(ks[1], (BATCH, MEM_LEN, D_MODEL), jnp.float32),
        'positions': jnp.broadcast_to(jnp.arange(SEQ, dtype=jnp.int32), (BATCH, SEQ)),
        'ln_g': 1.0 + 0.02 * jax.random.normal(ks[2], (DEPTH, 4, D_MODEL), jnp.float32),
        'ln_b': 0.02 * jax.random.normal(ks[3], (DEPTH, 4, D_MODEL), jnp.float32),
        'ffn_w_gu': w(ks[4], (DEPTH, 2, D_MODEL, 2 * D_FF), D_MODEL),
        'ffn_w_down': w(ks[5], (DEPTH, 2, D_FF, D_MODEL), D_FF, DN_BETA),
        'w_in': w(ks[6], (DEPTH, D_MODEL, D_IN), D_MODEL),
        'w_out': w(ks[7], (DEPTH, D_MIX, D_MODEL), D_MIX, DN_BETA),
        'mla_g_cq': 1.0 + 0.02 * jax.random.normal(ks[8], (DEPTH, MLA_Q_RANK), jnp.float32),
        'mla_g_ckv': 1.0 + 0.02 * jax.random.normal(ks[9], (DEPTH, MLA_KV_RANK), jnp.float32),
        'mla_w_uq': w(ks[10], (DEPTH, MLA_Q_RANK, MLA_HEADS * (MLA_NOPE + MLA_ROPE)), MLA_Q_RANK),
        'mla_w_ukv': w(ks[11], (DEPTH, MLA_KV_RANK, MLA_HEADS * (MLA_NOPE + MLA_V)), MLA_KV_RANK),
        'nsa_cmp_pe': 0.02 * jax.random.normal(ks[12], (DEPTH, 2, NSA_CMP_LEN, hd), jnp.float32),
        'nsa_cmp_w1': w(ks[13], (DEPTH, 2, NSA_CMP_LEN * hd, hd), NSA_CMP_LEN * hd),
        'nsa_cmp_w2': w(ks[14], (DEPTH, 2, hd, hd), hd),
        'mem_wq': w(ks[15], (DEPTH, D_MODEL, MEM_HEADS * hd), D_MODEL),
        'mem_wkv': w(ks[16], (DEPTH, D_MODEL, 2 * MEM_HEADS * hd), D_MODEL),
        'mem_wo': w(ks[17], (DEPTH, MEM_HEADS * hd, D_MODEL), MEM_HEADS * hd, DN_BETA),
    }


def reference(x, mem, positions, ln_g, ln_b, ffn_w_gu, ffn_w_down, w_in, w_out,
              mla_g_cq, mla_g_ckv, mla_w_uq, mla_w_ukv, nsa_cmp_pe, nsa_cmp_w1, nsa_cmp_w2,
              mem_wq, mem_wkv, mem_wo):
    for l in range(DEPTH):
        x = layer_norm(DN_ALPHA * x + 0.5 * swiglu(x, ffn_w_gu[l, 0], ffn_w_down[l, 0]), ln_g[l, 0], ln_b[l, 0])
        mix = hybrid_mixer(x, positions, w_in[l], w_out[l], mla_g_cq[l], mla_g_ckv[l], mla_w_uq[l], mla_w_ukv[l],
                           nsa_cmp_pe[l], nsa_cmp_w1[l], nsa_cmp_w2[l])
        x = layer_norm(DN_ALPHA * x + mix, ln_g[l, 1], ln_b[l, 1])
        x = layer_norm(DN_ALPHA * x + memory_cross_attention(x, mem, mem_wq[l], mem_wkv[l], mem_wo[l]), ln_g[l, 2], ln_b[l, 2])
        x = layer_norm(DN_ALPHA * x + 0.5 * swiglu(x, ffn_w_gu[l, 1], ffn_w_down[l, 1]), ln_g[l, 3], ln_b[l, 3])
    return x
```

```cpp
#include <hip/hip_runtime.h>
#include <cstdio>
#include <cstdint>

#ifndef MK_STEP_LAUNCHES
#define MK_STEP_LAUNCHES 0
#endif

#define GAS __attribute__((address_space(1)))
#define LAS __attribute__((address_space(3)))
typedef _Float16 h16;
typedef _Float16 half8 __attribute__((ext_vector_type(8)));
typedef _Float16 half4 __attribute__((ext_vector_type(4)));
typedef _Float16 half2v __attribute__((ext_vector_type(2)));
typedef float f32x4 __attribute__((ext_vector_type(4)));
typedef float f32x2 __attribute__((ext_vector_type(2)));
typedef unsigned u32x4 __attribute__((ext_vector_type(4)));
typedef unsigned long long u64;

constexpr int S = 8192, DM = 2048, DFF = 5632, DEPTH = 4, MEMLEN = 256;
constexpr int D_IN = 6556, NIN = 6656;
constexpr float LN_EPS = 1e-5f, RMS_EPS = 1e-6f;
constexpr float DN_ALPHA = 1.681792830507429f;
constexpr int NWAVES = 8, NTHREADS = 512;

constexpr size_t al256(size_t x) { return (x + 255) & ~(size_t)255; }
constexpr size_t WS_CTL = 0, CTL_BYTES = 1u << 20;
constexpr size_t WS_WGU  = CTL_BYTES;
constexpr size_t WS_WD   = WS_WGU  + (size_t)DEPTH * 2 * 2 * DFF * DM * 2;
constexpr size_t WS_WIN  = WS_WD   + (size_t)DEPTH * 2 * DM * DFF * 2;
constexpr size_t WS_WOUT = WS_WIN  + (size_t)DEPTH * NIN * DM * 2;
constexpr size_t WS_WUQ  = WS_WOUT + (size_t)DEPTH * DM * DM * 2;
constexpr size_t WS_WUKV = WS_WUQ  + (size_t)DEPTH * 768 * 512 * 2;
constexpr size_t WS_WC1  = WS_WUKV + (size_t)DEPTH * 1024 * 512 * 2;
constexpr size_t WS_WMQ  = WS_WC1  + (size_t)DEPTH * 2 * 256 * 2048 * 2;
constexpr size_t WS_WMKV = WS_WMQ  + (size_t)DEPTH * 512 * DM * 2;
constexpr size_t WS_WMO  = WS_WMKV + (size_t)DEPTH * 1024 * DM * 2;
constexpr size_t WS_XF   = WS_WMO  + (size_t)DEPTH * DM * 512 * 2;
constexpr size_t WS_XH   = WS_XF   + (size_t)S * DM * 4;
constexpr size_t WS_Z    = WS_XH   + (size_t)S * DM * 2;
constexpr size_t WS_HB   = WS_Z    + (size_t)S * DM * 4;
constexpr size_t WS_MEMH = WS_HB   + (size_t)S * DFF * 2;
constexpr size_t WS_MK   = WS_MEMH + (size_t)MEMLEN * DM * 2;
constexpr size_t WS_MV   = WS_MK   + (size_t)DEPTH * 4 * MEMLEN * 128 * 2;
constexpr size_t WS_T128C = WS_MV  + (size_t)DEPTH * 4 * MEMLEN * 128 * 2;
constexpr size_t WS_T128S = WS_T128C + (size_t)S * 64 * 4;
constexpr size_t WS_T64C  = WS_T128S + (size_t)S * 64 * 4;
constexpr size_t WS_T64S  = WS_T64C + (size_t)S * 32 * 4;
constexpr size_t HEADBUF = (size_t)S * 128 * 2;
constexpr size_t WS_AQ   = WS_T64S + (size_t)S * 32 * 4;
constexpr size_t WS_AK   = WS_AQ + 4 * HEADBUF;
constexpr size_t WS_AV   = WS_AK + 4 * HEADBUF;
constexpr size_t WS_BCQ  = WS_AV + 4 * HEADBUF;
constexpr size_t WS_BCKV = WS_BCQ + (size_t)S * 512 * 2;
constexpr size_t WS_BKR  = WS_BCKV + (size_t)S * 512 * 2;
constexpr size_t WS_Q192 = WS_BKR + (size_t)S * 64 * 2;
constexpr size_t WS_KN   = WS_Q192 + (size_t)4 * S * 192 * 2;
constexpr size_t WS_BV   = WS_KN + 4 * HEADBUF;
constexpr size_t WS_CQRAW = WS_BV + 4 * HEADBUF;
constexpr size_t WS_CQROPE = WS_CQRAW + 4 * HEADBUF;
constexpr size_t WS_KCMP = WS_CQROPE + 4 * HEADBUF;
constexpr size_t WS_VCMP = WS_KCMP + HEADBUF;
constexpr size_t WS_KSLC = WS_VCMP + HEADBUF;
constexpr size_t WS_VSLC = WS_KSLC + HEADBUF;
constexpr size_t WS_KWIN = WS_VSLC + HEADBUF;
constexpr size_t WS_VWIN = WS_KWIN + HEADBUF;
constexpr size_t WS_SMALL = WS_VWIN + HEADBUF;
constexpr size_t WS_DQ   = WS_SMALL + (size_t)S * 32 * 4;
constexpr size_t WS_DK   = WS_DQ + 4 * HEADBUF;
constexpr size_t WS_DV   = WS_DK + 4 * HEADBUF;
constexpr size_t WS_IQ   = WS_DV + 4 * HEADBUF;
constexpr size_t WS_IK   = WS_IQ + (size_t)S * 1024 * 2;
constexpr size_t WS_SSQQ = WS_IK + (size_t)S * 64 * 2;
constexpr size_t WS_SSQKV = WS_SSQQ + (size_t)S * 8 * 4;
constexpr size_t WS_YK   = WS_SSQKV + (size_t)S * 8 * 4;
constexpr size_t WS_YV   = WS_YK + (size_t)512 * 256 * 4;
constexpr size_t WS_KC   = WS_YV + (size_t)512 * 256 * 4;
constexpr size_t WS_VC   = WS_KC + (size_t)512 * 128 * 4;
constexpr size_t WS_CBIAS = WS_VC + (size_t)512 * 128 * 4;
constexpr size_t WS_KMEAN = WS_CBIAS + (size_t)DEPTH * 2 * 128 * 4;
constexpr size_t WS_MOBASEL = WS_KMEAN + (size_t)4 * 32 * 128 * 4;
constexpr size_t WS_OCMP = WS_MOBASEL + (size_t)S * 16 * 4;
constexpr size_t WS_NSASEL = WS_OCMP + (size_t)S * 512 * 4;
constexpr size_t WS_NSAMASK = WS_NSASEL + (size_t)S * 16 * 4;
constexpr size_t WS_DSALIST = WS_NSAMASK + (size_t)S * 4 * 4;
constexpr size_t WS_DSAMASK = WS_DSALIST + (size_t)S * 256 * 4;
constexpr size_t WS_OMIX = WS_DSAMASK + (size_t)S * 128 * 8;
constexpr size_t WS_MQ   = WS_OMIX + (size_t)S * DM * 2;
constexpr size_t WS_MO   = WS_MQ + 4 * HEADBUF;
constexpr size_t WS_LNG = WS_MO + (size_t)S * 512 * 2;
constexpr size_t WS_LNB = WS_LNG + (size_t)16 * DM * 4;
constexpr size_t WS_W2C = WS_LNB + (size_t)16 * DM * 4;
constexpr size_t WS_SCORES = al256(WS_W2C + (size_t)8 * 128 * 128 * 4);
constexpr size_t WS_END  = WS_SCORES + (size_t)S * S * 4;

constexpr int CW_TMO = 0, CW_CODE = 1, CW_BAR = 4096;

constexpr int RING_BYTES = 131072;
constexpr int LDSCTL_OFF = RING_BYTES, MISC_OFF = LDSCTL_OFF + 320;
constexpr int LDS_BYTES = 147456;

#define RLX_AGENT __ATOMIC_RELAXED, __HIP_MEMORY_SCOPE_AGENT
#define LDS_WAIT() asm volatile("s_waitcnt lgkmcnt(0)" ::: "memory")
#define VM_WAIT() asm volatile("s_waitcnt vmcnt(0)" ::: "memory")

__device__ const double ROPE_INV[64] = {
1.0, 0.8659643233600653, 0.7498942093324559, 0.6493816315762113,
0.5623413251903491, 0.4869675251658631, 0.4216965034285822, 0.3651741272548377,
0.31622776601683794, 0.27384196342643613, 0.23713737056616552, 0.2053525026457146,
0.1778279410038923, 0.1539926526059492, 0.1333521432163324, 0.11547819846894582,
0.1, 0.08659643233600653, 0.07498942093324558, 0.06493816315762113,
0.05623413251903491, 0.04869675251658631, 0.042169650342858224, 0.03651741272548377,
0.03162277660168379, 0.027384196342643614, 0.023713737056616554, 0.02053525026457146,
0.01778279410038923, 0.01539926526059492, 0.01333521432163324, 0.011547819846894581,
0.01, 0.008659643233600654, 0.007498942093324558, 0.006493816315762113,
0.005623413251903491, 0.004869675251658631, 0.004216965034285823, 0.003651741272548377,
0.0031622776601683794, 0.0027384196342643613, 0.0023713737056616554, 0.002053525026457146,
0.0017782794100389228, 0.001539926526059492, 0.001333521432163324, 0.0011547819846894581,
0.001, 0.0008659643233600654, 0.0007498942093324559, 0.0006493816315762113,
0.0005623413251903491, 0.0004869675251658631, 0.00042169650342858224, 0.0003651741272548377,
0.00031622776601683794, 0.0002738419634264361, 0.00023713737056616554, 0.0002053525026457146,
0.00017782794100389227, 0.0001539926526059492, 0.0001333521432163324, 0.00011547819846894582
};
namespace pg8 {
constexpr int BM = 256, BK = 64, HALF = 128, HTB = HALF * BK * 2, STAGE_BYTES = 8 * HTB, NXCD = 8, WGM = 8;
__host__ __device__ __forceinline__ int lds_byte(int r, int c) { const int st = (r >> 4) * 2 + (c >> 5), rr = r & 15, cc = c & 31, ob = rr * 64 + cc * 2; return st * 1024 + (ob ^ (((ob >> 9) & 1) << 5)); }
__host__ __device__ __forceinline__ void stage_rc(int b, int& R, int& C) { const int st = b / 1024, sb = b % 1024, swz = sb ^ (((sb >> 9) & 1) << 5); R = (st >> 1) * 16 + swz / 64; C = (st & 1) * 32 + (swz % 64) / 2; }
__host__ __device__ __forceinline__ int perm32(int rho) { const int n = rho >> 4, i = rho & 15; return 8 * (i >> 2) + 4 * n + (i & 3); }
struct Unit { int pm, pn; };
struct Gemm { const h16* A; const h16* Bt; int M, N, K; };
struct StaticOrder {
    int nM, nN, nwg, G, c;
    __host__ __device__ void init(int M, int N, int G_, int c_) { nM = M / BM; nN = N / BM; nwg = nM * nN; G = G_; c = c_; }
    __host__ __device__ bool next(int i, Unit& u) const {
        const long L = (long)i * G + c; if (L >= nwg) return false;
        int wgid = (int)L; { const int q = nwg / NXCD, r = nwg % NXCD, xcd = wgid % NXCD, off = wgid / NXCD; wgid = (xcd < r ? xcd * (q + 1) : r * (q + 1) + (xcd - r) * q) + off; }
        const int nig = WGM * nN, gid = wgid / nig, fm = gid * WGM, gsz = (nM - fm) < WGM ? (nM - fm) : WGM;
        u.pm = fm + ((wgid % nig) % gsz); u.pn = (wgid % nig) / gsz; return true;
    }
    __device__ __forceinline__ void a_ready(const Unit&) const {}
    __device__ __forceinline__ void done(const Unit&) const {}
};
template <class Epi, class Sched, bool ALIGN_EPI = false, bool SP2 = false>
__device__ __forceinline__ void gemm_phase(LAS unsigned char* lds, const Gemm g, const Sched& S, const Epi& E) {
    int tid_ = threadIdx.x; asm volatile("" : "+v"(tid_));
    const int tid = tid_, wid = __builtin_amdgcn_readfirstlane(tid >> 6), lane = tid & 63, wr = wid >> 2, wc = wid & 3, fr = lane & 15, fq = lane >> 4;
    const int K = g.K, nt = K / BK;
    unsigned voffA[2], voffB[2];
#pragma unroll
    for (int i = 0; i < 2; ++i) { int R, C; stage_rc(tid * 16 + i * 8192, R, C); const int Rb = Epi::PERM ? ((R & ~31) + perm32(R & 31)) : R;
        voffA[i] = (unsigned)(R * K + C) * 2u; voffB[i] = (unsigned)(Rb * K + C) * 2u; }
    const size_t kstep = (size_t)(BK * 2);
    const size_t hstep = (size_t)HALF * K * 2;
    const size_t tstep = 2 * hstep;
    const unsigned ldsw = (unsigned)wid * 1024u;
    const int aoff = lds_byte(wr * 64 + fr, fq * 8), boff = lds_byte(wc * 32 + fr, fq * 8);
#define PG8_SA(b, h) (((b) * 2 + (h)) * HTB)
#define PG8_SB(b, h) ((4 + (b) * 2 + (h)) * HTB)
#define PG8_STAGE(bufoff, gbase, voff) do { _Pragma("unroll") for (int _i = 0; _i < 2; ++_i) \
        __builtin_amdgcn_global_load_lds((const unsigned*)((const char*)(gbase) + (voff)[_i]), (LAS unsigned*)(lds + (bufoff) + ldsw + _i * 8192), 16, 0, 0); } while (0)
#define PG8_LDA(dst, b, h) do { _Pragma("unroll") for (int m = 0; m < 4; ++m) _Pragma("unroll") for (int k = 0; k < 2; ++k) dst[m][k] = *(const LAS half8*)(lds + PG8_SA(b, h) + aoff + m * 2048 + k * 1024); } while (0)
#define PG8_LDB(dst, b, h) do { _Pragma("unroll") for (int n = 0; n < 2; ++n) _Pragma("unroll") for (int k = 0; k < 2; ++k) dst[n][k] = *(const LAS half8*)(lds + PG8_SB(b, h) + boff + n * 2048 + k * 1024); } while (0)
#define PG8_MMA(ai, bj, At, Bt) do { __builtin_amdgcn_s_setprio(1); _Pragma("unroll") for (int m = 0; m < 4; ++m) _Pragma("unroll") for (int n = 0; n < 2; ++n) _Pragma("unroll") for (int k = 0; k < 2; ++k) \
        acc[ai][bj][m][n] = __builtin_amdgcn_mfma_f32_16x16x32_f16(Bt[n][k], At[m][k], acc[ai][bj][m][n], 0, 0, 0); __builtin_amdgcn_s_setprio(0); } while (0)
#define PG8_WAIT_V(n) asm volatile("s_waitcnt vmcnt(" #n ")" ::: "memory")
#define PG8_WAIT_L(n) asm volatile("s_waitcnt lgkmcnt(" #n ")" ::: "memory")
#define PG8_BAR __builtin_amdgcn_s_barrier()
#define PG8_SCHED __builtin_amdgcn_sched_barrier(0)
    Unit cur, nxt; int ui = 0;
    if (!S.next(0, cur)) return;
    f32x4 acc[2][2][4][2];
#pragma unroll
    for (int a = 0; a < 2; ++a)
#pragma unroll
        for (int b = 0; b < 2; ++b)
#pragma unroll
            for (int m = 0; m < 4; ++m)
#pragma unroll
                for (int n = 0; n < 2; ++n) acc[a][b][m][n] = (f32x4){0.f, 0.f, 0.f, 0.f};
    half8 At[4][2], B0[2][2], B1[2][2];
    const char* cA = (const char*)g.A + (size_t)cur.pm * tstep; const char* cB = (const char*)g.Bt + (size_t)cur.pn * tstep;
    S.a_ready(cur);
    if constexpr (SP2) {
        PG8_STAGE(PG8_SB(0, 0), cB, voffB); PG8_STAGE(PG8_SB(0, 1), cB + hstep, voffB); PG8_STAGE(PG8_SA(0, 0), cA, voffA); PG8_STAGE(PG8_SA(0, 1), cA + hstep, voffA);
        if (wr == 1) PG8_BAR;
        PG8_WAIT_V(2); PG8_BAR;
        PG8_STAGE(PG8_SB(1, 0), cB + kstep, voffB); PG8_STAGE(PG8_SA(1, 0), cA + kstep, voffA); PG8_STAGE(PG8_SB(1, 1), cB + hstep + kstep, voffB);
        PG8_WAIT_V(6); PG8_BAR;
    } else {
        PG8_STAGE(PG8_SB(0, 0), cB, voffB); PG8_STAGE(PG8_SA(0, 0), cA, voffA); PG8_STAGE(PG8_SB(0, 1), cB + hstep, voffB); PG8_STAGE(PG8_SA(0, 1), cA + hstep, voffA);
        if (wr == 1) PG8_BAR;
        PG8_WAIT_V(4); PG8_BAR;
        PG8_STAGE(PG8_SB(1, 0), cB + kstep, voffB); PG8_STAGE(PG8_SA(1, 0), cA + kstep, voffA); PG8_STAGE(PG8_SB(1, 1), cB + hstep + kstep, voffB);
        PG8_WAIT_V(6); PG8_BAR;
    }
    for (;;) {
        const bool has_next = S.next(ui + 1, nxt);
        const char* nA = has_next ? (const char*)g.A + (size_t)nxt.pm * tstep : cA; const char* nB = has_next ? (const char*)g.Bt + (size_t)nxt.pn * tstep : cB;
        for (int t = 0; t < nt; t += 2) {
            const bool last = (t == nt - 2);
            const char* a1 = cA + (size_t)(t + 1) * kstep;
            const char* a2 = last ? nA : cA + (size_t)(t + 2) * kstep; const char* b2 = last ? nB : cB + (size_t)(t + 2) * kstep;
            const char* a3 = a2 + kstep; const char* b3 = b2 + kstep;
            if (last && has_next) S.a_ready(nxt);
            if constexpr (SP2) {
            PG8_LDB(B0, 0, 0); PG8_LDB(B1, 0, 1); PG8_SCHED; PG8_LDA(At, 0, 0); PG8_STAGE(PG8_SA(1, 1), a1 + hstep, voffA);
            PG8_WAIT_V(8); PG8_WAIT_L(0); PG8_BAR; PG8_MMA(0, 0, At, B0); PG8_MMA(0, 1, At, B1); PG8_BAR; PG8_SCHED;
            PG8_LDA(At, 0, 1); PG8_STAGE(PG8_SB(0, 0), b2, voffB); PG8_STAGE(PG8_SB(0, 1), b2 + hstep, voffB); PG8_STAGE(PG8_SA(0, 0), a2, voffA);
            PG8_WAIT_V(8); PG8_WAIT_L(0); PG8_BAR; PG8_MMA(1, 0, At, B0); PG8_MMA(1, 1, At, B1); PG8_BAR; PG8_SCHED;
            PG8_LDB(B0, 1, 0); PG8_LDB(B1, 1, 1); PG8_SCHED; PG8_LDA(At, 1, 0); PG8_STAGE(PG8_SA(0, 1), a2 + hstep, voffA);
            PG8_WAIT_V(8); PG8_WAIT_L(0); PG8_BAR; PG8_MMA(0, 0, At, B0); PG8_MMA(0, 1, At, B1); PG8_BAR; PG8_SCHED;
            PG8_LDA(At, 1, 1); PG8_STAGE(PG8_SB(1, 0), b3, voffB); PG8_STAGE(PG8_SB(1, 1), b3 + hstep, voffB); PG8_STAGE(PG8_SA(1, 0), a3, voffA);
            PG8_WAIT_V(8); PG8_WAIT_L(0); PG8_BAR; PG8_MMA(1, 0, At, B0); PG8_MMA(1, 1, At, B1); PG8_BAR; PG8_SCHED;
            } else {
            PG8_LDB(B0, 0, 0); PG8_SCHED; PG8_LDA(At, 0, 0); PG8_STAGE(PG8_SA(1, 1), a1 + hstep, voffA);
            PG8_WAIT_L(8); PG8_BAR; PG8_WAIT_L(0); PG8_MMA(0, 0, At, B0); PG8_BAR; PG8_SCHED;
            PG8_LDB(B1, 0, 1); PG8_STAGE(PG8_SB(0, 0), b2, voffB);
            PG8_BAR; PG8_WAIT_L(0); PG8_MMA(0, 1, At, B1); PG8_BAR;
            PG8_LDA(At, 0, 1); PG8_STAGE(PG8_SA(0, 0), a2, voffA);
            PG8_BAR; PG8_WAIT_L(0); PG8_MMA(1, 0, At, B0); PG8_BAR; PG8_SCHED;
            PG8_STAGE(PG8_SB(0, 1), b2 + hstep, voffB);
            PG8_WAIT_V(6); PG8_BAR; PG8_MMA(1, 1, At, B1); PG8_BAR;
            PG8_LDB(B0, 1, 0); PG8_SCHED; PG8_LDA(At, 1, 0); PG8_STAGE(PG8_SA(0, 1), a2 + hstep, voffA);
            PG8_WAIT_L(8); PG8_BAR; PG8_WAIT_L(0); PG8_MMA(0, 0, At, B0); PG8_BAR; PG8_SCHED;
            PG8_LDB(B1, 1, 1); PG8_STAGE(PG8_SB(1, 0), b3, voffB);
            PG8_BAR; PG8_WAIT_L(0); PG8_MMA(0, 1, At, B1); PG8_BAR;
            PG8_LDA(At, 1, 1); PG8_STAGE(PG8_SA(1, 0), a3, voffA);
            PG8_BAR; PG8_WAIT_L(0); PG8_MMA(1, 0, At, B0); PG8_BAR; PG8_SCHED;
            PG8_STAGE(PG8_SB(1, 1), b3 + hstep, voffB);
            PG8_WAIT_V(6); PG8_BAR; PG8_MMA(1, 1, At, B1); PG8_BAR;
            }
        }
        if constexpr (ALIGN_EPI) { if (wr == 0) PG8_BAR; }
        if constexpr (!Epi::AFTER_DRAIN) { E(acc, cur, wr, wc, fr, fq); S.done(cur); }
        if (!has_next) break;
#pragma unroll
        for (int a = 0; a < 2; ++a)
#pragma unroll
            for (int b = 0; b < 2; ++b)
#pragma unroll
                for (int m = 0; m < 4; ++m)
#pragma unroll
                    for (int n = 0; n < 2; ++n) acc[a][b][m][n] = (f32x4){0.f, 0.f, 0.f, 0.f};
        cur = nxt; cA = nA; cB = nB; ++ui;
        if constexpr (ALIGN_EPI) { if (wr == 1) PG8_BAR; }
    }
    PG8_WAIT_V(0);
    if constexpr (!ALIGN_EPI) { if (wr == 0) PG8_BAR; }
    PG8_BAR;
    if constexpr (Epi::AFTER_DRAIN) { E.fused(acc, cur, wr, wc, fr, fq, lds, wid, lane); S.done(cur); }
#undef PG8_SA
#undef PG8_SB
#undef PG8_STAGE
#undef PG8_LDA
#undef PG8_LDB
#undef PG8_MMA
#undef PG8_WAIT_V
#undef PG8_WAIT_L
#undef PG8_BAR
#undef PG8_SCHED
}
}
#define XB_TMO      128
#define XB_XCNT(j)  (256  + 64 * (j))
#define XB_XSUB(j)  (1280 + 64 * (j))
#define XB_XGEN(j)  (2304 + 64 * (j))
#define XB_TOP      3328
#define XB_TOPGEN   3392
#define XCD_BAR_WORDS 3456
#define XB_SPIN_CAP (1u << 18)

__device__ __forceinline__ unsigned xb_ld(unsigned* p)              { return __hip_atomic_load(p, __ATOMIC_RELAXED, __HIP_MEMORY_SCOPE_AGENT); }
__device__ __forceinline__ unsigned xb_add(unsigned* p, unsigned v) { return __hip_atomic_fetch_add(p, v, __ATOMIC_RELAXED, __HIP_MEMORY_SCOPE_AGENT); }
__device__ __forceinline__ unsigned xb_xcc_id() { return (unsigned)__builtin_amdgcn_s_getreg((3 << 11) | 20) & 0xFu; }
#define XB_SPIN(cond, bar) do { unsigned _sp = 0; while (cond) { __builtin_amdgcn_s_sleep(1); \
    if ((++_sp & 255u) == 0u) { if (xb_ld(&(bar)[XB_TMO])) break; if (_sp > XB_SPIN_CAP) { atomicAdd(&(bar)[XB_TMO], 1u); break; } } } } while (0)

struct XcdBarrier {
    unsigned* bar; unsigned x;
    volatile LAS unsigned* st;
};

__device__ __forceinline__ XcdBarrier xcd_barrier_post(unsigned* bar, volatile LAS unsigned* st) {
    XcdBarrier b; b.bar = bar; b.x = xb_xcc_id(); b.st = st;
    if (threadIdx.x == 0) (void)xb_add(&bar[XB_XCNT(b.x)], 1u);
    return b;
}
__device__ __forceinline__ void xcd_barrier_complete(unsigned* bar, unsigned x, unsigned& nloc, unsigned& nx) {
    const unsigned G = gridDim.x * gridDim.y * gridDim.z;
    unsigned sum, cnt, mine, sp = 0u;
    for (;;) {
        sum = 0u; cnt = 0u; mine = 0u;
#pragma unroll
        for (unsigned j = 0; j < 16; ++j) { const unsigned c = xb_ld(&bar[XB_XCNT(j)]); sum += c; cnt += (c > 0u) ? 1u : 0u; mine = (j == x) ? c : mine; }
        if (sum == G) break;
        __builtin_amdgcn_s_sleep(1);
        if ((++sp & 255u) == 0u) { if (xb_ld(&bar[XB_TMO])) break; if (sp > XB_SPIN_CAP) { atomicAdd(&bar[XB_TMO], 1u); break; } }
    }
    nloc = mine > 0u ? mine : 1u; nx = cnt > 0u ? cnt : 1u;
}

__device__ __forceinline__ void xcd_barrier(const XcdBarrier& b) {
    asm volatile("s_waitcnt vmcnt(0)" ::: "memory");
    __syncthreads();
    if (threadIdx.x == 0) {
        unsigned* bar = b.bar;
        __builtin_amdgcn_s_waitcnt(0);
        unsigned nloc = b.st[0], nx = b.st[1];
        if (nloc == 0u) { xcd_barrier_complete(bar, b.x, nloc, nx); b.st[0] = nloc; b.st[1] = nx; }
        const unsigned old = xb_add(&bar[XB_XSUB(b.x)], 1u);
        const unsigned gen = old / nloc;
        if (old + 1u == (gen + 1u) * nloc) {
            __builtin_amdgcn_fence(__ATOMIC_RELEASE, "agent");
            asm volatile("s_waitcnt vmcnt(0)" ::: "memory");
            const unsigned og = xb_add(&bar[XB_TOP], 1u);
            const unsigned tg = og / nx;
            if (og + 1u == (tg + 1u) * nx) xb_add(&bar[XB_TOPGEN], 1u);
            else XB_SPIN(xb_ld(&bar[XB_TOPGEN]) == tg, bar);
            __builtin_amdgcn_fence(__ATOMIC_ACQUIRE, "agent");
            xb_add(&bar[XB_XGEN(b.x)], 1u);
            asm volatile("s_waitcnt vmcnt(0)" ::: "memory");
        } else {
            XB_SPIN(xb_ld(&bar[XB_XGEN(b.x)]) == gen, bar);
            __builtin_amdgcn_fence(__ATOMIC_ACQUIRE, "agent");
            asm volatile("s_waitcnt vmcnt(0)" ::: "memory");
        }
    }
    __syncthreads();
}
struct Frame {
    LAS unsigned char* lds;
    volatile LAS unsigned* MISC;
    unsigned* ctl;
    unsigned char* ws;
    int tid, lane, wave;
    int G;
    const float* in[19];
    float* out;
};
enum { IN_X = 0, IN_MEM, IN_POS, IN_LNG, IN_LNB, IN_WGU, IN_WD, IN_WIN, IN_WOUT, IN_GCQ, IN_GCKV, IN_WUQ, IN_WUKV, IN_PE, IN_W1, IN_W2, IN_MWQ, IN_MWKV, IN_MWO };

__device__ __forceinline__ float wave_sum(float v) {
#pragma unroll
    for (int o = 1; o < 64; o <<= 1) v += __shfl_xor(v, o);
    return v;
}
__device__ __forceinline__ float wave_max(float v) {
#pragma unroll
    for (int o = 1; o < 64; o <<= 1) v = fmaxf(v, __shfl_xor(v, o));
    return v;
}
__device__ __forceinline__ half8 pack_h8(f32x4 a, f32x4 b) {
    half8 r; r[0] = (h16)a[0]; r[1] = (h16)a[1]; r[2] = (h16)a[2]; r[3] = (h16)a[3]; r[4] = (h16)b[0]; r[5] = (h16)b[1]; r[6] = (h16)b[2]; r[7] = (h16)b[3]; return r;
}

struct EpiSwiglu {
    static constexpr bool PERM = true, AFTER_DRAIN = false;
    h16* H;
    __device__ __forceinline__ void operator()(const f32x4 (&acc)[2][2][4][2], const pg8::Unit& u, int wr, int wc, int fr, int fq) const {
        const int row0 = u.pm * 256 + wr * 64 + fr, col0 = u.pn * 128 + wc * 32 + 8 * fq;
#pragma unroll
        for (int ai = 0; ai < 2; ++ai)
#pragma unroll
            for (int m = 0; m < 4; ++m) {
                f32x4 o[2];
#pragma unroll
                for (int n = 0; n < 2; ++n)
#pragma unroll
                    for (int j = 0; j < 4; ++j) { const float g = acc[ai][0][m][n][j], uu = acc[ai][1][m][n][j]; o[n][j] = g * __builtin_amdgcn_rcpf(1.0f + __expf(-g)) * uu; }
                *(half8*)(H + (size_t)(row0 + ai * 128 + m * 16) * DFF + col0) = pack_h8(o[0], o[1]);
            }
    }
};
struct EpiResid {
    static constexpr bool PERM = false, AFTER_DRAIN = false;
    const float* xf; float* z; float s;
    __device__ __forceinline__ void operator()(const f32x4 (&acc)[2][2][4][2], const pg8::Unit& u, int wr, int wc, int fr, int fq) const {
        const int row0 = u.pm * 256 + wr * 64 + fr, col0 = u.pn * 256 + wc * 32 + 4 * fq;
#pragma unroll
        for (int ai = 0; ai < 2; ++ai)
#pragma unroll
            for (int m = 0; m < 4; ++m) { const size_t off = (size_t)(row0 + ai * 128 + m * 16) * DM + col0;
#pragma unroll
                for (int bj = 0; bj < 2; ++bj)
#pragma unroll
                    for (int n = 0; n < 2; ++n) { const f32x4 xv = *(const f32x4*)(xf + off + bj * 128 + n * 16); *(f32x4*)(z + off + bj * 128 + n * 16) = xv * DN_ALPHA + acc[ai][bj][m][n] * s; } }
    }
};

enum { JOB_WIN = 0, JOB_UQ, JOB_UKV, JOB_Y, JOB_MQ, JOB_MKV };
struct WaveDst { h16* p0; h16* p1; int ld; int colA, colB; int rope; h16* raw; float* f32p; float* ssq; int ssq_part; bool none; };
template <int JOB> __device__ __forceinline__ WaveDst proj_dst(unsigned char* ws, int t, int wc, int fq, int aux) {
    WaveDst d; d.p0 = nullptr; d.p1 = nullptr; d.ld = 128; d.rope = 0; d.raw = nullptr; d.f32p = nullptr; d.ssq = nullptr; d.ssq_part = 0; d.none = false;
    const int cp = wc * 32 + 8 * fq;
    d.colA = cp & 63; d.colB = cp & 63;
    const int hs = wc >> 1;
    if constexpr (JOB == JOB_WIN) {
        if (t < 11) {
            d.rope = 1; d.colB = d.colA + 64;
            size_t base;
            if (t < 2) base = WS_AQ + (size_t)(2 * t + hs) * HEADBUF;
            else if (t < 4) base = WS_AK + (size_t)(2 * (t - 2) + hs) * HEADBUF;
            else if (t < 6) { base = WS_CQROPE + (size_t)(2 * (t - 4) + hs) * HEADBUF; d.raw = (h16*)(ws + WS_CQRAW + (size_t)(2 * (t - 4) + hs) * HEADBUF); }
            else if (t == 6) base = hs ? WS_KWIN : WS_KSLC;
            else if (t < 9) base = WS_DQ + (size_t)(2 * (t - 7) + hs) * HEADBUF;
            else base = WS_DK + (size_t)(2 * (t - 9) + hs) * HEADBUF;
            d.p0 = d.p1 = (h16*)(ws + base);
        } else if (t < 15) {
            d.rope = 2; d.colA = cp & 31; d.colB = d.colA + 32; d.ld = 1024;
            d.p0 = d.p1 = (h16*)(ws + WS_IQ) + (4 * (t - 11) + wc) * 64;
        } else if (t == 15) {
            d.colA = cp & 31; d.colB = d.colA + 32; d.ld = 64;
            if (wc == 0) { d.rope = 2; d.p0 = d.p1 = (h16*)(ws + WS_BKR); }
            else if (wc == 1) { d.rope = 2; d.p0 = d.p1 = (h16*)(ws + WS_IK); }
            else if (wc == 2) { d.f32p = (float*)(ws + WS_SMALL); d.ld = 32; }
            else d.none = true;
        } else {
            if (t < 18) { const int h0 = 2 * (t - 16); d.p0 = (h16*)(ws + WS_AV + (size_t)h0 * HEADBUF) + 64 * hs; d.p1 = (h16*)(ws + WS_AV + (size_t)(h0 + 1) * HEADBUF) + 64 * hs; }
            else if (t < 20) { d.ld = 512; d.p0 = (h16*)(ws + WS_BCQ) + 256 * (t - 18) + 64 * hs; d.p1 = d.p0 + 128; d.ssq = (float*)(ws + WS_SSQQ); d.ssq_part = (t - 18) * 4 + wc; }
            else if (t < 22) { d.ld = 512; d.p0 = (h16*)(ws + WS_BCKV) + 256 * (t - 20) + 64 * hs; d.p1 = d.p0 + 128; d.ssq = (float*)(ws + WS_SSQKV); d.ssq_part = (t - 20) * 4 + wc; }
            else if (t == 22) { d.p0 = (h16*)(ws + WS_KCMP) + 64 * hs; d.p1 = (h16*)(ws + WS_VCMP) + 64 * hs; }
            else if (t == 23) { d.p0 = (h16*)(ws + WS_VSLC) + 64 * hs; d.p1 = (h16*)(ws + WS_VWIN) + 64 * hs; }
            else { const int h0 = 2 * (t - 24); d.p0 = (h16*)(ws + WS_DV + (size_t)h0 * HEADBUF) + 64 * hs; d.p1 = (h16*)(ws + WS_DV + (size_t)(h0 + 1) * HEADBUF) + 64 * hs; }
        }
    } else if constexpr (JOB == JOB_UQ) {
        d.ld = 192;
        if (t < 2) { d.p0 = (h16*)(ws + WS_Q192) + (size_t)(2 * t) * S * 192 + 64 * hs; d.p1 = (h16*)(ws + WS_Q192) + (size_t)(2 * t + 1) * S * 192 + 64 * hs; }
        else { d.rope = 2; d.colA = cp & 31; d.colB = d.colA + 32; d.p0 = d.p1 = (h16*)(ws + WS_Q192) + (size_t)wc * S * 192 + 128; }
        d.ssq = (float*)(ws + WS_SSQQ);
    } else if constexpr (JOB == JOB_UKV) {
        d.p0 = (h16*)(ws + WS_KN + (size_t)t * HEADBUF) + 64 * hs; d.p1 = (h16*)(ws + WS_BV + (size_t)t * HEADBUF) + 64 * hs;
        d.ssq = (float*)(ws + WS_SSQKV);
    } else if constexpr (JOB == JOB_Y) {
        d.f32p = (float*)(ws + (aux ? WS_YV : WS_YK)); d.ld = 256;
    } else if constexpr (JOB == JOB_MQ) {
        d.p0 = (h16*)(ws + WS_MQ + (size_t)(2 * t) * HEADBUF) + 64 * hs; d.p1 = (h16*)(ws + WS_MQ + (size_t)(2 * t + 1) * HEADBUF) + 64 * hs;
    } else {
        const int layer = t >> 2, tt = t & 3, h0 = 2 * (tt & 1);
        const size_t kb = (tt >> 1) ? WS_MV : WS_MK;
        d.p0 = (h16*)(ws + kb) + (size_t)((layer * 4 + h0) * MEMLEN) * 128 + 64 * hs; d.p1 = (h16*)(ws + kb) + (size_t)((layer * 4 + h0 + 1) * MEMLEN) * 128 + 64 * hs;
    }
    return d;
}
template <int JOB> struct EpiProj {
    static constexpr bool PERM = true, AFTER_DRAIN = false;
    unsigned char* ws; int aux;
    __device__ __forceinline__ void operator()(const f32x4 (&acc)[2][2][4][2], const pg8::Unit& u, int wr, int wc, int fr, int fq) const {
        const WaveDst d = proj_dst<JOB>(ws, u.pn, wc, fq, aux);
        if (d.none) return;
        const int row0 = u.pm * 256 + wr * 64 + fr;
        const float* tc = (const float*)(ws + (d.rope == 1 ? WS_T128C : WS_T64C)); const float* ts = (const float*)(ws + (d.rope == 1 ? WS_T128S : WS_T64S));
        const int tw = d.rope == 1 ? 64 : 32;
#pragma unroll
        for (int ai = 0; ai < 2; ++ai)
#pragma unroll
            for (int m = 0; m < 4; ++m) {
                const int row = row0 + ai * 128 + m * 16;
                f32x4 a0 = acc[ai][0][m][0], a1 = acc[ai][0][m][1], b0 = acc[ai][1][m][0], b1 = acc[ai][1][m][1];
                if constexpr (JOB == JOB_UQ || JOB == JOB_UKV) {
                    const f32x4 s0 = *(const f32x4*)(d.ssq + (size_t)row * 8), s1 = *(const f32x4*)(d.ssq + (size_t)row * 8 + 4);
                    const float ss = ((s0[0] + s0[1]) + (s0[2] + s0[3])) + ((s1[0] + s1[1]) + (s1[2] + s1[3]));
                    const float rs = 1.0f / sqrtf(ss * (1.0f / 512.0f) + RMS_EPS);
                    a0 = a0 * rs; a1 = a1 * rs; b0 = b0 * rs; b1 = b1 * rs;
                }
                if constexpr (JOB == JOB_WIN) {
                    if (d.ssq) {
                        float q = 0.f;
#pragma unroll
                        for (int j = 0; j < 4; ++j) q += a0[j] * a0[j] + a1[j] * a1[j] + b0[j] * b0[j] + b1[j] * b1[j];
                        q += __shfl_xor(q, 16); q += __shfl_xor(q, 32);
                        if (fq == 0) d.ssq[(size_t)row * 8 + d.ssq_part] = q;
                    }
                    if (d.raw) { *(half8*)(d.raw + (size_t)row * 128 + d.colA) = pack_h8(a0, a1); *(half8*)(d.raw + (size_t)row * 128 + d.colB) = pack_h8(b0, b1); }
                }
                if (d.f32p) {
                    if constexpr (JOB == JOB_Y) { float* p = d.f32p + (size_t)row * 256 + wc * 32 + 8 * fq; *(f32x4*)p = a0; *(f32x4*)(p + 4) = a1; *(f32x4*)(p + 128) = b0; *(f32x4*)(p + 132) = b1; }
                    else { float* p = d.f32p + (size_t)row * 32 + d.colA; *(f32x4*)p = a0; *(f32x4*)(p + 4) = a1; }
                    continue;
                }
                if (d.rope) {
                    const size_t ti = (size_t)row * tw + d.colA;
                    const f32x4 c0 = *(const f32x4*)(tc + ti), c1 = *(const f32x4*)(tc + ti + 4), s0 = *(const f32x4*)(ts + ti), s1 = *(const f32x4*)(ts + ti + 4);
                    const f32x4 o0 = a0 * c0 - b0 * s0, o1 = a1 * c1 - b1 * s1, q0 = a0 * s0 + b0 * c0, q1 = a1 * s1 + b1 * c1;
                    a0 = o0; a1 = o1; b0 = q0; b1 = q1;
                }
                *(half8*)(d.p0 + (size_t)row * d.ld + d.colA) = pack_h8(a0, a1);
                *(half8*)(d.p1 + (size_t)row * d.ld + d.colB) = pack_h8(b0, b1);
            }
    }
};
__device__ __forceinline__ int win_map(int np) {
    const int t = np >> 8, c = np & 255;
    if (t < 11) {
        const int slot = (c >> 6) & 1, d = (c & 63) + 64 * (c >> 7);
        int base;
        if (t < 2) base = 0 + 256 * t + 128 * slot;
        else if (t < 4) base = 512 + 256 * (t - 2) + 128 * slot;
        else if (t < 6) base = 2624 + 256 * (t - 4) + 128 * slot;
        else if (t == 6) base = slot ? 3648 : 3392;
        else if (t < 9) base = 3916 + 256 * (t - 7) + 128 * slot;
        else base = 4428 + 256 * (t - 9) + 128 * slot;
        return base + d;
    }
    if (t < 15) { const int head = (c >> 5) & 3, d = (c & 31) + 32 * (c >> 7); return 5452 + 64 * (4 * (t - 11) + head) + d; }
    if (t == 15) {
        const int head = (c >> 5) & 3, half = c >> 7, d = (c & 31) + 32 * half;
        if (head == 0) return 2560 + d;
        if (head == 1) return 6476 + d;
        if (head == 2) { if (half) return -1; if (d < 12) return 3904 + d; if (d < 28) return 6540 + (d - 12); return -1; }
        return -1;
    }
    if (t < 18) return 1024 + 256 * (t - 16) + c;
    if (t < 20) return 1536 + 256 * (t - 18) + c;
    if (t < 22) return 2048 + 256 * (t - 20) + c;
    if (t == 22) return 3136 + c;
    if (t == 23) return c < 128 ? 3520 + c : 3776 + (c - 128);
    return 4940 + 256 * (t - 24) + c;
}
__device__ __forceinline__ int uq_map(int np) {
    const int t = np >> 8, c = np & 255;
    if (t < 2) { const int slot = c >> 6, head = 2 * t + (slot >> 1), d = 64 * (slot & 1) + (c & 63); return head * 192 + d; }
    const int head = (c >> 5) & 3, d = (c & 31) + 32 * (c >> 7); return head * 192 + 128 + d;
}
enum { WK_GU0 = 0, WK_GU1, WK_D0, WK_D1, WK_IN, WK_OUT, WK_UQ, WK_UKV, WK_C1K, WK_C1V, WK_MQ, WK_MKV, WK_MO, WK_N };
struct WJob { const float* W; h16* dst; int K, NP, kind; const float* kscale; };
__device__ __forceinline__ long wsrc(int kind, int k, int np) {
    switch (kind) {
        case WK_GU0: case WK_GU1: { const int pn = np >> 8, c = np & 255; const int col = c < 128 ? 128 * pn + c : DFF + 128 * pn + (c - 128); return (long)k * (2 * DFF) + col; }
        case WK_D0: case WK_D1: return (long)k * DM + np;
        case WK_IN: { const int col = win_map(np); return col < 0 ? -1 : (long)k * D_IN + col; }
        case WK_OUT: return (long)k * DM + np;
        case WK_UQ: return (long)k * 768 + uq_map(np);
        case WK_UKV: return (long)k * 1024 + np;
        case WK_C1K: case WK_C1V: return (long)((np >> 7) * 2048 + k) * 128 + (np & 127);
        case WK_MQ: return (long)k * 512 + np;
        case WK_MKV: return (long)k * 1024 + np;
        default: return (long)k * DM + np;
    }
}
__device__ __forceinline__ void p0_transpose_item(const WJob& J, LAS float* scr, int item, int lane) {
    const int nblk = J.NP / 32, kb = item / nblk, nb = item % nblk, k0 = 64 * kb, n0 = 32 * nb;
#pragma unroll 8
    for (int i = 0; i < 32; ++i) { const int kk = 2 * i + (lane >> 5); const long so = wsrc(J.kind, k0 + kk, n0 + (lane & 31));
        float v = so >= 0 ? J.W[so] : 0.f; if (J.kscale) v *= J.kscale[k0 + kk]; scr[kk * 33 + (lane & 31)] = v; }
    LDS_WAIT(); asm volatile("" ::: "memory");
    const int c = lane & 7;
#pragma unroll
    for (int j = 0; j < 4; ++j) { const int n = (lane >> 3) + 8 * j; const LAS float* s = scr + (8 * c) * 33 + n;
        half8 o; o[0] = (h16)s[0]; o[1] = (h16)s[33]; o[2] = (h16)s[66]; o[3] = (h16)s[99]; o[4] = (h16)s[132]; o[5] = (h16)s[165]; o[6] = (h16)s[198]; o[7] = (h16)s[231];
        *(half8*)(J.dst + (size_t)(n0 + n) * J.K + k0 + 8 * c) = o; }
    LDS_WAIT(); asm volatile("" ::: "memory");
}
constexpr int WK_ITEMS[WK_N] = { 2 * DFF * DM / 2048, 2 * DFF * DM / 2048, DM * DFF / 2048, DM * DFF / 2048, NIN * DM / 2048, DM * DM / 2048, 768 * 512 / 2048, 1024 * 512 / 2048,
                                 256 * 2048 / 2048, 256 * 2048 / 2048, 512 * DM / 2048, 1024 * DM / 2048, DM * 512 / 2048 };
constexpr int wk_items_per_layer() { int s = 0; for (int i = 0; i < WK_N; ++i) s += WK_ITEMS[i]; return s; }
constexpr int IPL = wk_items_per_layer();
__device__ __forceinline__ WJob wjob(Frame& F, int l, int kind) {
    WJob J; J.kind = kind; J.kscale = nullptr;
    unsigned char* ws = F.ws;
    switch (kind) {
        case WK_GU0: case WK_GU1: { const int f = kind - WK_GU0; J.W = F.in[IN_WGU] + (size_t)(l * 2 + f) * DM * 2 * DFF; J.dst = (h16*)(ws + WS_WGU) + (size_t)(l * 2 + f) * 2 * DFF * DM; J.K = DM; J.NP = 2 * DFF; break; }
        case WK_D0: case WK_D1: { const int f = kind - WK_D0; J.W = F.in[IN_WD] + (size_t)(l * 2 + f) * DFF * DM; J.dst = (h16*)(ws + WS_WD) + (size_t)(l * 2 + f) * DM * DFF; J.K = DFF; J.NP = DM; break; }
        case WK_IN: J.W = F.in[IN_WIN] + (size_t)l * DM * D_IN; J.dst = (h16*)(ws + WS_WIN) + (size_t)l * NIN * DM; J.K = DM; J.NP = NIN; break;
        case WK_OUT: J.W = F.in[IN_WOUT] + (size_t)l * DM * DM; J.dst = (h16*)(ws + WS_WOUT) + (size_t)l * DM * DM; J.K = DM; J.NP = DM; break;
        case WK_UQ: J.W = F.in[IN_WUQ] + (size_t)l * 512 * 768; J.dst = (h16*)(ws + WS_WUQ) + (size_t)l * 768 * 512; J.K = 512; J.NP = 768; J.kscale = F.in[IN_GCQ] + l * 512; break;
        case WK_UKV: J.W = F.in[IN_WUKV] + (size_t)l * 512 * 1024; J.dst = (h16*)(ws + WS_WUKV) + (size_t)l * 1024 * 512; J.K = 512; J.NP = 1024; J.kscale = F.in[IN_GCKV] + l * 512; break;
        case WK_C1K: case WK_C1V: { const int i = kind - WK_C1K; J.W = F.in[IN_W1] + (size_t)(l * 2 + i) * 4096 * 128; J.dst = (h16*)(ws + WS_WC1) + (size_t)(l * 2 + i) * 256 * 2048; J.K = 2048; J.NP = 256; break; }
        case WK_MQ: J.W = F.in[IN_MWQ] + (size_t)l * DM * 512; J.dst = (h16*)(ws + WS_WMQ) + (size_t)l * 512 * DM; J.K = DM; J.NP = 512; break;
        case WK_MKV: J.W = F.in[IN_MWKV] + (size_t)l * DM * 1024; J.dst = (h16*)(ws + WS_WMKV) + (size_t)l * 1024 * DM; J.K = DM; J.NP = 1024; break;
        default: J.W = F.in[IN_MWO] + (size_t)l * 512 * DM; J.dst = (h16*)(ws + WS_WMO) + (size_t)l * DM * 512; J.K = 512; J.NP = DM; break;
    }
    return J;
}
__device__ __forceinline__ void sincos_d(double a, float& sn, float& cs) {
    const double k = __builtin_rint(a * 0.63661977236758134308);
    double r = __builtin_fma(-k, 1.57079632679489655800e+00, a); r = __builtin_fma(-k, 6.12323399573676603587e-17, r);
    const double r2 = r * r;
    double s = -1.0 / 1307674368000.0; s = s * r2 + 1.0 / 6227020800.0; s = s * r2 - 1.0 / 39916800.0; s = s * r2 + 1.0 / 362880.0; s = s * r2 - 1.0 / 5040.0; s = s * r2 + 1.0 / 120.0; s = s * r2 - 1.0 / 6.0; s = s * r2 * r + r;
    double c = 1.0 / 20922789888000.0; c = c * r2 - 1.0 / 87178291200.0; c = c * r2 + 1.0 / 479001600.0; c = c * r2 - 1.0 / 3628800.0; c = c * r2 + 1.0 / 40320.0; c = c * r2 - 1.0 / 720.0; c = c * r2 + 1.0 / 24.0; c = c * r2 - 0.5; c = c * r2 + 1.0;
    const int q = ((int)k) & 3;
    const double ss = (q == 0) ? s : (q == 1) ? c : (q == 2) ? -s : -c;
    const double cc = (q == 0) ? c : (q == 1) ? -s : (q == 2) ? -c : s;
    sn = (float)ss; cs = (float)cc;
}
__device__ __forceinline__ void p0_prologue(Frame& F) { int lane = F.lane; asm volatile("" : "+v"(lane));
    LAS float* scr = (LAS float*)(F.lds + F.wave * 16384);
    const int gw = blockIdx.x * NWAVES + F.wave, NGW = F.G * NWAVES;
    for (int it = gw; it < DEPTH * IPL; it += NGW) {
        const int l = it / IPL; int r = it % IPL; int kind = 0;
#pragma unroll
        for (int k = 0; k < WK_N; ++k) { if (kind == k && r >= WK_ITEMS[k]) { r -= WK_ITEMS[k]; kind = k + 1; } }
        const WJob J = wjob(F, l, kind);
        p0_transpose_item(J, scr, r, lane);
    }
    const int* pos = (const int*)F.in[IN_POS];
    for (int m = gw; m < S; m += NGW) {
        const f32x4* xr = (const f32x4*)(F.in[IN_X] + (size_t)m * DM) + lane;
        f32x4* xo = (f32x4*)((float*)(F.ws + WS_XF) + (size_t)m * DM) + lane;
        half4* xh = (half4*)((h16*)(F.ws + WS_XH) + (size_t)m * DM) + lane;
#pragma unroll
        for (int j = 0; j < 8; ++j) { const f32x4 v = xr[64 * j]; xo[64 * j] = v; half4 h; h[0] = (h16)v[0]; h[1] = (h16)v[1]; h[2] = (h16)v[2]; h[3] = (h16)v[3]; xh[64 * j] = h; }
        const double p = (double)pos[m];
        float sn, cs; sincos_d(p * ROPE_INV[lane], sn, cs);
        ((float*)(F.ws + WS_T128C))[(size_t)m * 64 + lane] = cs; ((float*)(F.ws + WS_T128S))[(size_t)m * 64 + lane] = sn;
        if ((lane & 1) == 0) { ((float*)(F.ws + WS_T64C))[(size_t)m * 32 + (lane >> 1)] = cs; ((float*)(F.ws + WS_T64S))[(size_t)m * 32 + (lane >> 1)] = sn; }
    }
    for (int m = gw; m < MEMLEN; m += NGW) {
        const f32x4* xr = (const f32x4*)(F.in[IN_MEM] + (size_t)m * DM) + lane;
        half4* xh = (half4*)((h16*)(F.ws + WS_MEMH) + (size_t)m * DM) + lane;
#pragma unroll
        for (int j = 0; j < 8; ++j) { const f32x4 v = xr[64 * j]; half4 h; h[0] = (h16)v[0]; h[1] = (h16)v[1]; h[2] = (h16)v[2]; h[3] = (h16)v[3]; xh[64 * j] = h; }
    }
    for (int i = gw * 64 + lane; i < 16 * DM; i += NGW * 64) { ((float*)(F.ws + WS_LNG))[i] = F.in[IN_LNG][i]; ((float*)(F.ws + WS_LNB))[i] = F.in[IN_LNB][i]; }
    for (int i = gw * 64 + lane; i < 8 * 128 * 128; i += NGW * 64) ((float*)(F.ws + WS_W2C))[i] = F.in[IN_W2][i];
    for (int it = gw; it < DEPTH * 2 * 8; it += NGW) {
        const int li = it >> 3, n = (it & 7) * 16 + (lane & 15), kq = lane >> 4;
        const float* pe = F.in[IN_PE] + (size_t)li * 4096; const float* w1 = F.in[IN_W1] + (size_t)li * 4096 * 128;
        float a = 0.f;
        for (int k = kq; k < 4096; k += 4) a += pe[k] * w1[(size_t)k * 128 + n];
        a += __shfl_xor(a, 16); a += __shfl_xor(a, 32);
        if (kq == 0) ((float*)(F.ws + WS_CBIAS))[li * 128 + n] = a;
    }
}
__device__ __forceinline__ void ln_phase(Frame& F, const float* z, const float* g, const float* b, float* of, h16* oh) { int lane = F.lane; asm volatile("" : "+v"(lane));
    const int gw = blockIdx.x * NWAVES + F.wave, NGW = F.G * NWAVES;
    f32x4 gv[8], bv[8];
#pragma unroll
    for (int j = 0; j < 8; ++j) { gv[j] = ((const f32x4*)g)[lane + 64 * j]; bv[j] = ((const f32x4*)b)[lane + 64 * j]; }
    for (int m = gw; m < S; m += NGW) {
        const f32x4* zr = (const f32x4*)(z + (size_t)m * DM) + lane;
        f32x4 v[8]; float s = 0.f;
#pragma unroll
        for (int j = 0; j < 8; ++j) { v[j] = zr[64 * j]; s += (v[j][0] + v[j][1]) + (v[j][2] + v[j][3]); }
        const float mean = wave_sum(s) * (1.f / DM); float s2 = 0.f;
#pragma unroll
        for (int j = 0; j < 8; ++j) { v[j] = v[j] - mean; s2 += (v[j][0] * v[j][0] + v[j][1] * v[j][1]) + (v[j][2] * v[j][2] + v[j][3] * v[j][3]); }
        const float rstd = 1.f / sqrtf(wave_sum(s2) * (1.f / DM) + LN_EPS);
        f32x4* orow = (f32x4*)(of + (size_t)m * DM) + lane; half4* hrow = (half4*)(oh + (size_t)m * DM) + lane;
#pragma unroll
        for (int j = 0; j < 8; ++j) { const f32x4 o = v[j] * rstd * gv[j] + bv[j]; orow[64 * j] = o; half4 h; h[0] = (h16)o[0]; h[1] = (h16)o[1]; h[2] = (h16)o[2]; h[3] = (h16)o[3]; hrow[64 * j] = h; }
    }
}
struct AttnAcc { float m, l, o0, o1; };
__device__ __forceinline__ void attn_init(AttnAcc& a) { a.m = -1e30f; a.l = 0.f; a.o0 = 0.f; a.o1 = 0.f; }
__device__ __forceinline__ float dot_h(const LAS float* qs, const h16* krow, int n16) {
    float acc = 0.f;
#pragma unroll 4
    for (int j = 0; j < n16; ++j) { const half8 w = *(const half8*)(krow + 8 * j); const f32x4 qa = *(const LAS f32x4*)(qs + 8 * j), qb = *(const LAS f32x4*)(qs + 8 * j + 4);
        acc += (float)w[0] * qa[0] + (float)w[1] * qa[1] + (float)w[2] * qa[2] + (float)w[3] * qa[3] + (float)w[4] * qb[0] + (float)w[5] * qb[1] + (float)w[6] * qb[2] + (float)w[7] * qb[3]; }
    return acc;
}
__device__ __forceinline__ void attn_chunk(AttnAcc& a, int key, float logit, const h16* V, int ldv, int lane) {
    const bool valid = key >= 0;
    const float lg = valid ? logit : -__builtin_inff();
    const float cmax = wave_max(lg);
    if (cmax == -__builtin_inff()) return;
    const float mn = fmaxf(a.m, cmax), alpha = __expf(a.m - mn);
    const float p = valid ? __expf(lg - mn) : 0.f;
    a.l = a.l * alpha + wave_sum(p); a.o0 *= alpha; a.o1 *= alpha; a.m = mn;
    u64 mask = __ballot(valid);
    while (mask) { const int j = __builtin_ctzll(mask); mask &= mask - 1;
        const float pj = __builtin_bit_cast(float, __builtin_amdgcn_readlane(__builtin_bit_cast(int, p), j)); const int kj = __builtin_amdgcn_readlane(key, j);
        const half2v v = *(const half2v*)(V + (size_t)kj * ldv + 2 * lane);
        a.o0 += pj * (float)v[0]; a.o1 += pj * (float)v[1]; }
}
__device__ __forceinline__ void load_q(LAS float* qs, const h16* q, int nd, int lane) {
    for (int i = lane; i < nd / 2; i += 64) { const half2v v = *(const half2v*)(q + 2 * i); qs[2 * i] = (float)v[0]; qs[2 * i + 1] = (float)v[1]; }
    LDS_WAIT(); asm volatile("" ::: "memory");
}
__device__ __forceinline__ void store_o(h16* dst, const AttnAcc& a, int lane) {
    const float inv = a.l > 0.f ? 1.0f / a.l : 0.f; half2v o; o[0] = (h16)(a.o0 * inv); o[1] = (h16)(a.o1 * inv); *(half2v*)(dst + 2 * lane) = o;
}
#define WAVE_ITEMS(it, total) for (int it = blockIdx.x * NWAVES + F.wave; it < (total); it += F.G * NWAVES)
constexpr float SC128 = 0.08838834764831845f, SC192 = 0.07216878364870323f;

__device__ __forceinline__ void moba_kmean_phase(Frame& F) { int lane = F.lane; asm volatile("" : "+v"(lane));
    WAVE_ITEMS(it, 4 * 32) { const int h = it >> 5, n = it & 31; const h16* k = (const h16*)(F.ws + WS_AK + (size_t)h * HEADBUF) + (size_t)n * 256 * 128 + 2 * lane;
        float s0 = 0.f, s1 = 0.f;
        for (int r = 0; r < 256; ++r) { const half2v v = *(const half2v*)(k + (size_t)r * 128); s0 += (float)v[0]; s1 += (float)v[1]; }
        float* o = (float*)(F.ws + WS_KMEAN) + (size_t)it * 128 + 2 * lane; o[0] = s0 * (1.f / 256.f); o[1] = s1 * (1.f / 256.f); }
}
__device__ __forceinline__ float gelu_tanh(float x) { const float u = 0.7978845608028654f * (x + 0.044715f * x * x * x); return 0.5f * x * (1.0f + tanhf(u)); }
__device__ __forceinline__ void nsa_cmp2_phase(Frame& F, int l) { int lane = F.lane; asm volatile("" : "+v"(lane));
    LAS float* hs = (LAS float*)(F.lds + F.wave * 16384);
    WAVE_ITEMS(it, 2 * 511) { const int br = it / 511, i = it % 511;
        const float* Y = (const float*)(F.ws + (br ? WS_YV : WS_YK)); const float* cb = (const float*)(F.ws + WS_CBIAS) + (l * 2 + br) * 128;
        const float* w2 = (const float*)(F.ws + WS_W2C) + (size_t)(l * 2 + br) * 128 * 128;
#pragma unroll
        for (int e = 0; e < 2; ++e) { const int n = lane + 64 * e; hs[n] = gelu_tanh(Y[(size_t)i * 256 + n] + Y[(size_t)(i + 1) * 256 + 128 + n] + cb[n]); }
        LDS_WAIT(); asm volatile("" ::: "memory");
        float o0 = 0.f, o1 = 0.f;
        for (int k = 0; k < 128; ++k) { const float hv = hs[k]; o0 += hv * w2[k * 128 + lane]; o1 += hv * w2[k * 128 + 64 + lane]; }
        float* o = (float*)(F.ws + (br ? WS_VC : WS_KC)) + (size_t)i * 128; o[lane] = o0; o[64 + lane] = o1;
        LDS_WAIT(); asm volatile("" ::: "memory"); }
}
__device__ __forceinline__ void moba_gate_phase(Frame& F) { int lane = F.lane; asm volatile("" : "+v"(lane));
    WAVE_ITEMS(it, S * 4) { const int t = it >> 2, h = it & 3, cur = t >> 8;
        int* sel = (int*)(F.ws + WS_MOBASEL) + (size_t)t * 16 + h * 4;
        const int n = lane & 31; float g = -__builtin_inff();
        if (n < cur) { const h16* q = (const h16*)(F.ws + WS_AQ + (size_t)h * HEADBUF) + (size_t)t * 128; const float* km = (const float*)(F.ws + WS_KMEAN) + (size_t)(h * 32 + n) * 128;
            float a = 0.f;
            for (int d = 0; d < 128; d += 8) { const half8 qv = *(const half8*)(q + d); const f32x4 k0 = *(const f32x4*)(km + d), k1 = *(const f32x4*)(km + d + 4);
                a += (float)qv[0] * k0[0] + (float)qv[1] * k0[1] + (float)qv[2] * k0[2] + (float)qv[3] * k0[3] + (float)qv[4] * k1[0] + (float)qv[5] * k1[1] + (float)qv[6] * k1[2] + (float)qv[7] * k1[3]; }
            g = a; }
        if (lane >= 32) g = -__builtin_inff();
#pragma unroll
        for (int r = 0; r < 3; ++r) { const float mx = wave_max(g); int idx = -1;
            if (mx > -__builtin_inff()) { const u64 bm = __ballot(g == mx); idx = __builtin_ctzll(bm); if (lane == idx) g = -__builtin_inff(); }
            if (lane == 0) sel[r] = idx; }
    }
}
__device__ __forceinline__ void dsa_score_phase(Frame& F) { int lane = F.lane; asm volatile("" : "+v"(lane));
    LAS float* qs = (LAS float*)(F.lds + F.wave * 16384);
    WAVE_ITEMS(t, S) {
        const h16* iq = (const h16*)(F.ws + WS_IQ) + (size_t)t * 1024;
#pragma unroll
        for (int e = 0; e < 2; ++e) { const half8 v = *(const half8*)(iq + (lane + 64 * e) * 8);
#pragma unroll
            for (int j = 0; j < 8; ++j) qs[(lane + 64 * e) * 8 + j] = (float)v[j]; }
        if (lane < 16) qs[1024 + lane] = ((const float*)(F.ws + WS_SMALL))[(size_t)t * 32 + 12 + lane] * (0.25f * 0.125f);
        LDS_WAIT(); asm volatile("" ::: "memory");
        float* sc = (float*)(F.ws + WS_SCORES) + (size_t)t * S;
        for (int c = 0; c * 64 <= t; ++c) { const int s = c * 64 + lane; const h16* ik = (const h16*)(F.ws + WS_IK) + (size_t)s * 64;
            float kv[64];
#pragma unroll
            for (int j = 0; j < 8; ++j) { const half8 v = *(const half8*)(ik + 8 * j);
#pragma unroll
                for (int e = 0; e < 8; ++e) kv[8 * j + e] = (float)v[e]; }
            float score = 0.f;
#pragma unroll 1
            for (int h = 0; h < 16; ++h) { float a = 0.f; const LAS float* qh = qs + h * 64;
#pragma unroll
                for (int d = 0; d < 64; d += 4) { const f32x4 q4 = *(const LAS f32x4*)(qh + d); a += q4[0] * kv[d] + q4[1] * kv[d + 1] + q4[2] * kv[d + 2] + q4[3] * kv[d + 3]; }
                score += qs[1024 + h] * fmaxf(a, 0.f); }
            sc[s] = score; }
        LDS_WAIT(); asm volatile("" ::: "memory");
    }
}
__device__ __forceinline__ void nsa_cmp_select_phase(Frame& F) { int lane = F.lane; asm volatile("" : "+v"(lane));
    LAS float* qs = (LAS float*)(F.lds + F.wave * 16384);
    LAS float* pp = qs + 256;
    const float* kc = (const float*)(F.ws + WS_KC); const float* vc = (const float*)(F.ws + WS_VC);
    WAVE_ITEMS(t, S) {
        const int nvis = t >= 31 ? ((t - 31) >> 4) + 1 : 0;
        float P[8];
#pragma unroll
        for (int c = 0; c < 8; ++c) P[c] = 0.f;
        for (int h = 0; h < 4; ++h) {
            load_q(qs, (const h16*)(F.ws + WS_CQRAW + (size_t)h * HEADBUF) + (size_t)t * 128, 128, lane);
            float lg[8]; float mx = -__builtin_inff();
#pragma unroll
            for (int c = 0; c < 8; ++c) { const int n = c * 64 + lane; lg[c] = -__builtin_inff();
                if (c * 64 < nvis) { const bool ok = n < nvis; const float* kr = kc + (size_t)(ok ? n : 0) * 128; float a = 0.f;
#pragma unroll 4
                    for (int d = 0; d < 128; d += 4) { const f32x4 k4 = *(const f32x4*)(kr + d); const f32x4 q4 = *(const LAS f32x4*)(qs + d); a += k4[0] * q4[0] + k4[1] * q4[1] + k4[2] * q4[2] + k4[3] * q4[3]; }
                    if (ok) lg[c] = a * SC128; }
                mx = fmaxf(mx, lg[c]); }
            mx = wave_max(mx);
            float o0 = 0.f, o1 = 0.f;
            if (nvis > 0) {
                float p[8]; float sum = 0.f;
#pragma unroll
                for (int c = 0; c < 8; ++c) { p[c] = lg[c] > -__builtin_inff() ? __expf(lg[c] - mx) : 0.f; sum += p[c]; }
                sum = wave_sum(sum); const float inv = 1.0f / sum;
#pragma unroll
                for (int c = 0; c < 8; ++c) { p[c] *= inv; P[c] += p[c];
                    if (c * 64 < nvis) { const int lim = min(64, nvis - c * 64);
                        for (int j = 0; j < lim; ++j) { const float pj = __builtin_bit_cast(float, __builtin_amdgcn_readlane(__builtin_bit_cast(int, p[c]), j)); const float* vr = vc + (size_t)(c * 64 + j) * 128;
                            o0 += pj * vr[lane]; o1 += pj * vr[64 + lane]; } } }
            }
            float* oc = (float*)(F.ws + WS_OCMP) + ((size_t)t * 4 + h) * 128; oc[lane] = o0; oc[64 + lane] = o1;
            LDS_WAIT(); asm volatile("" ::: "memory");
        }
#pragma unroll
        for (int c = 0; c < 8; ++c) { const int n = c * 64 + lane; if (n < 511) pp[n + 1] = P[c]; }
        if (lane == 0) { pp[0] = 0.f; pp[512] = 0.f; }
        LDS_WAIT(); asm volatile("" ::: "memory");
        const int cur = t >> 6;
        float v0, v1;
        { const int b = lane; float im = 0.f;
#pragma unroll
          for (int r = 0; r < 5; ++r) im += pp[4 * b + r];
          v0 = (b > cur) ? -__builtin_inff() : ((b == 0 || b == cur || b == cur - 1) ? __builtin_inff() : im); }
        { const int b = lane + 64; float im = 0.f;
#pragma unroll
          for (int r = 0; r < 5; ++r) im += pp[4 * b + r];
          v1 = (b > cur) ? -__builtin_inff() : ((b == cur || b == cur - 1) ? __builtin_inff() : im); }
        int* sel = (int*)(F.ws + WS_NSASEL) + (size_t)t * 16; unsigned m0 = 0, m1 = 0, m2 = 0, m3 = 0;
        for (int r = 0; r < 16; ++r) { const float mx = wave_max(fmaxf(v0, v1)); int idx = -1;
            if (mx > -__builtin_inff()) { const u64 b0 = __ballot(v0 == mx), b1 = __ballot(v1 == mx);
                idx = b0 ? __builtin_ctzll(b0) : 64 + __builtin_ctzll(b1);
                if (idx < 64) { if (lane == idx) v0 = -__builtin_inff(); } else { if (lane == idx - 64) v1 = -__builtin_inff(); }
                if (idx < 32) m0 |= 1u << idx; else if (idx < 64) m1 |= 1u << (idx - 32); else if (idx < 96) m2 |= 1u << (idx - 64); else m3 |= 1u << (idx - 96); }
            if (lane == 0) sel[r] = idx; }
        if (lane == 0) { unsigned* mk = (unsigned*)(F.ws + WS_NSAMASK) + (size_t)t * 4; mk[0] = m0; mk[1] = m1; mk[2] = m2; mk[3] = m3; }
        LDS_WAIT(); asm volatile("" ::: "memory");
    }
}
__device__ __forceinline__ unsigned f2key(float f) { const unsigned u = __builtin_bit_cast(unsigned, f); return (u & 0x80000000u) ? ~u : (u | 0x80000000u); }
__device__ __forceinline__ int wave_sum_i(int v) {
#pragma unroll
    for (int o = 1; o < 64; o <<= 1) v += __shfl_xor(v, o);
    return v;
}
__device__ __forceinline__ void dsa_topk_phase(Frame& F) { int lane = F.lane; asm volatile("" : "+v"(lane));
    WAVE_ITEMS(t, S) {
        asm volatile("" : "+v"(lane));
        const float* sc = (const float*)(F.ws + WS_SCORES) + (size_t)t * S + lane;
        int* list = (int*)(F.ws + WS_DSALIST) + (size_t)t * 256; u64* bm = (u64*)(F.ws + WS_DSAMASK) + (size_t)t * 128;
        unsigned u[128];
#pragma unroll
        for (int c = 0; c < 128; ++c) { u[c] = 0u; if (c * 64 <= t) { const bool ok = lane <= t - c * 64; const float v = ok ? sc[c * 64] : 0.f; u[c] = ok ? f2key(v) : 0u; } }
        unsigned T = 0u; int need_eq = 0;
        if (t >= 256) {
            for (int b = 31; b >= 0; --b) { const unsigned cand = T | (1u << b); int cnt = 0;
#pragma unroll
                for (int c = 0; c < 128; ++c) cnt += (u[c] >= cand) ? 1 : 0;
                cnt = wave_sum_i(cnt);
                if (cnt >= 256) T = cand; }
            int gt = 0;
#pragma unroll
            for (int c = 0; c < 128; ++c) gt += (u[c] > T) ? 1 : 0;
            need_eq = 256 - wave_sum_i(gt);
        } else T = 1u;
        int base = 0;
#pragma unroll
        for (int c = 0; c < 128; ++c) {
            bool selv = u[c] > T;
            if (need_eq > 0) { const u64 eq = __ballot(u[c] == T);
                if (eq) { const int rank = __builtin_popcountll(eq & ((1ull << lane) - 1ull)); selv = selv || (u[c] == T && rank < need_eq); need_eq -= min(need_eq, (int)__builtin_popcountll(eq)); } }
            const u64 sm = __ballot(selv);
            if (lane == 0) bm[c] = sm;
            if (selv) list[base + __builtin_popcountll(sm & ((1ull << lane) - 1ull))] = c * 64 + lane;
            base += __builtin_popcountll(sm);
            __builtin_amdgcn_sched_barrier(0);
        }
        for (int i = base + lane; i < 256; i += 64) list[i] = -1;
    }
}
__device__ __forceinline__ void moba_attn_phase(Frame& F) { int lane = F.lane; asm volatile("" : "+v"(lane));
    LAS float* qs = (LAS float*)(F.lds + F.wave * 16384);
    WAVE_ITEMS(it, S * 4) { const int t = it >> 2, h = it & 3, cur = t >> 8;
        const h16* K = (const h16*)(F.ws + WS_AK + (size_t)h * HEADBUF); const h16* V = (const h16*)(F.ws + WS_AV + (size_t)h * HEADBUF);
        load_q(qs, (const h16*)(F.ws + WS_AQ + (size_t)h * HEADBUF) + (size_t)t * 128, 128, lane);
        const int* sel = (const int*)(F.ws + WS_MOBASEL) + (size_t)t * 16 + h * 4;
        AttnAcc a; attn_init(a);
        for (int bi = 0; bi < 4; ++bi) { const int blk = bi == 0 ? cur : sel[bi - 1]; if (blk < 0) continue;
            for (int c = 0; c < 4; ++c) { const int s = blk * 256 + c * 64 + lane; const int key = (s <= t) ? s : -1;
                if (blk * 256 + c * 64 > t) break;
                const float lg = dot_h(qs, K + (size_t)(key < 0 ? 0 : key) * 128, 16) * SC128;
                attn_chunk(a, key, lg, V, 128, lane); } }
        store_o((h16*)(F.ws + WS_OMIX) + (size_t)t * DM + h * 128, a, lane);
        LDS_WAIT(); asm volatile("" ::: "memory"); }
}
__device__ __forceinline__ void mla_attn_phase(Frame& F) { int lane = F.lane; asm volatile("" : "+v"(lane));
    LAS float* qs = (LAS float*)(F.lds + F.wave * 16384);
    WAVE_ITEMS(it, S * 4) { const int t = it >> 2, h = it & 3;
        const h16* K = (const h16*)(F.ws + WS_KN + (size_t)h * HEADBUF); const h16* KR = (const h16*)(F.ws + WS_BKR); const h16* V = (const h16*)(F.ws + WS_BV + (size_t)h * HEADBUF);
        load_q(qs, (const h16*)(F.ws + WS_Q192) + ((size_t)h * S + t) * 192, 192, lane);
        AttnAcc a; attn_init(a);
        for (int c = 0; c * 64 <= t; ++c) { const int s = c * 64 + lane; const int key = (s <= t) ? s : -1; const int ks = key < 0 ? 0 : key;
            const float lg = (dot_h(qs, K + (size_t)ks * 128, 16) + dot_h(qs + 128, KR + (size_t)ks * 64, 8)) * SC192;
            attn_chunk(a, key, lg, V, 128, lane); }
        store_o((h16*)(F.ws + WS_OMIX) + (size_t)t * DM + 512 + h * 128, a, lane);
        LDS_WAIT(); asm volatile("" ::: "memory"); }
}
__device__ __forceinline__ void nsa_attn_phase(Frame& F) { int lane = F.lane; asm volatile("" : "+v"(lane));
    LAS float* qs = (LAS float*)(F.lds + F.wave * 16384);
    WAVE_ITEMS(it, S * 4) { const int t = it >> 2, h = it & 3, cur = t >> 6;
        load_q(qs, (const h16*)(F.ws + WS_CQROPE + (size_t)h * HEADBUF) + (size_t)t * 128, 128, lane);
        const h16* KS = (const h16*)(F.ws + WS_KSLC); const h16* VS = (const h16*)(F.ws + WS_VSLC); const h16* KW = (const h16*)(F.ws + WS_KWIN); const h16* VW = (const h16*)(F.ws + WS_VWIN);
        const int* sel = (const int*)(F.ws + WS_NSASEL) + (size_t)t * 16;
        AttnAcc a; attn_init(a);
        for (int r = 0; r < 16; ++r) { const int blk = sel[r]; if (blk < 0 || blk > cur) continue;
            const int s = blk * 64 + lane; const int key = (s <= t) ? s : -1;
            const float lg = dot_h(qs, KS + (size_t)(key < 0 ? 0 : key) * 128, 16) * SC128;
            attn_chunk(a, key, lg, VS, 128, lane); }
        AttnAcc w; attn_init(w);
        const int lo = t >= 511 ? t - 511 : 0;
        for (int c = lo >> 6; c * 64 <= t; ++c) { const int s = c * 64 + lane; const int key = (s <= t && s >= lo) ? s : -1;
            const float lg = dot_h(qs, KW + (size_t)(key < 0 ? 0 : key) * 128, 16) * SC128;
            attn_chunk(w, key, lg, VW, 128, lane); }
        const float* gl = (const float*)(F.ws + WS_SMALL) + (size_t)t * 32 + h * 3;
        const float g0 = 1.0f / (1.0f + __expf(-gl[0])), g1 = 1.0f / (1.0f + __expf(-gl[1])), g2 = 1.0f / (1.0f + __expf(-gl[2]));
        const float* oc = (const float*)(F.ws + WS_OCMP) + ((size_t)t * 4 + h) * 128 + 2 * lane;
        const float ia = a.l > 0.f ? 1.0f / a.l : 0.f, iw = w.l > 0.f ? 1.0f / w.l : 0.f;
        half2v o; o[0] = (h16)(g0 * oc[0] + g1 * a.o0 * ia + g2 * w.o0 * iw); o[1] = (h16)(g0 * oc[1] + g1 * a.o1 * ia + g2 * w.o1 * iw);
        *(half2v*)((h16*)(F.ws + WS_OMIX) + (size_t)t * DM + 1024 + h * 128 + 2 * lane) = o;
        LDS_WAIT(); asm volatile("" ::: "memory"); }
}
__device__ __forceinline__ void dsa_attn_phase(Frame& F) { int lane = F.lane; asm volatile("" : "+v"(lane));
    LAS float* qs = (LAS float*)(F.lds + F.wave * 16384);
    WAVE_ITEMS(it, S * 4) { const int t = it >> 2, h = it & 3;
        const h16* K = (const h16*)(F.ws + WS_DK + (size_t)h * HEADBUF); const h16* V = (const h16*)(F.ws + WS_DV + (size_t)h * HEADBUF);
        load_q(qs, (const h16*)(F.ws + WS_DQ + (size_t)h * HEADBUF) + (size_t)t * 128, 128, lane);
        const int* list = (const int*)(F.ws + WS_DSALIST) + (size_t)t * 256;
        AttnAcc a; attn_init(a);
        for (int c = 0; c < 4; ++c) { int key = list[c * 64 + lane]; if (key > t) key = -1;
            const float lg = dot_h(qs, K + (size_t)(key < 0 ? 0 : key) * 128, 16) * SC128;
            attn_chunk(a, key, lg, V, 128, lane); }
        store_o((h16*)(F.ws + WS_OMIX) + (size_t)t * DM + 1536 + h * 128, a, lane);
        LDS_WAIT(); asm volatile("" ::: "memory"); }
}
__device__ __forceinline__ void mem_attn_phase(Frame& F, int l) { int lane = F.lane; asm volatile("" : "+v"(lane));
    LAS float* qs = (LAS float*)(F.lds + F.wave * 16384);
    WAVE_ITEMS(it, S * 4) { const int t = it >> 2, h = it & 3;
        const h16* K = (const h16*)(F.ws + WS_MK) + (size_t)((l * 4 + h) * MEMLEN) * 128; const h16* V = (const h16*)(F.ws + WS_MV) + (size_t)((l * 4 + h) * MEMLEN) * 128;
        load_q(qs, (const h16*)(F.ws + WS_MQ + (size_t)h * HEADBUF) + (size_t)t * 128, 128, lane);
        AttnAcc a; attn_init(a);
        for (int c = 0; c < 4; ++c) { const int key = c * 64 + lane;
            const float lg = dot_h(qs, K + (size_t)key * 128, 16) * SC128;
            attn_chunk(a, key, lg, V, 128, lane); }
        store_o((h16*)(F.ws + WS_MO) + (size_t)t * 512 + h * 128, a, lane);
        LDS_WAIT(); asm volatile("" ::: "memory"); }
}
enum { PHB_P0, PHB_KMEAN, PHB_CMP2, PHB_GATE, PHB_SCORE, PHB_CMPSEL, PHB_TOPK, PHB_MOBA, PHB_MLA, PHB_NSA, PHB_DSA, PHB_MEMA, PHB_LN, PHB_GMKV, PHB_GSWIGLU, PHB_GWIN, PHB_GUQ, PHB_GUKV, PHB_GY, PHB_GMQ, PHB_GRESID };
#ifndef SKIPMASK
#define SKIPMASK 0u
#endif
constexpr int SLOTS = 7, NSTEPS = 2 + 16 * SLOTS;
struct Args { const float* in[19]; float* out; unsigned char* ws; int lo, hi; };
__global__ void __launch_bounds__(NTHREADS, 2) mk_fwd(Args args) {
    extern __shared__ __attribute__((aligned(16))) unsigned char lds_raw[];
    Frame F;
    F.lds = (LAS unsigned char*)lds_raw;
    F.MISC = (volatile LAS unsigned*)(F.lds + MISC_OFF);
    F.tid = threadIdx.x; F.lane = F.tid & 63; F.wave = __builtin_amdgcn_readfirstlane(F.tid >> 6);
    F.G = gridDim.x; F.ws = args.ws; F.ctl = (unsigned*)(args.ws + WS_CTL); F.out = args.out;
#pragma unroll
    for (int i = 0; i < 19; ++i) F.in[i] = args.in[i];
    for (int u = F.tid; u < (LDS_BYTES - LDSCTL_OFF) / 4; u += NTHREADS) ((LAS unsigned*)(F.lds + LDSCTL_OFF))[u] = 0u;
    __syncthreads();
    const int lo = args.lo, hi = args.hi;
    XcdBarrier bar; bar.bar = F.ctl + CW_BAR; bar.x = 0; bar.st = nullptr;
    if (hi - lo > 1) bar = xcd_barrier_post(F.ctl + CW_BAR, F.MISC + 8);
#define PH(name, call) do { if (!(SKIPMASK & (1u << PHB_##name))) { call; } } while (0)
#define IN(k) (lo <= (k) && (k) < hi)
#define END(k) do { if (hi > (k) + 1) xcd_barrier(bar); } while (0)
    unsigned char* ws = args.ws;
    const float* xf = (const float*)(ws + WS_XF); float* z = (float*)(ws + WS_Z); const h16* xh = (const h16*)(ws + WS_XH);

    if (IN(0)) { PH(P0, p0_prologue(F)); END(0); }
    if (IN(1)) {
        pg8::Gemm g{(const h16*)(ws + WS_MEMH), (const h16*)(ws + WS_WMKV), MEMLEN, DEPTH * 1024, DM}; pg8::StaticOrder So; So.init(MEMLEN, DEPTH * 1024, F.G, (int)blockIdx.x);
        EpiProj<JOB_MKV> E{ws, 0};
        PH(GMKV, (pg8::gemm_phase<EpiProj<JOB_MKV>, pg8::StaticOrder, true, true>(F.lds, g, So, E)));
        END(1);
    }
    for (int sb = 0; sb < 16; ++sb) {
        const int l = sb >> 2, kind = sb & 3, base = 2 + sb * SLOTS;
        if (hi <= base || lo >= base + SLOTS) continue;
        const h16* resA; const h16* resB; int resK; float resS; int lnidx;
        if (kind == 0 || kind == 3) {
            const int f = kind == 0 ? 0 : 1;
            resA = (const h16*)(ws + WS_HB); resB = (const h16*)(ws + WS_WD) + (size_t)(l * 2 + f) * DM * DFF; resK = DFF; resS = 0.5f; lnidx = kind;
            if (IN(base)) {
                pg8::Gemm g{xh, (const h16*)(ws + WS_WGU) + (size_t)(l * 2 + f) * 2 * DFF * DM, S, 2 * DFF, DM}; pg8::StaticOrder So; So.init(S, 2 * DFF, F.G, (int)blockIdx.x);
                EpiSwiglu E{(h16*)(ws + WS_HB)};
                PH(GSWIGLU, (pg8::gemm_phase<EpiSwiglu, pg8::StaticOrder, true, true>(F.lds, g, So, E)));
                END(base);
            }
        } else if (kind == 1) {
            resA = (const h16*)(ws + WS_OMIX); resB = (const h16*)(ws + WS_WOUT) + (size_t)l * DM * DM; resK = DM; resS = 1.0f; lnidx = 1;
            if (IN(base)) {
                pg8::Gemm g{xh, (const h16*)(ws + WS_WIN) + (size_t)l * NIN * DM, S, NIN, DM}; pg8::StaticOrder So; So.init(S, NIN, F.G, (int)blockIdx.x);
                EpiProj<JOB_WIN> E{ws, 0};
                PH(GWIN, (pg8::gemm_phase<EpiProj<JOB_WIN>, pg8::StaticOrder, true, true>(F.lds, g, So, E)));
                END(base);
            }
            if (IN(base + 1)) {
                { pg8::Gemm g{(const h16*)(ws + WS_BCQ), (const h16*)(ws + WS_WUQ) + (size_t)l * 768 * 512, S, 768, 512}; pg8::StaticOrder So; So.init(S, 768, F.G, (int)blockIdx.x);
                  EpiProj<JOB_UQ> E{ws, 0}; PH(GUQ, (pg8::gemm_phase<EpiProj<JOB_UQ>, pg8::StaticOrder, true, true>(F.lds, g, So, E))); }
                { pg8::Gemm g{(const h16*)(ws + WS_BCKV), (const h16*)(ws + WS_WUKV) + (size_t)l * 1024 * 512, S, 1024, 512}; pg8::StaticOrder So; So.init(S, 1024, F.G, (int)blockIdx.x);
                  EpiProj<JOB_UKV> E{ws, 0}; PH(GUKV, (pg8::gemm_phase<EpiProj<JOB_UKV>, pg8::StaticOrder, true, true>(F.lds, g, So, E))); }
                for (int br = 0; br < 2; ++br) {
                  pg8::Gemm g{(const h16*)(ws + (br ? WS_VCMP : WS_KCMP)), (const h16*)(ws + WS_WC1) + (size_t)(l * 2 + br) * 256 * 2048, 512, 256, 2048}; pg8::StaticOrder So; So.init(512, 256, F.G, (int)blockIdx.x);
                  EpiProj<JOB_Y> E{ws, br}; PH(GY, (pg8::gemm_phase<EpiProj<JOB_Y>, pg8::StaticOrder, true, true>(F.lds, g, So, E))); }
                __syncthreads();
                PH(KMEAN, moba_kmean_phase(F));
                END(base + 1);
            }
            if (IN(base + 2)) { PH(CMP2, nsa_cmp2_phase(F, l)); PH(GATE, moba_gate_phase(F)); PH(SCORE, dsa_score_phase(F)); END(base + 2); }
            if (IN(base + 3)) { PH(CMPSEL, nsa_cmp_select_phase(F)); PH(TOPK, dsa_topk_phase(F)); END(base + 3); }
            if (IN(base + 4)) { PH(MOBA, moba_attn_phase(F)); PH(MLA, mla_attn_phase(F)); PH(NSA, nsa_attn_phase(F)); PH(DSA, dsa_attn_phase(F)); END(base + 4); }
        } else {
            resA = (const h16*)(ws + WS_MO); resB = (const h16*)(ws + WS_WMO) + (size_t)l * DM * 512; resK = 512; resS = 1.0f; lnidx = 2;
            if (IN(base)) {
                pg8::Gemm g{xh, (const h16*)(ws + WS_WMQ) + (size_t)l * 512 * DM, S, 512, DM}; pg8::StaticOrder So; So.init(S, 512, F.G, (int)blockIdx.x);
                EpiProj<JOB_MQ> E{ws, 0};
                PH(GMQ, (pg8::gemm_phase<EpiProj<JOB_MQ>, pg8::StaticOrder, true, true>(F.lds, g, So, E)));
                END(base);
            }
            if (IN(base + 1)) { PH(MEMA, mem_attn_phase(F, l)); END(base + 1); }
        }
        if (IN(base + 5)) {
            pg8::Gemm g{resA, resB, S, DM, resK}; pg8::StaticOrder So; So.init(S, DM, F.G, (int)blockIdx.x);
            EpiResid E{xf, z, resS};
            PH(GRESID, (pg8::gemm_phase<EpiResid, pg8::StaticOrder, true, true>(F.lds, g, So, E)));
            END(base + 5);
        }
        if (IN(base + 6)) {
            const float* g = (const float*)(ws + WS_LNG) + (size_t)(l * 4 + lnidx) * DM; const float* b = (const float*)(ws + WS_LNB) + (size_t)(l * 4 + lnidx) * DM;
            PH(LN, ln_phase(F, z, g, b, sb == 15 ? F.out : (float*)(ws + WS_XF), (h16*)(ws + WS_XH)));
            END(base + 6);
        }
    }
#undef IN
#undef END
}

extern "C" void kernel_launch(void* const* d_in, const int* in_sizes, int n_in, void* d_out, int out_size, void* d_ws, size_t ws_size, hipStream_t stream) {
    static int grid = 0;
    if (grid == 0) {
        if (n_in != 19 || out_size != S * DM || ws_size < WS_END) { fprintf(stderr, "kernel_launch: unexpected shapes (n_in %d, out %d, ws %zu < %zu)\n", n_in, out_size, ws_size, (size_t)WS_END); grid = -1; return; }
        int dev = 0, cus = 0, per_cu = 0;
        if (hipGetDevice(&dev) != hipSuccess || hipDeviceGetAttribute(&cus, hipDeviceAttributeMultiprocessorCount, dev) != hipSuccess) { grid = -1; return; }
        if (hipFuncSetAttribute((const void*)mk_fwd, hipFuncAttributeMaxDynamicSharedMemorySize, LDS_BYTES) != hipSuccess) { fprintf(stderr, "kernel_launch: hipFuncSetAttribute failed\n"); grid = -1; return; }
        if (hipOccupancyMaxActiveBlocksPerMultiprocessor(&per_cu, (const void*)mk_fwd, NTHREADS, LDS_BYTES) != hipSuccess || per_cu < 1) { fprintf(stderr, "kernel_launch: occupancy query says %d\n", per_cu); }
        (void)hipGetLastError();
        grid = cus;
    }
    if (grid < 0) return;
    if (hipMemsetAsync((char*)d_ws + WS_CTL, 0, CTL_BYTES, stream) != hipSuccess) return;
    Args a{};
    for (int i = 0; i < 19; ++i) a.in[i] = (const float*)d_in[i];
    a.out = (float*)d_out; a.ws = (unsigned char*)d_ws;
#if MK_STEP_LAUNCHES
    for (int st = 0; st < NSTEPS; ++st) {
        if (st >= 2) { const int sb = (st - 2) / SLOTS, slot = (st - 2) % SLOTS, kind = sb & 3;
            const bool live = slot >= 5 || slot == 0 || (kind == 1 && slot <= 4) || (kind == 2 && slot == 1);
            if (!live) continue; }
        a.lo = st; a.hi = st + 1;
        hipLaunchKernelGGL(mk_fwd, dim3(grid), dim3(NTHREADS), LDS_BYTES, stream, a);
    }
#else
    a.lo = 0; a.hi = NSTEPS;
    hipLaunchKernelGGL(mk_fwd, dim3(grid), dim3(NTHREADS), LDS_BYTES, stream, a);
#endif
}
```

```cpp
#include <hip/hip_runtime.h>
#include <cstdio>
#include <cstdint>

#ifndef USE_FA
#define USE_FA 1
#endif
#ifndef FA_MASK
#define FA_MASK 0x1f
#endif
#ifndef MK_STEP_LAUNCHES
#define MK_STEP_LAUNCHES 0
#endif

#define GAS __attribute__((address_space(1)))
#define LAS __attribute__((address_space(3)))
typedef _Float16 h16;
typedef _Float16 half8 __attribute__((ext_vector_type(8)));
typedef _Float16 half4 __attribute__((ext_vector_type(4)));
typedef _Float16 half2v __attribute__((ext_vector_type(2)));
typedef float f32x4 __attribute__((ext_vector_type(4)));
typedef float f32x2 __attribute__((ext_vector_type(2)));
typedef unsigned u32x4 __attribute__((ext_vector_type(4)));
typedef unsigned long long u64;

constexpr int S = 8192, DM = 2048, DFF = 5632, DEPTH = 4, MEMLEN = 256;
constexpr int D_IN = 6556, NIN = 6656;
constexpr float LN_EPS = 1e-5f, RMS_EPS = 1e-6f;
constexpr float DN_ALPHA = 1.681792830507429f;
constexpr int NWAVES = 8, NTHREADS = 512;

constexpr size_t al256(size_t x) { return (x + 255) & ~(size_t)255; }
constexpr size_t WS_CTL = 0, CTL_BYTES = 1u << 20;
constexpr size_t WS_WGU  = CTL_BYTES;
constexpr size_t WS_WD   = WS_WGU  + (size_t)DEPTH * 2 * 2 * DFF * DM * 2;
constexpr size_t WS_WIN  = WS_WD   + (size_t)DEPTH * 2 * DM * DFF * 2;
constexpr size_t WS_WOUT = WS_WIN  + (size_t)DEPTH * NIN * DM * 2;
constexpr size_t WS_WUQ  = WS_WOUT + (size_t)DEPTH * DM * DM * 2;
constexpr size_t WS_WUKV = WS_WUQ  + (size_t)DEPTH * 768 * 512 * 2;
constexpr size_t WS_WC1  = WS_WUKV + (size_t)DEPTH * 1024 * 512 * 2;
constexpr size_t WS_WMQ  = WS_WC1  + (size_t)DEPTH * 2 * 256 * 2048 * 2;
constexpr size_t WS_WMKV = WS_WMQ  + (size_t)DEPTH * 512 * DM * 2;
constexpr size_t WS_WMO  = WS_WMKV + (size_t)DEPTH * 1024 * DM * 2;
constexpr size_t WS_XF   = WS_WMO  + (size_t)DEPTH * DM * 512 * 2;
constexpr size_t WS_XH   = WS_XF   + (size_t)S * DM * 4;
constexpr size_t WS_Z    = WS_XH   + (size_t)S * DM * 2;
constexpr size_t WS_HB   = WS_Z    + (size_t)S * DM * 4;
constexpr size_t WS_MEMH = WS_HB   + (size_t)S * DFF * 2;
constexpr size_t WS_MK   = WS_MEMH + (size_t)MEMLEN * DM * 2;
constexpr size_t WS_MV   = WS_MK   + (size_t)DEPTH * 4 * MEMLEN * 128 * 2;
constexpr size_t WS_T128C = WS_MV  + (size_t)DEPTH * 4 * MEMLEN * 128 * 2;
constexpr size_t WS_T128S = WS_T128C + (size_t)S * 64 * 4;
constexpr size_t WS_T64C  = WS_T128S + (size_t)S * 64 * 4;
constexpr size_t WS_T64S  = WS_T64C + (size_t)S * 32 * 4;
constexpr size_t HEADBUF = (size_t)S * 128 * 2;
constexpr size_t WS_AQ   = WS_T64S + (size_t)S * 32 * 4;
constexpr size_t WS_AK   = WS_AQ + 4 * HEADBUF;
constexpr size_t WS_AV   = WS_AK + 4 * HEADBUF;
constexpr size_t WS_BCQ  = WS_AV + 4 * HEADBUF;
constexpr size_t WS_BCKV = WS_BCQ + (size_t)S * 512 * 2;
constexpr size_t WS_BKR  = WS_BCKV + (size_t)S * 512 * 2;
constexpr size_t WS_Q192 = WS_BKR + (size_t)S * 64 * 2;
constexpr size_t WS_KN   = WS_Q192 + (size_t)4 * S * 192 * 2;
constexpr size_t WS_BV   = WS_KN + 4 * HEADBUF;
constexpr size_t WS_CQRAW = WS_BV + 4 * HEADBUF;
constexpr size_t WS_CQROPE = WS_CQRAW + 4 * HEADBUF;
constexpr size_t WS_KCMP = WS_CQROPE + 4 * HEADBUF;
constexpr size_t WS_VCMP = WS_KCMP + HEADBUF;
constexpr size_t WS_KSLC = WS_VCMP + HEADBUF;
constexpr size_t WS_VSLC = WS_KSLC + HEADBUF;
constexpr size_t WS_KWIN = WS_VSLC + HEADBUF;
constexpr size_t WS_VWIN = WS_KWIN + HEADBUF;
constexpr size_t WS_SMALL = WS_VWIN + HEADBUF;
constexpr size_t WS_DQ   = WS_SMALL + (size_t)S * 32 * 4;
constexpr size_t WS_DK   = WS_DQ + 4 * HEADBUF;
constexpr size_t WS_DV   = WS_DK + 4 * HEADBUF;
constexpr size_t WS_IQ   = WS_DV + 4 * HEADBUF;
constexpr size_t WS_IK   = WS_IQ + (size_t)S * 1024 * 2;
constexpr size_t WS_SSQQ = WS_IK + (size_t)S * 64 * 2;
constexpr size_t WS_SSQKV = WS_SSQQ + (size_t)S * 8 * 4;
constexpr size_t WS_YK   = WS_SSQKV + (size_t)S * 8 * 4;
constexpr size_t WS_YV   = WS_YK + (size_t)512 * 256 * 4;
constexpr size_t WS_KC   = WS_YV + (size_t)512 * 256 * 4;
constexpr size_t WS_VC   = WS_KC + (size_t)512 * 128 * 4;
constexpr size_t WS_CBIAS = WS_VC + (size_t)512 * 128 * 4;
constexpr size_t WS_KMEAN = WS_CBIAS + (size_t)DEPTH * 2 * 128 * 4;
constexpr size_t WS_MOBASEL = WS_KMEAN + (size_t)4 * 32 * 128 * 4;
constexpr size_t WS_OCMP = WS_MOBASEL + (size_t)S * 16 * 4;
constexpr size_t WS_NSASEL = WS_OCMP + (size_t)S * 512 * 4;
constexpr size_t WS_NSAMASK = WS_NSASEL + (size_t)S * 16 * 4;
constexpr size_t WS_DSALIST = WS_NSAMASK + (size_t)S * 4 * 4;
constexpr size_t WS_DSAMASK = WS_DSALIST + (size_t)S * 256 * 4;
constexpr size_t WS_OMIX = WS_DSAMASK + (size_t)S * 128 * 8;
constexpr size_t WS_MQ   = WS_OMIX + (size_t)S * DM * 2;
constexpr size_t WS_MO   = WS_MQ + 4 * HEADBUF;
constexpr size_t WS_LNG = WS_MO + (size_t)S * 512 * 2;
constexpr size_t WS_LNB = WS_LNG + (size_t)16 * DM * 4;
constexpr size_t WS_W2C = WS_LNB + (size_t)16 * DM * 4;
constexpr size_t WS_SCORES = al256(WS_W2C + (size_t)8 * 128 * 128 * 4);
constexpr size_t WS_END  = WS_SCORES + (size_t)S * S * 4;

constexpr int CW_TMO = 0, CW_CODE = 1, CW_BAR = 4096;

constexpr int RING_BYTES = 131072;
constexpr int LDSCTL_OFF = RING_BYTES, MISC_OFF = LDSCTL_OFF + 320;
constexpr int LDS_BYTES = 147456;

#define RLX_AGENT __ATOMIC_RELAXED, __HIP_MEMORY_SCOPE_AGENT
#define LDS_WAIT() asm volatile("s_waitcnt lgkmcnt(0)" ::: "memory")
#define VM_WAIT() asm volatile("s_waitcnt vmcnt(0)" ::: "memory")

__device__ const double ROPE_INV[64] = {
1.0, 0.8659643233600653, 0.7498942093324559, 0.6493816315762113,
0.5623413251903491, 0.4869675251658631, 0.4216965034285822, 0.3651741272548377,
0.31622776601683794, 0.27384196342643613, 0.23713737056616552, 0.2053525026457146,
0.1778279410038923, 0.1539926526059492, 0.1333521432163324, 0.11547819846894582,
0.1, 0.08659643233600653, 0.07498942093324558, 0.06493816315762113,
0.05623413251903491, 0.04869675251658631, 0.042169650342858224, 0.03651741272548377,
0.03162277660168379, 0.027384196342643614, 0.023713737056616554, 0.02053525026457146,
0.01778279410038923, 0.01539926526059492, 0.01333521432163324, 0.011547819846894581,
0.01, 0.008659643233600654, 0.007498942093324558, 0.006493816315762113,
0.005623413251903491, 0.004869675251658631, 0.004216965034285823, 0.003651741272548377,
0.0031622776601683794, 0.0027384196342643613, 0.0023713737056616554, 0.002053525026457146,
0.0017782794100389228, 0.001539926526059492, 0.001333521432163324, 0.0011547819846894581,
0.001, 0.0008659643233600654, 0.0007498942093324559, 0.0006493816315762113,
0.0005623413251903491, 0.0004869675251658631, 0.00042169650342858224, 0.0003651741272548377,
0.00031622776601683794, 0.0002738419634264361, 0.00023713737056616554, 0.0002053525026457146,
0.00017782794100389227, 0.0001539926526059492, 0.0001333521432163324, 0.00011547819846894582
};
namespace pg8 {
constexpr int BM = 256, BK = 64, HALF = 128, HTB = HALF * BK * 2, STAGE_BYTES = 8 * HTB, NXCD = 8, WGM = 8;
__host__ __device__ __forceinline__ int lds_byte(int r, int c) { const int st = (r >> 4) * 2 + (c >> 5), rr = r & 15, cc = c & 31, ob = rr * 64 + cc * 2; return st * 1024 + (ob ^ (((ob >> 9) & 1) << 5)); }
__host__ __device__ __forceinline__ void stage_rc(int b, int& R, int& C) { const int st = b / 1024, sb = b % 1024, swz = sb ^ (((sb >> 9) & 1) << 5); R = (st >> 1) * 16 + swz / 64; C = (st & 1) * 32 + (swz % 64) / 2; }
__host__ __device__ __forceinline__ int perm32(int rho) { const int n = rho >> 4, i = rho & 15; return 8 * (i >> 2) + 4 * n + (i & 3); }
struct Unit { int pm, pn; };
struct Gemm { const h16* A; const h16* Bt; int M, N, K; };
struct StaticOrder {
    int nM, nN, nwg, G, c;
    __host__ __device__ void init(int M, int N, int G_, int c_) { nM = M / BM; nN = N / BM; nwg = nM * nN; G = G_; c = c_; }
    __host__ __device__ bool next(int i, Unit& u) const {
        const long L = (long)i * G + c; if (L >= nwg) return false;
        int wgid = (int)L; { const int q = nwg / NXCD, r = nwg % NXCD, xcd = wgid % NXCD, off = wgid / NXCD; wgid = (xcd < r ? xcd * (q + 1) : r * (q + 1) + (xcd - r) * q) + off; }
        const int nig = WGM * nN, gid = wgid / nig, fm = gid * WGM, gsz = (nM - fm) < WGM ? (nM - fm) : WGM;
        u.pm = fm + ((wgid % nig) % gsz); u.pn = (wgid % nig) / gsz; return true;
    }
    __device__ __forceinline__ void a_ready(const Unit&) const {}
    __device__ __forceinline__ void done(const Unit&) const {}
};
template <class Epi, class Sched, bool ALIGN_EPI = false, bool SP2 = false>
__device__ __forceinline__ void gemm_phase(LAS unsigned char* lds, const Gemm g, const Sched& S, const Epi& E) {
    int tid_ = threadIdx.x; asm volatile("" : "+v"(tid_));
    const int tid = tid_, wid = __builtin_amdgcn_readfirstlane(tid >> 6), lane = tid & 63, wr = wid >> 2, wc = wid & 3, fr = lane & 15, fq = lane >> 4;
    const int K = g.K, nt = K / BK;
    unsigned voffA[2], voffB[2];
#pragma unroll
    for (int i = 0; i < 2; ++i) { int R, C; stage_rc(tid * 16 + i * 8192, R, C); const int Rb = Epi::PERM ? ((R & ~31) + perm32(R & 31)) : R;
        voffA[i] = (unsigned)(R * K + C) * 2u; voffB[i] = (unsigned)(Rb * K + C) * 2u; }
    const size_t kstep = (size_t)(BK * 2);
    const size_t hstep = (size_t)HALF * K * 2;
    const size_t tstep = 2 * hstep;
    const unsigned ldsw = (unsigned)wid * 1024u;
    const int aoff = lds_byte(wr * 64 + fr, fq * 8), boff = lds_byte(wc * 32 + fr, fq * 8);
#define PG8_SA(b, h) (((b) * 2 + (h)) * HTB)
#define PG8_SB(b, h) ((4 + (b) * 2 + (h)) * HTB)
#define PG8_STAGE(bufoff, gbase, voff) do { _Pragma("unroll") for (int _i = 0; _i < 2; ++_i) \
        __builtin_amdgcn_global_load_lds((const unsigned*)((const char*)(gbase) + (voff)[_i]), (LAS unsigned*)(lds + (bufoff) + ldsw + _i * 8192), 16, 0, 0); } while (0)
#define PG8_LDA(dst, b, h) do { _Pragma("unroll") for (int m = 0; m < 4; ++m) _Pragma("unroll") for (int k = 0; k < 2; ++k) dst[m][k] = *(const LAS half8*)(lds + PG8_SA(b, h) + aoff + m * 2048 + k * 1024); } while (0)
#define PG8_LDB(dst, b, h) do { _Pragma("unroll") for (int n = 0; n < 2; ++n) _Pragma("unroll") for (int k = 0; k < 2; ++k) dst[n][k] = *(const LAS half8*)(lds + PG8_SB(b, h) + boff + n * 2048 + k * 1024); } while (0)
#define PG8_MMA(ai, bj, At, Bt) do { __builtin_amdgcn_s_setprio(1); _Pragma("unroll") for (int m = 0; m < 4; ++m) _Pragma("unroll") for (int n = 0; n < 2; ++n) _Pragma("unroll") for (int k = 0; k < 2; ++k) \
        acc[ai][bj][m][n] = __builtin_amdgcn_mfma_f32_16x16x32_f16(Bt[n][k], At[m][k], acc[ai][bj][m][n], 0, 0, 0); __builtin_amdgcn_s_setprio(0); } while (0)
#define PG8_WAIT_V(n) asm volatile("s_waitcnt vmcnt(" #n ")" ::: "memory")
#define PG8_WAIT_L(n) asm volatile("s_waitcnt lgkmcnt(" #n ")" ::: "memory")
#define PG8_BAR __builtin_amdgcn_s_barrier()
#define PG8_SCHED __builtin_amdgcn_sched_barrier(0)
    Unit cur, nxt; int ui = 0;
    if (!S.next(0, cur)) return;
    f32x4 acc[2][2][4][2];
#pragma unroll
    for (int a = 0; a < 2; ++a)
#pragma unroll
        for (int b = 0; b < 2; ++b)
#pragma unroll
            for (int m = 0; m < 4; ++m)
#pragma unroll
                for (int n = 0; n < 2; ++n) acc[a][b][m][n] = (f32x4){0.f, 0.f, 0.f, 0.f};
    half8 At[4][2], B0[2][2], B1[2][2];
    const char* cA = (const char*)g.A + (size_t)cur.pm * tstep; const char* cB = (const char*)g.Bt + (size_t)cur.pn * tstep;
    S.a_ready(cur);
    if constexpr (SP2) {
        PG8_STAGE(PG8_SB(0, 0), cB, voffB); PG8_STAGE(PG8_SB(0, 1), cB + hstep, voffB); PG8_STAGE(PG8_SA(0, 0), cA, voffA); PG8_STAGE(PG8_SA(0, 1), cA + hstep, voffA);
        if (wr == 1) PG8_BAR;
        PG8_WAIT_V(2); PG8_BAR;
        PG8_STAGE(PG8_SB(1, 0), cB + kstep, voffB); PG8_STAGE(PG8_SA(1, 0), cA + kstep, voffA); PG8_STAGE(PG8_SB(1, 1), cB + hstep + kstep, voffB);
        PG8_WAIT_V(6); PG8_BAR;
    } else {
        PG8_STAGE(PG8_SB(0, 0), cB, voffB); PG8_STAGE(PG8_SA(0, 0), cA, voffA); PG8_STAGE(PG8_SB(0, 1), cB + hstep, voffB); PG8_STAGE(PG8_SA(0, 1), cA + hstep, voffA);
        if (wr == 1) PG8_BAR;
        PG8_WAIT_V(4); PG8_BAR;
        PG8_STAGE(PG8_SB(1, 0), cB + kstep, voffB); PG8_STAGE(PG8_SA(1, 0), cA + kstep, voffA); PG8_STAGE(PG8_SB(1, 1), cB + hstep + kstep, voffB);
        PG8_WAIT_V(6); PG8_BAR;
    }
    for (;;) {
        const bool has_next = S.next(ui + 1, nxt);
        const char* nA = has_next ? (const char*)g.A + (size_t)nxt.pm * tstep : cA; const char* nB = has_next ? (const char*)g.Bt + (size_t)nxt.pn * tstep : cB;
        for (int t = 0; t < nt; t += 2) {
            const bool last = (t == nt - 2);
            const char* a1 = cA + (size_t)(t + 1) * kstep;
            const char* a2 = last ? nA : cA + (size_t)(t + 2) * kstep; const char* b2 = last ? nB : cB + (size_t)(t + 2) * kstep;
            const char* a3 = a2 + kstep; const char* b3 = b2 + kstep;
            if (last && has_next) S.a_ready(nxt);
            if constexpr (SP2) {
            PG8_LDB(B0, 0, 0); PG8_LDB(B1, 0, 1); PG8_SCHED; PG8_LDA(At, 0, 0); PG8_STAGE(PG8_SA(1, 1), a1 + hstep, voffA);
            PG8_WAIT_V(8); PG8_WAIT_L(0); PG8_BAR; PG8_MMA(0, 0, At, B0); PG8_MMA(0, 1, At, B1); PG8_BAR; PG8_SCHED;
            PG8_LDA(At, 0, 1); PG8_STAGE(PG8_SB(0, 0), b2, voffB); PG8_STAGE(PG8_SB(0, 1), b2 + hstep, voffB); PG8_STAGE(PG8_SA(0, 0), a2, voffA);
            PG8_WAIT_V(8); PG8_WAIT_L(0); PG8_BAR; PG8_MMA(1, 0, At, B0); PG8_MMA(1, 1, At, B1); PG8_BAR; PG8_SCHED;
            PG8_LDB(B0, 1, 0); PG8_LDB(B1, 1, 1); PG8_SCHED; PG8_LDA(At, 1, 0); PG8_STAGE(PG8_SA(0, 1), a2 + hstep, voffA);
            PG8_WAIT_V(8); PG8_WAIT_L(0); PG8_BAR; PG8_MMA(0, 0, At, B0); PG8_MMA(0, 1, At, B1); PG8_BAR; PG8_SCHED;
            PG8_LDA(At, 1, 1); PG8_STAGE(PG8_SB(1, 0), b3, voffB); PG8_STAGE(PG8_SB(1, 1), b3 + hstep, voffB); PG8_STAGE(PG8_SA(1, 0), a3, voffA);
            PG8_WAIT_V(8); PG8_WAIT_L(0); PG8_BAR; PG8_MMA(1, 0, At, B0); PG8_MMA(1, 1, At, B1); PG8_BAR; PG8_SCHED;
            } else {
            PG8_LDB(B0, 0, 0); PG8_SCHED; PG8_LDA(At, 0, 0); PG8_STAGE(PG8_SA(1, 1), a1 + hstep, voffA);
            PG8_WAIT_L(8); PG8_BAR; PG8_WAIT_L(0); PG8_MMA(0, 0, At, B0); PG8_BAR; PG8_SCHED;
            PG8_LDB(B1, 0, 1); PG8_STAGE(PG8_SB(0, 0), b2, voffB);
            PG8_BAR; PG8_WAIT_L(0); PG8_MMA(0, 1, At, B1); PG8_BAR;
            PG8_LDA(At, 0, 1); PG8_STAGE(PG8_SA(0, 0), a2, voffA);
            PG8_BAR; PG8_WAIT_L(0); PG8_MMA(1, 0, At, B0); PG8_BAR; PG8_SCHED;
            PG8_STAGE(PG8_SB(0, 1), b2 + hstep, voffB);
            PG8_WAIT_V(6); PG8_BAR; PG8_MMA(1, 1, At, B1); PG8_BAR;
            PG8_LDB(B0, 1, 0); PG8_SCHED; PG8_LDA(At, 1, 0); PG8_STAGE(PG8_SA(0, 1), a2 + hstep, voffA);
            PG8_WAIT_L(8); PG8_BAR; PG8_WAIT_L(0); PG8_MMA(0, 0, At, B0); PG8_BAR; PG8_SCHED;
            PG8_LDB(B1, 1, 1); PG8_STAGE(PG8_SB(1, 0), b3, voffB);
            PG8_BAR; PG8_WAIT_L(0); PG8_MMA(0, 1, At, B1); PG8_BAR;
            PG8_LDA(At, 1, 1); PG8_STAGE(PG8_SA(1, 0), a3, voffA);
            PG8_BAR; PG8_WAIT_L(0); PG8_MMA(1, 0, At, B0); PG8_BAR; PG8_SCHED;
            PG8_STAGE(PG8_SB(1, 1), b3 + hstep, voffB);
            PG8_WAIT_V(6); PG8_BAR; PG8_MMA(1, 1, At, B1); PG8_BAR;
            }
        }
        if constexpr (ALIGN_EPI) { if (wr == 0) PG8_BAR; }
        if constexpr (!Epi::AFTER_DRAIN) { E(acc, cur, wr, wc, fr, fq); S.done(cur); }
        if (!has_next) break;
#pragma unroll
        for (int a = 0; a < 2; ++a)
#pragma unroll
            for (int b = 0; b < 2; ++b)
#pragma unroll
                for (int m = 0; m < 4; ++m)
#pragma unroll
                    for (int n = 0; n < 2; ++n) acc[a][b][m][n] = (f32x4){0.f, 0.f, 0.f, 0.f};
        cur = nxt; cA = nA; cB = nB; ++ui;
        if constexpr (ALIGN_EPI) { if (wr == 1) PG8_BAR; }
    }
    PG8_WAIT_V(0);
    if constexpr (!ALIGN_EPI) { if (wr == 0) PG8_BAR; }
    PG8_BAR;
    if constexpr (Epi::AFTER_DRAIN) { E.fused(acc, cur, wr, wc, fr, fq, lds, wid, lane); S.done(cur); }
#undef PG8_SA
#undef PG8_SB
#undef PG8_STAGE
#undef PG8_LDA
#undef PG8_LDB
#undef PG8_MMA
#undef PG8_WAIT_V
#undef PG8_WAIT_L
#undef PG8_BAR
#undef PG8_SCHED
}
}
#define XB_TMO      128
#define XB_XCNT(j)  (256  + 64 * (j))
#define XB_XSUB(j)  (1280 + 64 * (j))
#define XB_XGEN(j)  (2304 + 64 * (j))
#define XB_TOP      3328
#define XB_TOPGEN   3392
#define XCD_BAR_WORDS 3456
#define XB_SPIN_CAP (1u << 18)

__device__ __forceinline__ unsigned xb_ld(unsigned* p)              { return __hip_atomic_load(p, __ATOMIC_RELAXED, __HIP_MEMORY_SCOPE_AGENT); }
__device__ __forceinline__ unsigned xb_add(unsigned* p, unsigned v) { return __hip_atomic_fetch_add(p, v, __ATOMIC_RELAXED, __HIP_MEMORY_SCOPE_AGENT); }
__device__ __forceinline__ unsigned xb_xcc_id() { return (unsigned)__builtin_amdgcn_s_getreg((3 << 11) | 20) & 0xFu; }
#define XB_SPIN(cond, bar) do { unsigned _sp = 0; while (cond) { __builtin_amdgcn_s_sleep(1); \
    if ((++_sp & 255u) == 0u) { if (xb_ld(&(bar)[XB_TMO])) break; if (_sp > XB_SPIN_CAP) { atomicAdd(&(bar)[XB_TMO], 1u); break; } } } } while (0)

struct XcdBarrier {
    unsigned* bar; unsigned x;
    volatile LAS unsigned* st;
};

__device__ __forceinline__ XcdBarrier xcd_barrier_post(unsigned* bar, volatile LAS unsigned* st) {
    XcdBarrier b; b.bar = bar; b.x = xb_xcc_id(); b.st = st;
    if (threadIdx.x == 0) (void)xb_add(&bar[XB_XCNT(b.x)], 1u);
    return b;
}
__device__ __forceinline__ void xcd_barrier_complete(unsigned* bar, unsigned x, unsigned& nloc, unsigned& nx) {
    const unsigned G = gridDim.x * gridDim.y * gridDim.z;
    unsigned sum, cnt, mine, sp = 0u;
    for (;;) {
        sum = 0u; cnt = 0u; mine = 0u;
#pragma unroll
        for (unsigned j = 0; j < 16; ++j) { const unsigned c = xb_ld(&bar[XB_XCNT(j)]); sum += c; cnt += (c > 0u) ? 1u : 0u; mine = (j == x) ? c : mine; }
        if (sum == G) break;
        __builtin_amdgcn_s_sleep(1);
        if ((++sp & 255u) == 0u) { if (xb_ld(&bar[XB_TMO])) break; if (sp > XB_SPIN_CAP) { atomicAdd(&bar[XB_TMO], 1u); break; } }
    }
    nloc = mine > 0u ? mine : 1u; nx = cnt > 0u ? cnt : 1u;
}

__device__ __forceinline__ void xcd_barrier(const XcdBarrier& b) {
    asm volatile("s_waitcnt vmcnt(0)" ::: "memory");
    __syncthreads();
    if (threadIdx.x == 0) {
        unsigned* bar = b.bar;
        __builtin_amdgcn_s_waitcnt(0);
        unsigned nloc = b.st[0], nx = b.st[1];
        if (nloc == 0u) { xcd_barrier_complete(bar, b.x, nloc, nx); b.st[0] = nloc; b.st[1] = nx; }
        const unsigned old = xb_add(&bar[XB_XSUB(b.x)], 1u);
        const unsigned gen = old / nloc;
        if (old + 1u == (gen + 1u) * nloc) {
            __builtin_amdgcn_fence(__ATOMIC_RELEASE, "agent");
            asm volatile("s_waitcnt vmcnt(0)" ::: "memory");
            const unsigned og = xb_add(&bar[XB_TOP], 1u);
            const unsigned tg = og / nx;
            if (og + 1u == (tg + 1u) * nx) xb_add(&bar[XB_TOPGEN], 1u);
            else XB_SPIN(xb_ld(&bar[XB_TOPGEN]) == tg, bar);
            __builtin_amdgcn_fence(__ATOMIC_ACQUIRE, "agent");
            xb_add(&bar[XB_XGEN(b.x)], 1u);
            asm volatile("s_waitcnt vmcnt(0)" ::: "memory");
        } else {
            XB_SPIN(xb_ld(&bar[XB_XGEN(b.x)]) == gen, bar);
            __builtin_amdgcn_fence(__ATOMIC_ACQUIRE, "agent");
            asm volatile("s_waitcnt vmcnt(0)" ::: "memory");
        }
    }
    __syncthreads();
}
struct Frame {
    LAS unsigned char* lds;
    volatile LAS unsigned* MISC;
    unsigned* ctl;
    unsigned char* ws;
    int tid, lane, wave;
    int G;
    const float* in[19];
    float* out;
};
enum { IN_X = 0, IN_MEM, IN_POS, IN_LNG, IN_LNB, IN_WGU, IN_WD, IN_WIN, IN_WOUT, IN_GCQ, IN_GCKV, IN_WUQ, IN_WUKV, IN_PE, IN_W1, IN_W2, IN_MWQ, IN_MWKV, IN_MWO };

__device__ __forceinline__ float wave_sum(float v) {
#pragma unroll
    for (int o = 1; o < 64; o <<= 1) v += __shfl_xor(v, o);
    return v;
}
__device__ __forceinline__ float wave_max(float v) {
#pragma unroll
    for (int o = 1; o < 64; o <<= 1) v = fmaxf(v, __shfl_xor(v, o));
    return v;
}
__device__ __forceinline__ half8 pack_h8(f32x4 a, f32x4 b) {
    half8 r; r[0] = (h16)a[0]; r[1] = (h16)a[1]; r[2] = (h16)a[2]; r[3] = (h16)a[3]; r[4] = (h16)b[0]; r[5] = (h16)b[1]; r[6] = (h16)b[2]; r[7] = (h16)b[3]; return r;
}

struct EpiSwiglu {
    static constexpr bool PERM = true, AFTER_DRAIN = false;
    h16* H;
    __device__ __forceinline__ void operator()(const f32x4 (&acc)[2][2][4][2], const pg8::Unit& u, int wr, int wc, int fr, int fq) const {
        const int row0 = u.pm * 256 + wr * 64 + fr, col0 = u.pn * 128 + wc * 32 + 8 * fq;
#pragma unroll
        for (int ai = 0; ai < 2; ++ai)
#pragma unroll
            for (int m = 0; m < 4; ++m) {
                f32x4 o[2];
#pragma unroll
                for (int n = 0; n < 2; ++n)
#pragma unroll
                    for (int j = 0; j < 4; ++j) { const float g = acc[ai][0][m][n][j], uu = acc[ai][1][m][n][j]; o[n][j] = g * __builtin_amdgcn_rcpf(1.0f + __expf(-g)) * uu; }
                *(half8*)(H + (size_t)(row0 + ai * 128 + m * 16) * DFF + col0) = pack_h8(o[0], o[1]);
            }
    }
};
struct EpiResid {
    static constexpr bool PERM = false, AFTER_DRAIN = false;
    const float* xf; float* z; float s;
    __device__ __forceinline__ void operator()(const f32x4 (&acc)[2][2][4][2], const pg8::Unit& u, int wr, int wc, int fr, int fq) const {
        const int row0 = u.pm * 256 + wr * 64 + fr, col0 = u.pn * 256 + wc * 32 + 4 * fq;
#pragma unroll
        for (int ai = 0; ai < 2; ++ai)
#pragma unroll
            for (int m = 0; m < 4; ++m) { const size_t off = (size_t)(row0 + ai * 128 + m * 16) * DM + col0;
#pragma unroll
                for (int bj = 0; bj < 2; ++bj)
#pragma unroll
                    for (int n = 0; n < 2; ++n) { const f32x4 xv = *(const f32x4*)(xf + off + bj * 128 + n * 16); *(f32x4*)(z + off + bj * 128 + n * 16) = xv * DN_ALPHA + acc[ai][bj][m][n] * s; } }
    }
};

enum { JOB_WIN = 0, JOB_UQ, JOB_UKV, JOB_Y, JOB_MQ, JOB_MKV };
struct WaveDst { h16* p0; h16* p1; int ld; int colA, colB; int rope; h16* raw; float* f32p; float* ssq; int ssq_part; bool none; };
template <int JOB> __device__ __forceinline__ WaveDst proj_dst(unsigned char* ws, int t, int wc, int fq, int aux) {
    WaveDst d; d.p0 = nullptr; d.p1 = nullptr; d.ld = 128; d.rope = 0; d.raw = nullptr; d.f32p = nullptr; d.ssq = nullptr; d.ssq_part = 0; d.none = false;
    const int cp = wc * 32 + 8 * fq;
    d.colA = cp & 63; d.colB = cp & 63;
    const int hs = wc >> 1;
    if constexpr (JOB == JOB_WIN) {
        if (t < 11) {
            d.rope = 1; d.colB = d.colA + 64;
            size_t base;
            if (t < 2) base = WS_AQ + (size_t)(2 * t + hs) * HEADBUF;
            else if (t < 4) base = WS_AK + (size_t)(2 * (t - 2) + hs) * HEADBUF;
            else if (t < 6) { base = WS_CQROPE + (size_t)(2 * (t - 4) + hs) * HEADBUF; d.raw = (h16*)(ws + WS_CQRAW + (size_t)(2 * (t - 4) + hs) * HEADBUF); }
            else if (t == 6) base = hs ? WS_KWIN : WS_KSLC;
            else if (t < 9) base = WS_DQ + (size_t)(2 * (t - 7) + hs) * HEADBUF;
            else base = WS_DK + (size_t)(2 * (t - 9) + hs) * HEADBUF;
            d.p0 = d.p1 = (h16*)(ws + base);
        } else if (t < 15) {
            d.rope = 2; d.colA = cp & 31; d.colB = d.colA + 32; d.ld = 1024;
            d.p0 = d.p1 = (h16*)(ws + WS_IQ) + (4 * (t - 11) + wc) * 64;
        } else if (t == 15) {
            d.colA = cp & 31; d.colB = d.colA + 32; d.ld = 64;
            if (wc == 0) { d.rope = 2; d.p0 = d.p1 = (h16*)(ws + WS_BKR); }
            else if (wc == 1) { d.rope = 2; d.p0 = d.p1 = (h16*)(ws + WS_IK); }
            else if (wc == 2) { d.f32p = (float*)(ws + WS_SMALL); d.ld = 32; }
            else d.none = true;
        } else {
            if (t < 18) { const int h0 = 2 * (t - 16); d.p0 = (h16*)(ws + WS_AV + (size_t)h0 * HEADBUF) + 64 * hs; d.p1 = (h16*)(ws + WS_AV + (size_t)(h0 + 1) * HEADBUF) + 64 * hs; }
            else if (t < 20) { d.ld = 512; d.p0 = (h16*)(ws + WS_BCQ) + 256 * (t - 18) + 64 * hs; d.p1 = d.p0 + 128; d.ssq = (float*)(ws + WS_SSQQ); d.ssq_part = (t - 18) * 4 + wc; }
            else if (t < 22) { d.ld = 512; d.p0 = (h16*)(ws + WS_BCKV) + 256 * (t - 20) + 64 * hs; d.p1 = d.p0 + 128; d.ssq = (float*)(ws + WS_SSQKV); d.ssq_part = (t - 20) * 4 + wc; }
            else if (t == 22) { d.p0 = (h16*)(ws + WS_KCMP) + 64 * hs; d.p1 = (h16*)(ws + WS_VCMP) + 64 * hs; }
            else if (t == 23) { d.p0 = (h16*)(ws + WS_VSLC) + 64 * hs; d.p1 = (h16*)(ws + WS_VWIN) + 64 * hs; }
            else { const int h0 = 2 * (t - 24); d.p0 = (h16*)(ws + WS_DV + (size_t)h0 * HEADBUF) + 64 * hs; d.p1 = (h16*)(ws + WS_DV + (size_t)(h0 + 1) * HEADBUF) + 64 * hs; }
        }
    } else if constexpr (JOB == JOB_UQ) {
        d.ld = 192;
        if (t < 2) { d.p0 = (h16*)(ws + WS_Q192) + (size_t)(2 * t) * S * 192 + 64 * hs; d.p1 = (h16*)(ws + WS_Q192) + (size_t)(2 * t + 1) * S * 192 + 64 * hs; }
        else { d.rope = 2; d.colA = cp & 31; d.colB = d.colA + 32; d.p0 = d.p1 = (h16*)(ws + WS_Q192) + (size_t)wc * S * 192 + 128; }
        d.ssq = (float*)(ws + WS_SSQQ);
    } else if constexpr (JOB == JOB_UKV) {
        d.p0 = (h16*)(ws + WS_KN + (size_t)t * HEADBUF) + 64 * hs; d.p1 = (h16*)(ws + WS_BV + (size_t)t * HEADBUF) + 64 * hs;
        d.ssq = (float*)(ws + WS_SSQKV);
    } else if constexpr (JOB == JOB_Y) {
        d.f32p = (float*)(ws + (aux ? WS_YV : WS_YK)); d.ld = 256;
    } else if constexpr (JOB == JOB_MQ) {
        d.p0 = (h16*)(ws + WS_MQ + (size_t)(2 * t) * HEADBUF) + 64 * hs; d.p1 = (h16*)(ws + WS_MQ + (size_t)(2 * t + 1) * HEADBUF) + 64 * hs;
    } else {
        const int layer = t >> 2, tt = t & 3, h0 = 2 * (tt & 1);
        const size_t kb = (tt >> 1) ? WS_MV : WS_MK;
        d.p0 = (h16*)(ws + kb) + (size_t)((layer * 4 + h0) * MEMLEN) * 128 + 64 * hs; d.p1 = (h16*)(ws + kb) + (size_t)((layer * 4 + h0 + 1) * MEMLEN) * 128 + 64 * hs;
    }
    return d;
}
template <int JOB> struct EpiProj {
    static constexpr bool PERM = true, AFTER_DRAIN = false;
    unsigned char* ws; int aux;
    __device__ __forceinline__ void operator()(const f32x4 (&acc)[2][2][4][2], const pg8::Unit& u, int wr, int wc, int fr, int fq) const {
        const WaveDst d = proj_dst<JOB>(ws, u.pn, wc, fq, aux);
        if (d.none) return;
        const int row0 = u.pm * 256 + wr * 64 + fr;
        const float* tc = (const float*)(ws + (d.rope == 1 ? WS_T128C : WS_T64C)); const float* ts = (const float*)(ws + (d.rope == 1 ? WS_T128S : WS_T64S));
        const int tw = d.rope == 1 ? 64 : 32;
#pragma unroll
        for (int ai = 0; ai < 2; ++ai)
#pragma unroll
            for (int m = 0; m < 4; ++m) {
                const int row = row0 + ai * 128 + m * 16;
                f32x4 a0 = acc[ai][0][m][0], a1 = acc[ai][0][m][1], b0 = acc[ai][1][m][0], b1 = acc[ai][1][m][1];
                if constexpr (JOB == JOB_UQ || JOB == JOB_UKV) {
                    const f32x4 s0 = *(const f32x4*)(d.ssq + (size_t)row * 8), s1 = *(const f32x4*)(d.ssq + (size_t)row * 8 + 4);
                    const float ss = ((s0[0] + s0[1]) + (s0[2] + s0[3])) + ((s1[0] + s1[1]) + (s1[2] + s1[3]));
                    const float rs = 1.0f / sqrtf(ss * (1.0f / 512.0f) + RMS_EPS);
                    a0 = a0 * rs; a1 = a1 * rs; b0 = b0 * rs; b1 = b1 * rs;
                }
                if constexpr (JOB == JOB_WIN) {
                    if (d.ssq) {
                        float q = 0.f;
#pragma unroll
                        for (int j = 0; j < 4; ++j) q += a0[j] * a0[j] + a1[j] * a1[j] + b0[j] * b0[j] + b1[j] * b1[j];
                        q += __shfl_xor(q, 16); q += __shfl_xor(q, 32);
                        if (fq == 0) d.ssq[(size_t)row * 8 + d.ssq_part] = q;
                    }
                    if (d.raw) { *(half8*)(d.raw + (size_t)row * 128 + d.colA) = pack_h8(a0, a1); *(half8*)(d.raw + (size_t)row * 128 + d.colB) = pack_h8(b0, b1); }
                }
                if (d.f32p) {
                    if constexpr (JOB == JOB_Y) { float* p = d.f32p + (size_t)row * 256 + wc * 32 + 8 * fq; *(f32x4*)p = a0; *(f32x4*)(p + 4) = a1; *(f32x4*)(p + 128) = b0; *(f32x4*)(p + 132) = b1; }
                    else { float* p = d.f32p + (size_t)row * 32 + d.colA; *(f32x4*)p = a0; *(f32x4*)(p + 4) = a1; }
                    continue;
                }
                if (d.rope) {
                    const size_t ti = (size_t)row * tw + d.colA;
                    const f32x4 c0 = *(const f32x4*)(tc + ti), c1 = *(const f32x4*)(tc + ti + 4), s0 = *(const f32x4*)(ts + ti), s1 = *(const f32x4*)(ts + ti + 4);
                    const f32x4 o0 = a0 * c0 - b0 * s0, o1 = a1 * c1 - b1 * s1, q0 = a0 * s0 + b0 * c0, q1 = a1 * s1 + b1 * c1;
                    a0 = o0; a1 = o1; b0 = q0; b1 = q1;
                }
                *(half8*)(d.p0 + (size_t)row * d.ld + d.colA) = pack_h8(a0, a1);
                *(half8*)(d.p1 + (size_t)row * d.ld + d.colB) = pack_h8(b0, b1);
            }
    }
};
__device__ __forceinline__ int win_map(int np) {
    const int t = np >> 8, c = np & 255;
    if (t < 11) {
        const int slot = (c >> 6) & 1, d = (c & 63) + 64 * (c >> 7);
        int base;
        if (t < 2) base = 0 + 256 * t + 128 * slot;
        else if (t < 4) base = 512 + 256 * (t - 2) + 128 * slot;
        else if (t < 6) base = 2624 + 256 * (t - 4) + 128 * slot;
        else if (t == 6) base = slot ? 3648 : 3392;
        else if (t < 9) base = 3916 + 256 * (t - 7) + 128 * slot;
        else base = 4428 + 256 * (t - 9) + 128 * slot;
        return base + d;
    }
    if (t < 15) { const int head = (c >> 5) & 3, d = (c & 31) + 32 * (c >> 7); return 5452 + 64 * (4 * (t - 11) + head) + d; }
    if (t == 15) {
        const int head = (c >> 5) & 3, half = c >> 7, d = (c & 31) + 32 * half;
        if (head == 0) return 2560 + d;
        if (head == 1) return 6476 + d;
        if (head == 2) { if (half) return -1; if (d < 12) return 3904 + d; if (d < 28) return 6540 + (d - 12); return -1; }
        return -1;
    }
    if (t < 18) return 1024 + 256 * (t - 16) + c;
    if (t < 20) return 1536 + 256 * (t - 18) + c;
    if (t < 22) return 2048 + 256 * (t - 20) + c;
    if (t == 22) return 3136 + c;
    if (t == 23) return c < 128 ? 3520 + c : 3776 + (c - 128);
    return 4940 + 256 * (t - 24) + c;
}
__device__ __forceinline__ int uq_map(int np) {
    const int t = np >> 8, c = np & 255;
    if (t < 2) { const int slot = c >> 6, head = 2 * t + (slot >> 1), d = 64 * (slot & 1) + (c & 63); return head * 192 + d; }
    const int head = (c >> 5) & 3, d = (c & 31) + 32 * (c >> 7); return head * 192 + 128 + d;
}
enum { WK_GU0 = 0, WK_GU1, WK_D0, WK_D1, WK_IN, WK_OUT, WK_UQ, WK_UKV, WK_C1K, WK_C1V, WK_MQ, WK_MKV, WK_MO, WK_N };
struct WJob { const float* W; h16* dst; int K, NP, kind; const float* kscale; };
__device__ __forceinline__ long wsrc(int kind, int k, int np) {
    switch (kind) {
        case WK_GU0: case WK_GU1: { const int pn = np >> 8, c = np & 255; const int col = c < 128 ? 128 * pn + c : DFF + 128 * pn + (c - 128); return (long)k * (2 * DFF) + col; }
        case WK_D0: case WK_D1: return (long)k * DM + np;
        case WK_IN: { const int col = win_map(np); return col < 0 ? -1 : (long)k * D_IN + col; }
        case WK_OUT: return (long)k * DM + np;
        case WK_UQ: return (long)k * 768 + uq_map(np);
        case WK_UKV: return (long)k * 1024 + np;
        case WK_C1K: case WK_C1V: return (long)((np >> 7) * 2048 + k) * 128 + (np & 127);
        case WK_MQ: return (long)k * 512 + np;
        case WK_MKV: return (long)k * 1024 + np;
        default: return (long)k * DM + np;
    }
}
__device__ __forceinline__ void p0_transpose_item(const WJob& J, LAS float* scr, int item, int lane) {
    const int nblk = J.NP / 32, kb = item / nblk, nb = item % nblk, k0 = 64 * kb, n0 = 32 * nb;
#pragma unroll 8
    for (int i = 0; i < 32; ++i) { const int kk = 2 * i + (lane >> 5); const long so = wsrc(J.kind, k0 + kk, n0 + (lane & 31));
        float v = so >= 0 ? J.W[so] : 0.f; if (J.kscale) v *= J.kscale[k0 + kk]; scr[kk * 33 + (lane & 31)] = v; }
    LDS_WAIT(); asm volatile("" ::: "memory");
    const int c = lane & 7;
#pragma unroll
    for (int j = 0; j < 4; ++j) { const int n = (lane >> 3) + 8 * j; const LAS float* s = scr + (8 * c) * 33 + n;
        half8 o; o[0] = (h16)s[0]; o[1] = (h16)s[33]; o[2] = (h16)s[66]; o[3] = (h16)s[99]; o[4] = (h16)s[132]; o[5] = (h16)s[165]; o[6] = (h16)s[198]; o[7] = (h16)s[231];
        *(half8*)(J.dst + (size_t)(n0 + n) * J.K + k0 + 8 * c) = o; }
    LDS_WAIT(); asm volatile("" ::: "memory");
}
constexpr int WK_ITEMS[WK_N] = { 2 * DFF * DM / 2048, 2 * DFF * DM / 2048, DM * DFF / 2048, DM * DFF / 2048, NIN * DM / 2048, DM * DM / 2048, 768 * 512 / 2048, 1024 * 512 / 2048,
                                 256 * 2048 / 2048, 256 * 2048 / 2048, 512 * DM / 2048, 1024 * DM / 2048, DM * 512 / 2048 };
constexpr int wk_items_per_layer() { int s = 0; for (int i = 0; i < WK_N; ++i) s += WK_ITEMS[i]; return s; }
constexpr int IPL = wk_items_per_layer();
__device__ __forceinline__ WJob wjob(Frame& F, int l, int kind) {
    WJob J; J.kind = kind; J.kscale = nullptr;
    unsigned char* ws = F.ws;
    switch (kind) {
        case WK_GU0: case WK_GU1: { const int f = kind - WK_GU0; J.W = F.in[IN_WGU] + (size_t)(l * 2 + f) * DM * 2 * DFF; J.dst = (h16*)(ws + WS_WGU) + (size_t)(l * 2 + f) * 2 * DFF * DM; J.K = DM; J.NP = 2 * DFF; break; }
        case WK_D0: case WK_D1: { const int f = kind - WK_D0; J.W = F.in[IN_WD] + (size_t)(l * 2 + f) * DFF * DM; J.dst = (h16*)(ws + WS_WD) + (size_t)(l * 2 + f) * DM * DFF; J.K = DFF; J.NP = DM; break; }
        case WK_IN: J.W = F.in[IN_WIN] + (size_t)l * DM * D_IN; J.dst = (h16*)(ws + WS_WIN) + (size_t)l * NIN * DM; J.K = DM; J.NP = NIN; break;
        case WK_OUT: J.W = F.in[IN_WOUT] + (size_t)l * DM * DM; J.dst = (h16*)(ws + WS_WOUT) + (size_t)l * DM * DM; J.K = DM; J.NP = DM; break;
        case WK_UQ: J.W = F.in[IN_WUQ] + (size_t)l * 512 * 768; J.dst = (h16*)(ws + WS_WUQ) + (size_t)l * 768 * 512; J.K = 512; J.NP = 768; J.kscale = F.in[IN_GCQ] + l * 512; break;
        case WK_UKV: J.W = F.in[IN_WUKV] + (size_t)l * 512 * 1024; J.dst = (h16*)(ws + WS_WUKV) + (size_t)l * 1024 * 512; J.K = 512; J.NP = 1024; J.kscale = F.in[IN_GCKV] + l * 512; break;
        case WK_C1K: case WK_C1V: { const int i = kind - WK_C1K; J.W = F.in[IN_W1] + (size_t)(l * 2 + i) * 4096 * 128; J.dst = (h16*)(ws + WS_WC1) + (size_t)(l * 2 + i) * 256 * 2048; J.K = 2048; J.NP = 256; break; }
        case WK_MQ: J.W = F.in[IN_MWQ] + (size_t)l * DM * 512; J.dst = (h16*)(ws + WS_WMQ) + (size_t)l * 512 * DM; J.K = DM; J.NP = 512; break;
        case WK_MKV: J.W = F.in[IN_MWKV] + (size_t)l * DM * 1024; J.dst = (h16*)(ws + WS_WMKV) + (size_t)l * 1024 * DM; J.K = DM; J.NP = 1024; break;
        default: J.W = F.in[IN_MWO] + (size_t)l * 512 * DM; J.dst = (h16*)(ws + WS_WMO) + (size_t)l * DM * 512; J.K = 512; J.NP = DM; break;
    }
    return J;
}
__device__ __forceinline__ void sincos_d(double a, float& sn, float& cs) {
    const double k = __builtin_rint(a * 0.63661977236758134308);
    double r = __builtin_fma(-k, 1.57079632679489655800e+00, a); r = __builtin_fma(-k, 6.12323399573676603587e-17, r);
    const double r2 = r * r;
    double s = -1.0 / 1307674368000.0; s = s * r2 + 1.0 / 6227020800.0; s = s * r2 - 1.0 / 39916800.0; s = s * r2 + 1.0 / 362880.0; s = s * r2 - 1.0 / 5040.0; s = s * r2 + 1.0 / 120.0; s = s * r2 - 1.0 / 6.0; s = s * r2 * r + r;
    double c = 1.0 / 20922789888000.0; c = c * r2 - 1.0 / 87178291200.0; c = c * r2 + 1.0 / 479001600.0; c = c * r2 - 1.0 / 3628800.0; c = c * r2 + 1.0 / 40320.0; c = c * r2 - 1.0 / 720.0; c = c * r2 + 1.0 / 24.0; c = c * r2 - 0.5; c = c * r2 + 1.0;
    const int q = ((int)k) & 3;
    const double ss = (q == 0) ? s : (q == 1) ? c : (q == 2) ? -s : -c;
    const double cc = (q == 0) ? c : (q == 1) ? -s : (q == 2) ? -c : s;
    sn = (float)ss; cs = (float)cc;
}
__device__ __forceinline__ void p0_prologue(Frame& F) { int lane = F.lane; asm volatile("" : "+v"(lane));
    LAS float* scr = (LAS float*)(F.lds + F.wave * 16384);
    const int gw = blockIdx.x * NWAVES + F.wave, NGW = F.G * NWAVES;
    for (int it = gw; it < DEPTH * IPL; it += NGW) {
        const int l = it / IPL; int r = it % IPL; int kind = 0;
#pragma unroll
        for (int k = 0; k < WK_N; ++k) { if (kind == k && r >= WK_ITEMS[k]) { r -= WK_ITEMS[k]; kind = k + 1; } }
        const WJob J = wjob(F, l, kind);
        p0_transpose_item(J, scr, r, lane);
    }
    const int* pos = (const int*)F.in[IN_POS];
    for (int m = gw; m < S; m += NGW) {
        const f32x4* xr = (const f32x4*)(F.in[IN_X] + (size_t)m * DM) + lane;
        f32x4* xo = (f32x4*)((float*)(F.ws + WS_XF) + (size_t)m * DM) + lane;
        half4* xh = (half4*)((h16*)(F.ws + WS_XH) + (size_t)m * DM) + lane;
#pragma unroll
        for (int j = 0; j < 8; ++j) { const f32x4 v = xr[64 * j]; xo[64 * j] = v; half4 h; h[0] = (h16)v[0]; h[1] = (h16)v[1]; h[2] = (h16)v[2]; h[3] = (h16)v[3]; xh[64 * j] = h; }
        const double p = (double)pos[m];
        float sn, cs; sincos_d(p * ROPE_INV[lane], sn, cs);
        ((float*)(F.ws + WS_T128C))[(size_t)m * 64 + lane] = cs; ((float*)(F.ws + WS_T128S))[(size_t)m * 64 + lane] = sn;
        if ((lane & 1) == 0) { ((float*)(F.ws + WS_T64C))[(size_t)m * 32 + (lane >> 1)] = cs; ((float*)(F.ws + WS_T64S))[(size_t)m * 32 + (lane >> 1)] = sn; }
    }
    for (int m = gw; m < MEMLEN; m += NGW) {
        const f32x4* xr = (const f32x4*)(F.in[IN_MEM] + (size_t)m * DM) + lane;
        half4* xh = (half4*)((h16*)(F.ws + WS_MEMH) + (size_t)m * DM) + lane;
#pragma unroll
        for (int j = 0; j < 8; ++j) { const f32x4 v = xr[64 * j]; half4 h; h[0] = (h16)v[0]; h[1] = (h16)v[1]; h[2] = (h16)v[2]; h[3] = (h16)v[3]; xh[64 * j] = h; }
    }
    for (int i = gw * 64 + lane; i < 16 * DM; i += NGW * 64) { ((float*)(F.ws + WS_LNG))[i] = F.in[IN_LNG][i]; ((float*)(F.ws + WS_LNB))[i] = F.in[IN_LNB][i]; }
    for (int i = gw * 64 + lane; i < 8 * 128 * 128; i += NGW * 64) ((float*)(F.ws + WS_W2C))[i] = F.in[IN_W2][i];
    for (int it = gw; it < DEPTH * 2 * 8; it += NGW) {
        const int li = it >> 3, n = (it & 7) * 16 + (lane & 15), kq = lane >> 4;
        const float* pe = F.in[IN_PE] + (size_t)li * 4096; const float* w1 = F.in[IN_W1] + (size_t)li * 4096 * 128;
        float a = 0.f;
        for (int k = kq; k < 4096; k += 4) a += pe[k] * w1[(size_t)k * 128 + n];
        a += __shfl_xor(a, 16); a += __shfl_xor(a, 32);
        if (kq == 0) ((float*)(F.ws + WS_CBIAS))[li * 128 + n] = a;
    }
}
__device__ __forceinline__ void ln_phase(Frame& F, const float* z, const float* g, const float* b, float* of, h16* oh) { int lane = F.lane; asm volatile("" : "+v"(lane));
    const int gw = blockIdx.x * NWAVES + F.wave, NGW = F.G * NWAVES;
    f32x4 gv[8], bv[8];
#pragma unroll
    for (int j = 0; j < 8; ++j) { gv[j] = ((const f32x4*)g)[lane + 64 * j]; bv[j] = ((const f32x4*)b)[lane + 64 * j]; }
    for (int m = gw; m < S; m += NGW) {
        const f32x4* zr = (const f32x4*)(z + (size_t)m * DM) + lane;
        f32x4 v[8]; float s = 0.f;
#pragma unroll
        for (int j = 0; j < 8; ++j) { v[j] = zr[64 * j]; s += (v[j][0] + v[j][1]) + (v[j][2] + v[j][3]); }
        const float mean = wave_sum(s) * (1.f / DM); float s2 = 0.f;
#pragma unroll
        for (int j = 0; j < 8; ++j) { v[j] = v[j] - mean; s2 += (v[j][0] * v[j][0] + v[j][1] * v[j][1]) + (v[j][2] * v[j][2] + v[j][3] * v[j][3]); }
        const float rstd = 1.f / sqrtf(wave_sum(s2) * (1.f / DM) + LN_EPS);
        f32x4* orow = (f32x4*)(of + (size_t)m * DM) + lane; half4* hrow = (half4*)(oh + (size_t)m * DM) + lane;
#pragma unroll
        for (int j = 0; j < 8; ++j) { const f32x4 o = v[j] * rstd * gv[j] + bv[j]; orow[64 * j] = o; half4 h; h[0] = (h16)o[0]; h[1] = (h16)o[1]; h[2] = (h16)o[2]; h[3] = (h16)o[3]; hrow[64 * j] = h; }
    }
}
struct AttnAcc { float m, l, o0, o1; };
__device__ __forceinline__ void attn_init(AttnAcc& a) { a.m = -1e30f; a.l = 0.f; a.o0 = 0.f; a.o1 = 0.f; }
__device__ __forceinline__ float dot_h(const LAS float* qs, const h16* krow, int n16) {
    float acc = 0.f;
#pragma unroll 4
    for (int j = 0; j < n16; ++j) { const half8 w = *(const half8*)(krow + 8 * j); const f32x4 qa = *(const LAS f32x4*)(qs + 8 * j), qb = *(const LAS f32x4*)(qs + 8 * j + 4);
        acc += (float)w[0] * qa[0] + (float)w[1] * qa[1] + (float)w[2] * qa[2] + (float)w[3] * qa[3] + (float)w[4] * qb[0] + (float)w[5] * qb[1] + (float)w[6] * qb[2] + (float)w[7] * qb[3]; }
    return acc;
}
__device__ __forceinline__ void attn_chunk(AttnAcc& a, int key, float logit, const h16* V, int ldv, int lane) {
    const bool valid = key >= 0;
    const float lg = valid ? logit : -__builtin_inff();
    const float cmax = wave_max(lg);
    if (cmax == -__builtin_inff()) return;
    const float mn = fmaxf(a.m, cmax), alpha = __expf(a.m - mn);
    const float p = valid ? __expf(lg - mn) : 0.f;
    a.l = a.l * alpha + wave_sum(p); a.o0 *= alpha; a.o1 *= alpha; a.m = mn;
    u64 mask = __ballot(valid);
    while (mask) { const int j = __builtin_ctzll(mask); mask &= mask - 1;
        const float pj = __builtin_bit_cast(float, __builtin_amdgcn_readlane(__builtin_bit_cast(int, p), j)); const int kj = __builtin_amdgcn_readlane(key, j);
        const half2v v = *(const half2v*)(V + (size_t)kj * ldv + 2 * lane);
        a.o0 += pj * (float)v[0]; a.o1 += pj * (float)v[1]; }
}
__device__ __forceinline__ void load_q(LAS float* qs, const h16* q, int nd, int lane) {
    for (int i = lane; i < nd / 2; i += 64) { const half2v v = *(const half2v*)(q + 2 * i); qs[2 * i] = (float)v[0]; qs[2 * i + 1] = (float)v[1]; }
    LDS_WAIT(); asm volatile("" ::: "memory");
}
__device__ __forceinline__ void store_o(h16* dst, const AttnAcc& a, int lane) {
    const float inv = a.l > 0.f ? 1.0f / a.l : 0.f; half2v o; o[0] = (h16)(a.o0 * inv); o[1] = (h16)(a.o1 * inv); *(half2v*)(dst + 2 * lane) = o;
}
#define WAVE_ITEMS(it, total) for (int it = blockIdx.x * NWAVES + F.wave; it < (total); it += F.G * NWAVES)
constexpr float SC128 = 0.08838834764831845f, SC192 = 0.07216878364870323f;

__device__ __forceinline__ void moba_kmean_phase(Frame& F) { int lane = F.lane; asm volatile("" : "+v"(lane));
    WAVE_ITEMS(it, 4 * 32) { const int h = it >> 5, n = it & 31; const h16* k = (const h16*)(F.ws + WS_AK + (size_t)h * HEADBUF) + (size_t)n * 256 * 128 + 2 * lane;
        float s0 = 0.f, s1 = 0.f;
        for (int r = 0; r < 256; ++r) { const half2v v = *(const half2v*)(k + (size_t)r * 128); s0 += (float)v[0]; s1 += (float)v[1]; }
        float* o = (float*)(F.ws + WS_KMEAN) + (size_t)it * 128 + 2 * lane; o[0] = s0 * (1.f / 256.f); o[1] = s1 * (1.f / 256.f); }
}
__device__ __forceinline__ float gelu_tanh(float x) { const float u = 0.7978845608028654f * (x + 0.044715f * x * x * x); return 0.5f * x * (1.0f + tanhf(u)); }
__device__ __forceinline__ void nsa_cmp2_phase(Frame& F, int l) { int lane = F.lane; asm volatile("" : "+v"(lane));
    LAS float* hs = (LAS float*)(F.lds + F.wave * 16384);
    WAVE_ITEMS(it, 2 * 511) { const int br = it / 511, i = it % 511;
        const float* Y = (const float*)(F.ws + (br ? WS_YV : WS_YK)); const float* cb = (const float*)(F.ws + WS_CBIAS) + (l * 2 + br) * 128;
        const float* w2 = (const float*)(F.ws + WS_W2C) + (size_t)(l * 2 + br) * 128 * 128;
#pragma unroll
        for (int e = 0; e < 2; ++e) { const int n = lane + 64 * e; hs[n] = gelu_tanh(Y[(size_t)i * 256 + n] + Y[(size_t)(i + 1) * 256 + 128 + n] + cb[n]); }
        LDS_WAIT(); asm volatile("" ::: "memory");
        float o0 = 0.f, o1 = 0.f;
        for (int k = 0; k < 128; ++k) { const float hv = hs[k]; o0 += hv * w2[k * 128 + lane]; o1 += hv * w2[k * 128 + 64 + lane]; }
        float* o = (float*)(F.ws + (br ? WS_VC : WS_KC)) + (size_t)i * 128; o[lane] = o0; o[64 + lane] = o1;
        LDS_WAIT(); asm volatile("" ::: "memory"); }
}
__device__ __forceinline__ void moba_gate_phase(Frame& F) { int lane = F.lane; asm volatile("" : "+v"(lane));
    WAVE_ITEMS(it, S * 4) { const int t = it >> 2, h = it & 3, cur = t >> 8;
        int* sel = (int*)(F.ws + WS_MOBASEL) + (size_t)t * 16 + h * 4;
        const int n = lane & 31; float g = -__builtin_inff();
        if (n < cur) { const h16* q = (const h16*)(F.ws + WS_AQ + (size_t)h * HEADBUF) + (size_t)t * 128; const float* km = (const float*)(F.ws + WS_KMEAN) + (size_t)(h * 32 + n) * 128;
            float a = 0.f;
            for (int d = 0; d < 128; d += 8) { const half8 qv = *(const half8*)(q + d); const f32x4 k0 = *(const f32x4*)(km + d), k1 = *(const f32x4*)(km + d + 4);
                a += (float)qv[0] * k0[0] + (float)qv[1] * k0[1] + (float)qv[2] * k0[2] + (float)qv[3] * k0[3] + (float)qv[4] * k1[0] + (float)qv[5] * k1[1] + (float)qv[6] * k1[2] + (float)qv[7] * k1[3]; }
            g = a; }
        if (lane >= 32) g = -__builtin_inff();
#pragma unroll
        for (int r = 0; r < 3; ++r) { const float mx = wave_max(g); int idx = -1;
            if (mx > -__builtin_inff()) { const u64 bm = __ballot(g == mx); idx = __builtin_ctzll(bm); if (lane == idx) g = -__builtin_inff(); }
            if (lane == 0) sel[r] = idx; }
    }
}
__device__ __forceinline__ void dsa_score_phase(Frame& F) { int lane = F.lane; asm volatile("" : "+v"(lane));
    LAS float* qs = (LAS float*)(F.lds + F.wave * 16384);
    WAVE_ITEMS(t, S) {
        const h16* iq = (const h16*)(F.ws + WS_IQ) + (size_t)t * 1024;
#pragma unroll
        for (int e = 0; e < 2; ++e) { const half8 v = *(const half8*)(iq + (lane + 64 * e) * 8);
#pragma unroll
            for (int j = 0; j < 8; ++j) qs[(lane + 64 * e) * 8 + j] = (float)v[j]; }
        if (lane < 16) qs[1024 + lane] = ((const float*)(F.ws + WS_SMALL))[(size_t)t * 32 + 12 + lane] * (0.25f * 0.125f);
        LDS_WAIT(); asm volatile("" ::: "memory");
        float* sc = (float*)(F.ws + WS_SCORES) + (size_t)t * S;
        for (int c = 0; c * 64 <= t; ++c) { const int s = c * 64 + lane; const h16* ik = (const h16*)(F.ws + WS_IK) + (size_t)s * 64;
            float kv[64];
#pragma unroll
            for (int j = 0; j < 8; ++j) { const half8 v = *(const half8*)(ik + 8 * j);
#pragma unroll
                for (int e = 0; e < 8; ++e) kv[8 * j + e] = (float)v[e]; }
            float score = 0.f;
#pragma unroll 1
            for (int h = 0; h < 16; ++h) { float a = 0.f; const LAS float* qh = qs + h * 64;
#pragma unroll
                for (int d = 0; d < 64; d += 4) { const f32x4 q4 = *(const LAS f32x4*)(qh + d); a += q4[0] * kv[d] + q4[1] * kv[d + 1] + q4[2] * kv[d + 2] + q4[3] * kv[d + 3]; }
                score += qs[1024 + h] * fmaxf(a, 0.f); }
            sc[s] = score; }
        LDS_WAIT(); asm volatile("" ::: "memory");
    }
}
__device__ __forceinline__ void nsa_cmp_select_phase(Frame& F) { int lane = F.lane; asm volatile("" : "+v"(lane));
    LAS float* qs = (LAS float*)(F.lds + F.wave * 16384);
    LAS float* pp = qs + 256;
    const float* kc = (const float*)(F.ws + WS_KC); const float* vc = (const float*)(F.ws + WS_VC);
    WAVE_ITEMS(t, S) {
        const int nvis = t >= 31 ? ((t - 31) >> 4) + 1 : 0;
        float P[8];
#pragma unroll
        for (int c = 0; c < 8; ++c) P[c] = 0.f;
        for (int h = 0; h < 4; ++h) {
            load_q(qs, (const h16*)(F.ws + WS_CQRAW + (size_t)h * HEADBUF) + (size_t)t * 128, 128, lane);
            float lg[8]; float mx = -__builtin_inff();
#pragma unroll
            for (int c = 0; c < 8; ++c) { const int n = c * 64 + lane; lg[c] = -__builtin_inff();
                if (c * 64 < nvis) { const bool ok = n < nvis; const float* kr = kc + (size_t)(ok ? n : 0) * 128; float a = 0.f;
#pragma unroll 4
                    for (int d = 0; d < 128; d += 4) { const f32x4 k4 = *(const f32x4*)(kr + d); const f32x4 q4 = *(const LAS f32x4*)(qs + d); a += k4[0] * q4[0] + k4[1] * q4[1] + k4[2] * q4[2] + k4[3] * q4[3]; }
                    if (ok) lg[c] = a * SC128; }
                mx = fmaxf(mx, lg[c]); }
            mx = wave_max(mx);
            float o0 = 0.f, o1 = 0.f;
            if (nvis > 0) {
                float p[8]; float sum = 0.f;
#pragma unroll
                for (int c = 0; c < 8; ++c) { p[c] = lg[c] > -__builtin_inff() ? __expf(lg[c] - mx) : 0.f; sum += p[c]; }
                sum = wave_sum(sum); const float inv = 1.0f / sum;
#pragma unroll
                for (int c = 0; c < 8; ++c) { p[c] *= inv; P[c] += p[c];
                    if (c * 64 < nvis) { const int lim = min(64, nvis - c * 64);
                        for (int j = 0; j < lim; ++j) { const float pj = __builtin_bit_cast(float, __builtin_amdgcn_readlane(__builtin_bit_cast(int, p[c]), j)); const float* vr = vc + (size_t)(c * 64 + j) * 128;
                            o0 += pj * vr[lane]; o1 += pj * vr[64 + lane]; } } }
            }
            float* oc = (float*)(F.ws + WS_OCMP) + ((size_t)t * 4 + h) * 128; oc[lane] = o0; oc[64 + lane] = o1;
            LDS_WAIT(); asm volatile("" ::: "memory");
        }
#pragma unroll
        for (int c = 0; c < 8; ++c) { const int n = c * 64 + lane; if (n < 511) pp[n + 1] = P[c]; }
        if (lane == 0) { pp[0] = 0.f; pp[512] = 0.f; }
        LDS_WAIT(); asm volatile("" ::: "memory");
        const int cur = t >> 6;
        float v0, v1;
        { const int b = lane; float im = 0.f;
#pragma unroll
          for (int r = 0; r < 5; ++r) im += pp[4 * b + r];
          v0 = (b > cur) ? -__builtin_inff() : ((b == 0 || b == cur || b == cur - 1) ? __builtin_inff() : im); }
        { const int b = lane + 64; float im = 0.f;
#pragma unroll
          for (int r = 0; r < 5; ++r) im += pp[4 * b + r];
          v1 = (b > cur) ? -__builtin_inff() : ((b == cur || b == cur - 1) ? __builtin_inff() : im); }
        int* sel = (int*)(F.ws + WS_NSASEL) + (size_t)t * 16; unsigned m0 = 0, m1 = 0, m2 = 0, m3 = 0;
        for (int r = 0; r < 16; ++r) { const float mx = wave_max(fmaxf(v0, v1)); int idx = -1;
            if (mx > -__builtin_inff()) { const u64 b0 = __ballot(v0 == mx), b1 = __ballot(v1 == mx);
                idx = b0 ? __builtin_ctzll(b0) : 64 + __builtin_ctzll(b1);
                if (idx < 64) { if (lane == idx) v0 = -__builtin_inff(); } else { if (lane == idx - 64) v1 = -__builtin_inff(); }
                if (idx < 32) m0 |= 1u << idx; else if (idx < 64) m1 |= 1u << (idx - 32); else if (idx < 96) m2 |= 1u << (idx - 64); else m3 |= 1u << (idx - 96); }
            if (lane == 0) sel[r] = idx; }
        if (lane == 0) { unsigned* mk = (unsigned*)(F.ws + WS_NSAMASK) + (size_t)t * 4; mk[0] = m0; mk[1] = m1; mk[2] = m2; mk[3] = m3; }
        LDS_WAIT(); asm volatile("" ::: "memory");
    }
}
__device__ __forceinline__ unsigned f2key(float f) { const unsigned u = __builtin_bit_cast(unsigned, f); return (u & 0x80000000u) ? ~u : (u | 0x80000000u); }
__device__ __forceinline__ int wave_sum_i(int v) {
#pragma unroll
    for (int o = 1; o < 64; o <<= 1) v += __shfl_xor(v, o);
    return v;
}
__device__ __forceinline__ void dsa_topk_phase(Frame& F) { int lane = F.lane; asm volatile("" : "+v"(lane));
    WAVE_ITEMS(t, S) {
        asm volatile("" : "+v"(lane));
        const float* sc = (const float*)(F.ws + WS_SCORES) + (size_t)t * S + lane;
        int* list = (int*)(F.ws + WS_DSALIST) + (size_t)t * 256; u64* bm = (u64*)(F.ws + WS_DSAMASK) + (size_t)t * 128;
        unsigned u[128];
#pragma unroll
        for (int c = 0; c < 128; ++c) { u[c] = 0u; if (c * 64 <= t) { const bool ok = lane <= t - c * 64; const float v = ok ? sc[c * 64] : 0.f; u[c] = ok ? f2key(v) : 0u; } }
        unsigned T = 0u; int need_eq = 0;
        if (t >= 256) {
            for (int b = 31; b >= 0; --b) { const unsigned cand = T | (1u << b); int cnt = 0;
#pragma unroll
                for (int c = 0; c < 128; ++c) cnt += (u[c] >= cand) ? 1 : 0;
                cnt = wave_sum_i(cnt);
                if (cnt >= 256) T = cand; }
            int gt = 0;
#pragma unroll
            for (int c = 0; c < 128; ++c) gt += (u[c] > T) ? 1 : 0;
            need_eq = 256 - wave_sum_i(gt);
        } else T = 1u;
        int base = 0;
#pragma unroll
        for (int c = 0; c < 128; ++c) {
            bool selv = u[c] > T;
            if (need_eq > 0) { const u64 eq = __ballot(u[c] == T);
                if (eq) { const int rank = __builtin_popcountll(eq & ((1ull << lane) - 1ull)); selv = selv || (u[c] == T && rank < need_eq); need_eq -= min(need_eq, (int)__builtin_popcountll(eq)); } }
            const u64 sm = __ballot(selv);
            if (lane == 0) bm[c] = sm;
            if (selv) list[base + __builtin_popcountll(sm & ((1ull << lane) - 1ull))] = c * 64 + lane;
            base += __builtin_popcountll(sm);
            __builtin_amdgcn_sched_barrier(0);
        }
        for (int i = base + lane; i < 256; i += 64) list[i] = -1;
    }
}
__device__ __forceinline__ void moba_attn_phase(Frame& F) { int lane = F.lane; asm volatile("" : "+v"(lane));
    LAS float* qs = (LAS float*)(F.lds + F.wave * 16384);
    WAVE_ITEMS(it, S * 4) { const int t = it >> 2, h = it & 3, cur = t >> 8;
        const h16* K = (const h16*)(F.ws + WS_AK + (size_t)h * HEADBUF); const h16* V = (const h16*)(F.ws + WS_AV + (size_t)h * HEADBUF);
        load_q(qs, (const h16*)(F.ws + WS_AQ + (size_t)h * HEADBUF) + (size_t)t * 128, 128, lane);
        const int* sel = (const int*)(F.ws + WS_MOBASEL) + (size_t)t * 16 + h * 4;
        AttnAcc a; attn_init(a);
        for (int bi = 0; bi < 4; ++bi) { const int blk = bi == 0 ? cur : sel[bi - 1]; if (blk < 0) continue;
            for (int c = 0; c < 4; ++c) { const int s = blk * 256 + c * 64 + lane; const int key = (s <= t) ? s : -1;
                if (blk * 256 + c * 64 > t) break;
                const float lg = dot_h(qs, K + (size_t)(key < 0 ? 0 : key) * 128, 16) * SC128;
                attn_chunk(a, key, lg, V, 128, lane); } }
        store_o((h16*)(F.ws + WS_OMIX) + (size_t)t * DM + h * 128, a, lane);
        LDS_WAIT(); asm volatile("" ::: "memory"); }
}
__device__ __forceinline__ void mla_attn_phase(Frame& F) { int lane = F.lane; asm volatile("" : "+v"(lane));
    LAS float* qs = (LAS float*)(F.lds + F.wave * 16384);
    WAVE_ITEMS(it, S * 4) { const int t = it >> 2, h = it & 3;
        const h16* K = (const h16*)(F.ws + WS_KN + (size_t)h * HEADBUF); const h16* KR = (const h16*)(F.ws + WS_BKR); const h16* V = (const h16*)(F.ws + WS_BV + (size_t)h * HEADBUF);
        load_q(qs, (const h16*)(F.ws + WS_Q192) + ((size_t)h * S + t) * 192, 192, lane);
        AttnAcc a; attn_init(a);
        for (int c = 0; c * 64 <= t; ++c) { const int s = c * 64 + lane; const int key = (s <= t) ? s : -1; const int ks = key < 0 ? 0 : key;
            const float lg = (dot_h(qs, K + (size_t)ks * 128, 16) + dot_h(qs + 128, KR + (size_t)ks * 64, 8)) * SC192;
            attn_chunk(a, key, lg, V, 128, lane); }
        store_o((h16*)(F.ws + WS_OMIX) + (size_t)t * DM + 512 + h * 128, a, lane);
        LDS_WAIT(); asm volatile("" ::: "memory"); }
}
__device__ __forceinline__ void nsa_attn_phase(Frame& F) { int lane = F.lane; asm volatile("" : "+v"(lane));
    LAS float* qs = (LAS float*)(F.lds + F.wave * 16384);
    WAVE_ITEMS(it, S * 4) { const int t = it >> 2, h = it & 3, cur = t >> 6;
        load_q(qs, (const h16*)(F.ws + WS_CQROPE + (size_t)h * HEADBUF) + (size_t)t * 128, 128, lane);
        const h16* KS = (const h16*)(F.ws + WS_KSLC); const h16* VS = (const h16*)(F.ws + WS_VSLC); const h16* KW = (const h16*)(F.ws + WS_KWIN); const h16* VW = (const h16*)(F.ws + WS_VWIN);
        const int* sel = (const int*)(F.ws + WS_NSASEL) + (size_t)t * 16;
        AttnAcc a; attn_init(a);
        for (int r = 0; r < 16; ++r) { const int blk = sel[r]; if (blk < 0 || blk > cur) continue;
            const int s = blk * 64 + lane; const int key = (s <= t) ? s : -1;
            const float lg = dot_h(qs, KS + (size_t)(key < 0 ? 0 : key) * 128, 16) * SC128;
            attn_chunk(a, key, lg, VS, 128, lane); }
        AttnAcc w; attn_init(w);
        const int lo = t >= 511 ? t - 511 : 0;
        for (int c = lo >> 6; c * 64 <= t; ++c) { const int s = c * 64 + lane; const int key = (s <= t && s >= lo) ? s : -1;
            const float lg = dot_h(qs, KW + (size_t)(key < 0 ? 0 : key) * 128, 16) * SC128;
            attn_chunk(w, key, lg, VW, 128, lane); }
        const float* gl = (const float*)(F.ws + WS_SMALL) + (size_t)t * 32 + h * 3;
        const float g0 = 1.0f / (1.0f + __expf(-gl[0])), g1 = 1.0f / (1.0f + __expf(-gl[1])), g2 = 1.0f / (1.0f + __expf(-gl[2]));
        const float* oc = (const float*)(F.ws + WS_OCMP) + ((size_t)t * 4 + h) * 128 + 2 * lane;
        const float ia = a.l > 0.f ? 1.0f / a.l : 0.f, iw = w.l > 0.f ? 1.0f / w.l : 0.f;
        half2v o; o[0] = (h16)(g0 * oc[0] + g1 * a.o0 * ia + g2 * w.o0 * iw); o[1] = (h16)(g0 * oc[1] + g1 * a.o1 * ia + g2 * w.o1 * iw);
        *(half2v*)((h16*)(F.ws + WS_OMIX) + (size_t)t * DM + 1024 + h * 128 + 2 * lane) = o;
        LDS_WAIT(); asm volatile("" ::: "memory"); }
}
__device__ __forceinline__ void dsa_attn_phase(Frame& F) { int lane = F.lane; asm volatile("" : "+v"(lane));
    LAS float* qs = (LAS float*)(F.lds + F.wave * 16384);
    WAVE_ITEMS(it, S * 4) { const int t = it >> 2, h = it & 3;
        const h16* K = (const h16*)(F.ws + WS_DK + (size_t)h * HEADBUF); const h16* V = (const h16*)(F.ws + WS_DV + (size_t)h * HEADBUF);
        load_q(qs, (const h16*)(F.ws + WS_DQ + (size_t)h * HEADBUF) + (size_t)t * 128, 128, lane);
        const int* list = (const int*)(F.ws + WS_DSALIST) + (size_t)t * 256;
        AttnAcc a; attn_init(a);
        for (int c = 0; c < 4; ++c) { int key = list[c * 64 + lane]; if (key > t) key = -1;
            const float lg = dot_h(qs, K + (size_t)(key < 0 ? 0 : key) * 128, 16) * SC128;
            attn_chunk(a, key, lg, V, 128, lane); }
        store_o((h16*)(F.ws + WS_OMIX) + (size_t)t * DM + 1536 + h * 128, a, lane);
        LDS_WAIT(); asm volatile("" ::: "memory"); }
}
__device__ __forceinline__ void mem_attn_phase(Frame& F, int l) { int lane = F.lane; asm volatile("" : "+v"(lane));
    LAS float* qs = (LAS float*)(F.lds + F.wave * 16384);
    WAVE_ITEMS(it, S * 4) { const int t = it >> 2, h = it & 3;
        const h16* K = (const h16*)(F.ws + WS_MK) + (size_t)((l * 4 + h) * MEMLEN) * 128; const h16* V = (const h16*)(F.ws + WS_MV) + (size_t)((l * 4 + h) * MEMLEN) * 128;
        load_q(qs, (const h16*)(F.ws + WS_MQ + (size_t)h * HEADBUF) + (size_t)t * 128, 128, lane);
        AttnAcc a; attn_init(a);
        for (int c = 0; c < 4; ++c) { const int key = c * 64 + lane;
            const float lg = dot_h(qs, K + (size_t)key * 128, 16) * SC128;
            attn_chunk(a, key, lg, V, 128, lane); }
        store_o((h16*)(F.ws + WS_MO) + (size_t)t * 512 + h * 128, a, lane);
        LDS_WAIT(); asm volatile("" ::: "memory"); }
}
namespace fa {
typedef short s16x4 __attribute__((ext_vector_type(4)));
typedef float f32x16 __attribute__((ext_vector_type(16)));
constexpr int SHM_K = 16384, SHM_V = 16384, SHM_KR = 8192;
constexpr int OFF_V = 0, OFF_K = 2 * SHM_V, OFF_KR = OFF_K + 2 * SHM_K, OFF_WS = OFF_KR + 2 * SHM_KR, OFF_TICKET = OFF_WS + NWAVES * 96 * 4;
enum { K_MLA = 0, K_MOBA, K_SLC, K_WIN, K_DSA, K_MEM };
#define FA_KSWZ(row, colB) ((row) * 256 + ((colB) ^ (((row) & 7) << 4)))
#define FA_KRSWZ(row, colB) ((row) * 128 + ((colB) ^ (((row) & 7) << 4)))
#define FA_SBAR() __builtin_amdgcn_sched_barrier(0)
__device__ __forceinline__ int v_st(int k, int c) { const int kk = (k & ~0xC) | ((k & 4) << 1) | ((k & 8) >> 1); return ((kk >> 3) * 4 + (c >> 5)) * 512 + ((kk & 7) * 32 + (c & 31)) * 2; }
__device__ __forceinline__ int v_rd_base(int lane) { return ((lane & 3) << 3) | (((lane >> 2) & 3) << 6) | (((lane >> 4) & 1) << 5) | (((lane >> 5) & 1) << 8); }
constexpr int v_rd_off(int d0, int ks, int half) { return d0 * 512 + ks * 4096 + half * 2048; }
__device__ __forceinline__ int crow(int r, int hi) { return (r & 3) + 8 * (r >> 2) + 4 * hi; }
__device__ __forceinline__ unsigned cvtpk(float lo, float hi) { half2v h; h[0] = (h16)lo; h[1] = (h16)hi; return __builtin_bit_cast(unsigned, h); }

__device__ __forceinline__ void mask_tile(f32x16& p0, f32x16& p1, int dq, unsigned W) {
    const float NEG = -__builtin_inff();
#pragma unroll
    for (int r = 0; r < 16; ++r) { const int c = (r & 3) + 8 * (r >> 2);
        if ((unsigned)(dq - c) >= W) p0[r] = NEG;
        if ((unsigned)(dq - c - 32) >= W) p1[r] = NEG; }
}
__device__ __forceinline__ void mask_all(f32x16& p0, f32x16& p1, bool keep) {
    const float NEG = -__builtin_inff();
#pragma unroll
    for (int r = 0; r < 16; ++r) { p0[r] = keep ? p0[r] : NEG; p1[r] = keep ? p1[r] : NEG; }
}
__device__ __forceinline__ void mask_bits(f32x16& p0, f32x16& p1, unsigned lo, unsigned hi_w, int hi) {
    const unsigned a = lo >> (4 * hi), b = hi_w >> (4 * hi); const unsigned NEGB = 0xFF800000u;
#pragma unroll
    for (int r = 0; r < 16; ++r) { const int c = (r & 3) + 8 * (r >> 2);
        const unsigned ma = (unsigned)__builtin_amdgcn_sbfe((int)a, c, 1), mb = (unsigned)__builtin_amdgcn_sbfe((int)b, c, 1);
        const float x0 = p0[r], x1 = p1[r];
        p0[r] = __uint_as_float((__float_as_uint(x0) & ma) | (NEGB & ~ma));
        p1[r] = __uint_as_float((__float_as_uint(x1) & mb) | (NEGB & ~mb)); }
}
__device__ __forceinline__ void partialSM(f32x16& p0, f32x16& p1, float& m_reg, float& mn, float& alpha, const float sc, const float C2) {
    float pmax = p0[0];
#pragma unroll
    for (int r = 1; r < 16; ++r) pmax = fmaxf(pmax, p0[r]);
#pragma unroll
    for (int r = 0; r < 16; ++r) pmax = fmaxf(pmax, p1[r]);
    { auto rr = __builtin_amdgcn_permlane32_swap(__float_as_uint(pmax), __float_as_uint(pmax), false, false);
      pmax = fmaxf(__uint_as_float(rr[0]), __uint_as_float(rr[1])); }
    if (__builtin_expect(__all((pmax - m_reg) * sc <= 8.0f), 1)) { mn = m_reg; alpha = 1.f; }
    else { mn = fmaxf(m_reg, pmax); alpha = __builtin_amdgcn_exp2f((m_reg - mn) * C2); m_reg = mn; }
    const float mnL = -mn * C2;
#pragma unroll
    for (int r = 0; r < 16; ++r) p0[r] = __builtin_amdgcn_exp2f(fmaf(p0[r], C2, mnL));
#pragma unroll
    for (int r = 0; r < 16; ++r) p1[r] = __builtin_amdgcn_exp2f(fmaf(p1[r], C2, mnL));
}
__device__ __forceinline__ void finishSM(const f32x16& p0, const f32x16& p1, float alpha, float& l_reg, half8& pa0, half8& pa1, half8& pa2, half8& pa3) {
    float ps = 0;
#pragma unroll
    for (int r = 0; r < 16; ++r) ps += p0[r];
#pragma unroll
    for (int r = 0; r < 16; ++r) ps += p1[r];
    { auto rr = __builtin_amdgcn_permlane32_swap(__float_as_uint(ps), __float_as_uint(ps), false, false);
      ps = __uint_as_float(rr[0]) + __uint_as_float(rr[1]); }
    l_reg = l_reg * alpha + ps;
#define FA_PK4(P, B_, OUT) do { unsigned a0 = cvtpk(P[B_ + 0], P[B_ + 1]), a1 = cvtpk(P[B_ + 2], P[B_ + 3]); unsigned b0 = cvtpk(P[B_ + 4], P[B_ + 5]), b1 = cvtpk(P[B_ + 6], P[B_ + 7]); \
        auto r0 = __builtin_amdgcn_permlane32_swap(a0, b0, false, false); auto r1 = __builtin_amdgcn_permlane32_swap(a1, b1, false, false); \
        u32x4 w = {r0[0], r1[0], r0[1], r1[1]}; OUT = __builtin_bit_cast(half8, w); } while (0)
    FA_PK4(p0, 0, pa0); FA_PK4(p0, 8, pa1); FA_PK4(p1, 0, pa2); FA_PK4(p1, 8, pa3);
#undef FA_PK4
}
template <bool MLA>
__device__ __forceinline__ void qkt(f32x16& p0, f32x16& p1, const LAS char* lds, int kboff, int kroff, int r32, int hi, const half8* qr, bool act) {
    if (!act) { const float NEG = -__builtin_inff();
#pragma unroll
        for (int r = 0; r < 16; ++r) { p0[r] = NEG; p1[r] = NEG; } return; }
#pragma unroll
    for (int r = 0; r < 16; ++r) { p0[r] = 0.f; p1[r] = 0.f; }
    const LAS char* kb[4];
#pragma unroll
    for (int dd = 0; dd < 4; ++dd) kb[dd] = lds + OFF_K + kboff + FA_KSWZ(r32, (dd * 16 + hi * 8) * 2);
#pragma unroll
    for (int d0 = 0; d0 < 8; ++d0) { const LAS char* a = kb[d0 & 3] + (d0 >> 2) * 128;
        const half8 b0 = *(const LAS half8*)a; const half8 b1 = *(const LAS half8*)(a + 32 * 256);
        p0 = __builtin_amdgcn_mfma_f32_32x32x16_f16(b0, qr[d0], p0, 0, 0, 0);
        p1 = __builtin_amdgcn_mfma_f32_32x32x16_f16(b1, qr[d0], p1, 0, 0, 0); }
    if constexpr (MLA) {
#pragma unroll
        for (int d0 = 0; d0 < 4; ++d0) { const LAS char* a = lds + OFF_KR + kroff + FA_KRSWZ(r32, (d0 * 16 + hi * 8) * 2);
            const half8 b0 = *(const LAS half8*)a; const half8 b1 = *(const LAS half8*)(a + 32 * 128);
            p0 = __builtin_amdgcn_mfma_f32_32x32x16_f16(b0, qr[8 + d0], p0, 0, 0, 0);
            p1 = __builtin_amdgcn_mfma_f32_32x32x16_f16(b1, qr[8 + d0], p1, 0, 0, 0); }
    }
}
__device__ __forceinline__ void pv_tile(f32x16* o, int vb0, half8 pa0, half8 pa1, half8 pa2, half8 pa3, bool act) {
    if (!act) return;
#define FA_TRRD(dst, off) asm volatile("ds_read_b64_tr_b16 %0, %1 offset:%2" : "=&v"(dst) : "v"(vb0), "i"(off) : "memory")
#define FA_H8(l, h) __builtin_bit_cast(half8, (short __attribute__((ext_vector_type(8)))){l[0], l[1], l[2], l[3], h[0], h[1], h[2], h[3]})
#define FA_PV_D0(d0) do { s16x4 l0, l1, l2, l3, h0, h1, h2, h3; constexpr int b_ = v_rd_off(d0, 0, 0); \
        FA_TRRD(l0, b_); FA_TRRD(h0, b_ + 2048); FA_TRRD(l1, b_ + 4096); FA_TRRD(h1, b_ + 6144); FA_TRRD(l2, b_ + 8192); FA_TRRD(h2, b_ + 10240); FA_TRRD(l3, b_ + 12288); FA_TRRD(h3, b_ + 14336); \
        asm volatile("s_waitcnt lgkmcnt(0)" ::: "memory"); FA_SBAR(); \
        o[d0] = __builtin_amdgcn_mfma_f32_32x32x16_f16(pa0, FA_H8(l0, h0), o[d0], 0, 0, 0); \
        o[d0] = __builtin_amdgcn_mfma_f32_32x32x16_f16(pa1, FA_H8(l1, h1), o[d0], 0, 0, 0); \
        o[d0] = __builtin_amdgcn_mfma_f32_32x32x16_f16(pa2, FA_H8(l2, h2), o[d0], 0, 0, 0); \
        o[d0] = __builtin_amdgcn_mfma_f32_32x32x16_f16(pa3, FA_H8(l3, h3), o[d0], 0, 0, 0); } while (0)
    FA_PV_D0(0); FA_PV_D0(1); FA_PV_D0(2); FA_PV_D0(3);
#undef FA_PV_D0
#undef FA_H8
#undef FA_TRRD
}
struct UnitArgs {
    const h16* Q; int qld;
    const h16* K; const h16* KR; const h16* V;
    h16* O; int old;
    int P0, j_lo, j_hi;
    const void* mk;
    const float* gate; int gidx;
    const float* ocmp;
    int epi;
};
template <int KIND>
__device__ __forceinline__ void run_unit(LAS char* lds, const UnitArgs& U, int tid_in) {
    constexpr bool MLA = KIND == K_MLA;
    int tid = tid_in; asm volatile("" : "+v"(tid));
    const int wid = __builtin_amdgcn_readfirstlane(tid >> 6), lane = tid & 63, r32 = lane & 31, hi = lane >> 5;
    const int sr = tid >> 4, sc = (tid & 15) * 8;
    const int qlo = U.P0 + wid * 32, rowpos = qlo + r32;
    const float sc_ = MLA ? SC192 : SC128; const float C2 = 1.4426950408889634f * sc_;
    LAS float* wsf = (LAS float*)(lds + OFF_WS) + wid * 96; LAS float* li_l = wsf; LAS float* al_l = wsf + 32; LAS float* g_l = wsf + 64;
    half8 qr[MLA ? 12 : 8];
    { const h16* qp = U.Q + (size_t)(wid * 32 + r32) * U.qld + hi * 8;
#pragma unroll
      for (int d0 = 0; d0 < (MLA ? 12 : 8); ++d0) qr[d0] = *(const half8*)(qp + d0 * 16); }
    unsigned mb0 = 0, mb1 = 0, mb2 = 0, mb3 = 0;
    if constexpr (KIND == K_MOBA) { const int* s = (const int*)U.mk + (size_t)rowpos * 16;
#pragma unroll
        for (int i = 0; i < 3; ++i) { const int b = s[i]; if (b >= 0) mb0 |= 1u << b; } }
    if constexpr (KIND == K_SLC) { const u32x4 m = *(const u32x4*)((const unsigned*)U.mk + (size_t)rowpos * 4); mb0 = m[0]; mb1 = m[1]; mb2 = m[2]; mb3 = m[3]; }
    const int NT = U.j_hi - U.j_lo;
    half8 st_k0, st_k1, st_v0, st_v1, st_kr; unsigned dm_lo = 0, dm_hi = 0, dn_lo = 0, dn_hi = 0;
    const int kws = FA_KSWZ(sr, sc * 2), vst0 = v_st(sr, sc), vst1 = v_st(32 + sr, sc), krw = FA_KRSWZ(tid >> 3, (tid & 7) * 16);
    const int vb0 = (int)(unsigned)(size_t)(lds + OFF_V) + v_rd_base(lane);
#define FA_LOADT(j) do { const int k0_ = (j) * 64; st_k0 = *(const half8*)(U.K + (size_t)(k0_ + sr) * 128 + sc); st_k1 = *(const half8*)(U.K + (size_t)(k0_ + 32 + sr) * 128 + sc); \
        st_v0 = *(const half8*)(U.V + (size_t)(k0_ + sr) * 128 + sc); st_v1 = *(const half8*)(U.V + (size_t)(k0_ + 32 + sr) * 128 + sc); \
        if constexpr (MLA) st_kr = *(const half8*)(U.KR + (size_t)(k0_ + (tid >> 3)) * 64 + (tid & 7) * 8); \
        if constexpr (KIND == K_DSA) { const unsigned long long w_ = ((const unsigned long long*)U.mk)[(size_t)rowpos * 128 + (j)]; dn_lo = (unsigned)w_; dn_hi = (unsigned)(w_ >> 32); } } while (0)
#define FA_WRITET(bf) do { *(LAS half8*)(lds + OFF_K + (bf) * SHM_K + kws) = st_k0; *(LAS half8*)(lds + OFF_K + (bf) * SHM_K + kws + 32 * 256) = st_k1; \
        *(LAS half8*)(lds + OFF_V + (bf) * SHM_V + vst0) = st_v0; *(LAS half8*)(lds + OFF_V + (bf) * SHM_V + vst1) = st_v1; \
        if constexpr (MLA) *(LAS half8*)(lds + OFF_KR + (bf) * SHM_KR + krw) = st_kr; } while (0)
    float m_reg = -1e30f, l_reg = 0.f; f32x16 o[4];
#pragma unroll
    for (int d = 0; d < 4; ++d)
#pragma unroll
        for (int r = 0; r < 16; ++r) o[d][r] = 0.f;
    FA_LOADT(U.j_lo); asm volatile("s_waitcnt vmcnt(0)" ::: "memory"); FA_WRITET(0); dm_lo = dn_lo; dm_hi = dn_hi;
    __syncthreads();
    f32x16 pA0, pA1; float mnA, alA; half8 pa0, pa1, pa2, pa3;
#define FA_STEP(t) do { const int kb_ = (U.j_lo + (t)) * 64; int bsel_ = (t) & 1; asm volatile("" : "+v"(bsel_)); \
        bool act_ = kb_ <= qlo + 31; if constexpr (KIND == K_WIN) act_ = act_ && (kb_ + 63 >= qlo - 511); if constexpr (KIND == K_MEM) act_ = true; \
        qkt<MLA>(pA0, pA1, lds, bsel_ * SHM_K, bsel_ * SHM_KR, r32, hi, qr, act_); \
        if (act_) { \
            if constexpr (KIND == K_MLA) { if (kb_ + 63 > qlo) mask_tile(pA0, pA1, rowpos - kb_ - 4 * hi, 0x40000000u); } \
            if constexpr (KIND == K_WIN) { if (kb_ + 63 > qlo || kb_ <= qlo + 31 - 512) mask_tile(pA0, pA1, rowpos - kb_ - 4 * hi, 512u); } \
            if constexpr (KIND == K_MOBA) { const int blk_ = kb_ >> 8; if (blk_ == (U.P0 >> 8)) { if (kb_ + 63 > qlo) mask_tile(pA0, pA1, rowpos - kb_ - 4 * hi, 0x40000000u); } else mask_all(pA0, pA1, (mb0 >> blk_) & 1u); } \
            if constexpr (KIND == K_SLC) { const int b_ = kb_ >> 6; const unsigned w_ = (b_ < 32) ? mb0 : (b_ < 64) ? mb1 : (b_ < 96) ? mb2 : mb3; mask_all(pA0, pA1, (w_ >> (b_ & 31)) & 1u); \
                if (kb_ + 63 > qlo) mask_tile(pA0, pA1, rowpos - kb_ - 4 * hi, 0x40000000u); } \
            if constexpr (KIND == K_DSA) mask_bits(pA0, pA1, dm_lo, dm_hi, hi); \
            partialSM(pA0, pA1, m_reg, mnA, alA, sc_, C2); \
            if (__any(alA < 1.f)) { if (hi == 0) al_l[r32] = alA; asm volatile("s_waitcnt lgkmcnt(0)" ::: "memory"); \
                _Pragma("unroll") for (int d_ = 0; d_ < 4; ++d_) _Pragma("unroll") for (int r = 0; r < 16; ++r) o[d_][r] *= al_l[crow(r, hi)]; } \
            finishSM(pA0, pA1, alA, l_reg, pa0, pa1, pa2, pa3); FA_SBAR(); \
            pv_tile(o, vb0 + bsel_ * SHM_V, pa0, pa1, pa2, pa3, true); } } while (0)
    for (int t = 0; t < NT; ++t) {
        if (t + 1 < NT) FA_LOADT(U.j_lo + t + 1);
        FA_SBAR();
        FA_STEP(t);
        FA_SBAR();
        if (t + 1 < NT) { asm volatile("s_waitcnt vmcnt(0)" ::: "memory"); FA_WRITET((t + 1) & 1); dm_lo = dn_lo; dm_hi = dn_hi; }
        __syncthreads();
    }
    float rs = l_reg > 0.f ? 1.0f / l_reg : 0.f;
    if (U.epi != 0) { const float gl = U.gate[(size_t)rowpos * 32 + U.gidx]; rs *= 1.0f / (1.0f + __expf(-gl));
        if (U.epi == 1) { const float g0 = U.gate[(size_t)rowpos * 32 + U.gidx - 1]; if (hi == 0) g_l[r32] = 1.0f / (1.0f + __expf(-g0)); } }
    if (hi == 0) li_l[r32] = rs;
    asm volatile("s_waitcnt lgkmcnt(0)" ::: "memory");
#pragma unroll
    for (int r = 0; r < 16; ++r) { const int orow = wid * 32 + crow(r, hi); const float rli = li_l[crow(r, hi)]; const float g0 = (U.epi == 1) ? g_l[crow(r, hi)] : 0.f;
#pragma unroll
        for (int d0 = 0; d0 < 4; ++d0) { float v = o[d0][r] * rli;
            if (U.epi == 1) v += g0 * U.ocmp[(size_t)(U.P0 + orow) * 512 + d0 * 32 + r32];
            const float vn = __shfl_xor(v, 1);
            if ((r32 & 1) == 0) { unsigned* op = (unsigned*)(U.O + (size_t)orow * U.old + d0 * 32 + r32);
                if (U.epi == 2) { const half2v pv = __builtin_bit_cast(half2v, *op); *op = cvtpk(v + (float)pv[0], vn + (float)pv[1]); }
                else *op = cvtpk(v, vn); } } }
    __syncthreads();
#undef FA_LOADT
#undef FA_WRITET
#undef FA_STEP
}
}

constexpr int CW_QUEUE = 8192;
__device__ __forceinline__ int fa_ticket(Frame& F, unsigned* head) {
    LAS int* tk = (LAS int*)(F.lds + fa::OFF_TICKET);
    if (F.tid == 0) *tk = (int)__hip_atomic_fetch_add(head, 1u, __ATOMIC_RELAXED, __HIP_MEMORY_SCOPE_AGENT);
    __syncthreads();
    const int u = *tk;
    __syncthreads();
    return u;
}
__device__ __forceinline__ void fa_mixer_phase(Frame& F, int l) {
    LAS char* lds = (LAS char*)F.lds; unsigned char* ws = F.ws;
    for (;;) {
        const int u = fa_ticket(F, F.ctl + CW_QUEUE + 64 * l);
        if (u >= 512) break;
        const int qb = 31 - (u >> 4), type = (u >> 2) & 3, h = u & 3, P0 = qb * 256;
        if (!((FA_MASK >> type) & 1)) continue;
        fa::UnitArgs U; U.P0 = P0; U.j_lo = 0; U.j_hi = (P0 + 255) / 64 + 1; U.KR = nullptr; U.mk = nullptr; U.gate = nullptr; U.gidx = 0; U.ocmp = nullptr; U.epi = 0; U.old = DM;
        if (type == 0) {
            U.Q = (const h16*)(ws + WS_Q192) + ((size_t)h * S + P0) * 192; U.qld = 192; U.K = (const h16*)(ws + WS_KN + (size_t)h * HEADBUF); U.KR = (const h16*)(ws + WS_BKR); U.V = (const h16*)(ws + WS_BV + (size_t)h * HEADBUF);
            U.O = (h16*)(ws + WS_OMIX) + (size_t)P0 * DM + 512 + h * 128;
            fa::run_unit<fa::K_MLA>(lds, U, F.tid);
        } else if (type == 1) {
            U.Q = (const h16*)(ws + WS_CQROPE + (size_t)h * HEADBUF) + (size_t)P0 * 128; U.qld = 128; U.K = (const h16*)(ws + WS_KSLC); U.V = (const h16*)(ws + WS_VSLC);
            U.O = (h16*)(ws + WS_OMIX) + (size_t)P0 * DM + 1024 + h * 128; U.mk = ws + WS_NSAMASK; U.gate = (const float*)(ws + WS_SMALL); U.gidx = h * 3 + 1; U.ocmp = (const float*)(ws + WS_OCMP) + h * 128; U.epi = 1;
            fa::run_unit<fa::K_SLC>(lds, U, F.tid);
            U.K = (const h16*)(ws + WS_KWIN); U.V = (const h16*)(ws + WS_VWIN); U.j_lo = P0 >= 511 ? (P0 - 511) / 64 : 0; U.gidx = h * 3 + 2; U.epi = 2;
            fa::run_unit<fa::K_WIN>(lds, U, F.tid);
        } else if (type == 2) {
            U.Q = (const h16*)(ws + WS_AQ + (size_t)h * HEADBUF) + (size_t)P0 * 128; U.qld = 128; U.K = (const h16*)(ws + WS_AK + (size_t)h * HEADBUF); U.V = (const h16*)(ws + WS_AV + (size_t)h * HEADBUF);
            U.O = (h16*)(ws + WS_OMIX) + (size_t)P0 * DM + h * 128; U.mk = (const int*)(ws + WS_MOBASEL) + h * 4;
            fa::run_unit<fa::K_MOBA>(lds, U, F.tid);
        } else {
            U.Q = (const h16*)(ws + WS_DQ + (size_t)h * HEADBUF) + (size_t)P0 * 128; U.qld = 128; U.K = (const h16*)(ws + WS_DK + (size_t)h * HEADBUF); U.V = (const h16*)(ws + WS_DV + (size_t)h * HEADBUF);
            U.O = (h16*)(ws + WS_OMIX) + (size_t)P0 * DM + 1536 + h * 128; U.mk = ws + WS_DSAMASK;
            fa::run_unit<fa::K_DSA>(lds, U, F.tid);
        }
    }
}
__device__ __forceinline__ void fa_mem_phase(Frame& F, int l) {
    LAS char* lds = (LAS char*)F.lds; unsigned char* ws = F.ws;
    for (int u = blockIdx.x; u < 128; u += F.G) {
        const int qb = u >> 2, h = u & 3, P0 = qb * 256;
        fa::UnitArgs U; U.P0 = P0; U.j_lo = 0; U.j_hi = 4; U.KR = nullptr; U.mk = nullptr; U.gate = nullptr; U.gidx = 0; U.ocmp = nullptr; U.epi = 0;
        U.Q = (const h16*)(ws + WS_MQ + (size_t)h * HEADBUF) + (size_t)P0 * 128; U.qld = 128;
        U.K = (const h16*)(ws + WS_MK) + (size_t)((l * 4 + h) * MEMLEN) * 128; U.V = (const h16*)(ws + WS_MV) + (size_t)((l * 4 + h) * MEMLEN) * 128;
        U.O = (h16*)(ws + WS_MO) + (size_t)P0 * 512 + h * 128; U.old = 512;
        fa::run_unit<fa::K_MEM>(lds, U, F.tid);
    }
}

enum { PHB_P0, PHB_KMEAN, PHB_CMP2, PHB_GATE, PHB_SCORE, PHB_CMPSEL, PHB_TOPK, PHB_MOBA, PHB_MLA, PHB_NSA, PHB_DSA, PHB_MEMA, PHB_LN, PHB_GMKV, PHB_GSWIGLU, PHB_GWIN, PHB_GUQ, PHB_GUKV, PHB_GY, PHB_GMQ, PHB_GRESID };
#ifndef SKIPMASK
#define SKIPMASK 0u
#endif
constexpr int SLOTS = 7, NSTEPS = 2 + 16 * SLOTS;
struct Args { const float* in[19]; float* out; unsigned char* ws; int lo, hi; };
__global__ void __launch_bounds__(NTHREADS, 2) mk_fwd(Args args) {
    extern __shared__ __attribute__((aligned(16))) unsigned char lds_raw[];
    Frame F;
    F.lds = (LAS unsigned char*)lds_raw;
    F.MISC = (volatile LAS unsigned*)(F.lds + MISC_OFF);
    F.tid = threadIdx.x; F.lane = F.tid & 63; F.wave = __builtin_amdgcn_readfirstlane(F.tid >> 6);
    F.G = gridDim.x; F.ws = args.ws; F.ctl = (unsigned*)(args.ws + WS_CTL); F.out = args.out;
#pragma unroll
    for (int i = 0; i < 19; ++i) F.in[i] = args.in[i];
    for (int u = F.tid; u < (LDS_BYTES - LDSCTL_OFF) / 4; u += NTHREADS) ((LAS unsigned*)(F.lds + LDSCTL_OFF))[u] = 0u;
    __syncthreads();
    const int lo = args.lo, hi = args.hi;
    XcdBarrier bar; bar.bar = F.ctl + CW_BAR; bar.x = 0; bar.st = nullptr;
    if (hi - lo > 1) bar = xcd_barrier_post(F.ctl + CW_BAR, F.MISC + 8);
#define PH(name, call) do { if (!(SKIPMASK & (1u << PHB_##name))) { call; } } while (0)
#define IN(k) (lo <= (k) && (k) < hi)
#define END(k) do { if (hi > (k) + 1) xcd_barrier(bar); } while (0)
    unsigned char* ws = args.ws;
    const float* xf = (const float*)(ws + WS_XF); float* z = (float*)(ws + WS_Z); const h16* xh = (const h16*)(ws + WS_XH);

    if (IN(0)) { PH(P0, p0_prologue(F)); END(0); }
    if (IN(1)) {
        pg8::Gemm g{(const h16*)(ws + WS_MEMH), (const h16*)(ws + WS_WMKV), MEMLEN, DEPTH * 1024, DM}; pg8::StaticOrder So; So.init(MEMLEN, DEPTH * 1024, F.G, (int)blockIdx.x);
        EpiProj<JOB_MKV> E{ws, 0};
        PH(GMKV, (pg8::gemm_phase<EpiProj<JOB_MKV>, pg8::StaticOrder, true, true>(F.lds, g, So, E)));
        END(1);
    }
    for (int sb = 0; sb < 16; ++sb) {
        const int l = sb >> 2, kind = sb & 3, base = 2 + sb * SLOTS;
        if (hi <= base || lo >= base + SLOTS) continue;
        const h16* resA; const h16* resB; int resK; float resS; int lnidx;
        if (kind == 0 || kind == 3) {
            const int f = kind == 0 ? 0 : 1;
            resA = (const h16*)(ws + WS_HB); resB = (const h16*)(ws + WS_WD) + (size_t)(l * 2 + f) * DM * DFF; resK = DFF; resS = 0.5f; lnidx = kind;
            if (IN(base)) {
                pg8::Gemm g{xh, (const h16*)(ws + WS_WGU) + (size_t)(l * 2 + f) * 2 * DFF * DM, S, 2 * DFF, DM}; pg8::StaticOrder So; So.init(S, 2 * DFF, F.G, (int)blockIdx.x);
                EpiSwiglu E{(h16*)(ws + WS_HB)};
                PH(GSWIGLU, (pg8::gemm_phase<EpiSwiglu, pg8::StaticOrder, true, true>(F.lds, g, So, E)));
                END(base);
            }
        } else if (kind == 1) {
            resA = (const h16*)(ws + WS_OMIX); resB = (const h16*)(ws + WS_WOUT) + (size_t)l * DM * DM; resK = DM; resS = 1.0f; lnidx = 1;
            if (IN(base)) {
                pg8::Gemm g{xh, (const h16*)(ws + WS_WIN) + (size_t)l * NIN * DM, S, NIN, DM}; pg8::StaticOrder So; So.init(S, NIN, F.G, (int)blockIdx.x);
                EpiProj<JOB_WIN> E{ws, 0};
                PH(GWIN, (pg8::gemm_phase<EpiProj<JOB_WIN>, pg8::StaticOrder, true, true>(F.lds, g, So, E)));
                END(base);
            }
            if (IN(base + 1)) {
                { pg8::Gemm g{(const h16*)(ws + WS_BCQ), (const h16*)(ws + WS_WUQ) + (size_t)l * 768 * 512, S, 768, 512}; pg8::StaticOrder So; So.init(S, 768, F.G, (int)blockIdx.x);
                  EpiProj<JOB_UQ> E{ws, 0}; PH(GUQ, (pg8::gemm_phase<EpiProj<JOB_UQ>, pg8::StaticOrder, true, true>(F.lds, g, So, E))); }
                { pg8::Gemm g{(const h16*)(ws + WS_BCKV), (const h16*)(ws + WS_WUKV) + (size_t)l * 1024 * 512, S, 1024, 512}; pg8::StaticOrder So; So.init(S, 1024, F.G, (int)blockIdx.x);
                  EpiProj<JOB_UKV> E{ws, 0}; PH(GUKV, (pg8::gemm_phase<EpiProj<JOB_UKV>, pg8::StaticOrder, true, true>(F.lds, g, So, E))); }
                for (int br = 0; br < 2; ++br) {
                  pg8::Gemm g{(const h16*)(ws + (br ? WS_VCMP : WS_KCMP)), (const h16*)(ws + WS_WC1) + (size_t)(l * 2 + br) * 256 * 2048, 512, 256, 2048}; pg8::StaticOrder So; So.init(512, 256, F.G, (int)blockIdx.x);
                  EpiProj<JOB_Y> E{ws, br}; PH(GY, (pg8::gemm_phase<EpiProj<JOB_Y>, pg8::StaticOrder, true, true>(F.lds, g, So, E))); }
                __syncthreads();
                PH(KMEAN, moba_kmean_phase(F));
                END(base + 1);
            }
            if (IN(base + 2)) { PH(CMP2, nsa_cmp2_phase(F, l)); PH(GATE, moba_gate_phase(F)); PH(SCORE, dsa_score_phase(F)); END(base + 2); }
            if (IN(base + 3)) { PH(CMPSEL, nsa_cmp_select_phase(F)); PH(TOPK, dsa_topk_phase(F)); END(base + 3); }
            if (IN(base + 4)) {
#if USE_FA
                fa_mixer_phase(F, l);
                if (!(FA_MASK & 1)) mla_attn_phase(F);
                if (!(FA_MASK & 2)) nsa_attn_phase(F);
                if (!(FA_MASK & 4)) moba_attn_phase(F);
                if (!(FA_MASK & 8)) dsa_attn_phase(F);
#else
                PH(MOBA, moba_attn_phase(F)); PH(MLA, mla_attn_phase(F)); PH(NSA, nsa_attn_phase(F)); PH(DSA, dsa_attn_phase(F));
#endif
                END(base + 4); }
        } else {
            resA = (const h16*)(ws + WS_MO); resB = (const h16*)(ws + WS_WMO) + (size_t)l * DM * 512; resK = 512; resS = 1.0f; lnidx = 2;
            if (IN(base)) {
                pg8::Gemm g{xh, (const h16*)(ws + WS_WMQ) + (size_t)l * 512 * DM, S, 512, DM}; pg8::StaticOrder So; So.init(S, 512, F.G, (int)blockIdx.x);
                EpiProj<JOB_MQ> E{ws, 0};
                PH(GMQ, (pg8::gemm_phase<EpiProj<JOB_MQ>, pg8::StaticOrder, true, true>(F.lds, g, So, E)));
                END(base);
            }
            if (IN(base + 1)) {
#if USE_FA
                if (FA_MASK & 16) fa_mem_phase(F, l); else mem_attn_phase(F, l);
#else
                PH(MEMA, mem_attn_phase(F, l));
#endif
                END(base + 1); }
        }
        if (IN(base + 5)) {
            pg8::Gemm g{resA, resB, S, DM, resK}; pg8::StaticOrder So; So.init(S, DM, F.G, (int)blockIdx.x);
            EpiResid E{xf, z, resS};
            PH(GRESID, (pg8::gemm_phase<EpiResid, pg8::StaticOrder, true, true>(F.lds, g, So, E)));
            END(base + 5);
        }
        if (IN(base + 6)) {
            const float* g = (const float*)(ws + WS_LNG) + (size_t)(l * 4 + lnidx) * DM; const float* b = (const float*)(ws + WS_LNB) + (size_t)(l * 4 + lnidx) * DM;
            PH(LN, ln_phase(F, z, g, b, sb == 15 ? F.out : (float*)(ws + WS_XF), (h16*)(ws + WS_XH)));
            END(base + 6);
        }
    }
#undef IN
#undef END
}

extern "C" void kernel_launch(void* const* d_in, const int* in_sizes, int n_in, void* d_out, int out_size, void* d_ws, size_t ws_size, hipStream_t stream) {
    static int grid = 0;
    if (grid == 0) {
        if (n_in != 19 || out_size != S * DM || ws_size < WS_END) { fprintf(stderr, "kernel_launch: unexpected shapes (n_in %d, out %d, ws %zu < %zu)\n", n_in, out_size, ws_size, (size_t)WS_END); grid = -1; return; }
        int dev = 0, cus = 0, per_cu = 0;
        if (hipGetDevice(&dev) != hipSuccess || hipDeviceGetAttribute(&cus, hipDeviceAttributeMultiprocessorCount, dev) != hipSuccess) { grid = -1; return; }
        if (hipFuncSetAttribute((const void*)mk_fwd, hipFuncAttributeMaxDynamicSharedMemorySize, LDS_BYTES) != hipSuccess) { fprintf(stderr, "kernel_launch: hipFuncSetAttribute failed\n"); grid = -1; return; }
        if (hipOccupancyMaxActiveBlocksPerMultiprocessor(&per_cu, (const void*)mk_fwd, NTHREADS, LDS_BYTES) != hipSuccess || per_cu < 1) { fprintf(stderr, "kernel_launch: occupancy query says %d\n", per_cu); }
        (void)hipGetLastError();
        grid = cus;
    }
    if (grid < 0) return;
    if (hipMemsetAsync((char*)d_ws + WS_CTL, 0, CTL_BYTES, stream) != hipSuccess) return;
    Args a{};
    for (int i = 0; i < 19; ++i) a.in[i] = (const float*)d_in[i];
    a.out = (float*)d_out; a.ws = (unsigned char*)d_ws;
#if MK_STEP_LAUNCHES
    for (int st = 0; st < NSTEPS; ++st) {
        if (st >= 2) { const int sb = (st - 2) / SLOTS, slot = (st - 2) % SLOTS, kind = sb & 3;
            const bool live = slot >= 5 || slot == 0 || (kind == 1 && slot <= 4) || (kind == 2 && slot == 1);
            if (!live) continue; }
        a.lo = st; a.hi = st + 1;
        hipLaunchKernelGGL(mk_fwd, dim3(grid), dim3(NTHREADS), LDS_BYTES, stream, a);
    }
#else
    a.lo = 0; a.hi = NSTEPS;
    hipLaunchKernelGGL(mk_fwd, dim3(grid), dim3(NTHREADS), LDS_BYTES, stream, a);
#endif
}
```

```cpp
#include <hip/hip_runtime.h>
#include <cstdio>
#include <cstdint>

#ifndef USE_FA
#define USE_FA 1
#endif
#ifndef FA_MASK
#define FA_MASK 0x1f
#endif
#ifndef MK_STEP_LAUNCHES
#define MK_STEP_LAUNCHES 0
#endif

#define GAS __attribute__((address_space(1)))
#define LAS __attribute__((address_space(3)))
typedef _Float16 h16;
typedef _Float16 half8 __attribute__((ext_vector_type(8)));
typedef _Float16 half4 __attribute__((ext_vector_type(4)));
typedef _Float16 half2v __attribute__((ext_vector_type(2)));
typedef float f32x4 __attribute__((ext_vector_type(4)));
typedef float f32x2 __attribute__((ext_vector_type(2)));
typedef unsigned u32x4 __attribute__((ext_vector_type(4)));
typedef unsigned long long u64;

constexpr int S = 8192, DM = 2048, DFF = 5632, DEPTH = 4, MEMLEN = 256;
constexpr int D_IN = 6556, NIN = 6656;
constexpr float LN_EPS = 1e-5f, RMS_EPS = 1e-6f;
constexpr float DN_ALPHA = 1.681792830507429f;
constexpr int NWAVES = 8, NTHREADS = 512;

constexpr size_t al256(size_t x) { return (x + 255) & ~(size_t)255; }
constexpr size_t WS_CTL = 0, CTL_BYTES = 1u << 20;
constexpr size_t WS_WGU  = CTL_BYTES;
constexpr size_t WS_WD   = WS_WGU  + (size_t)DEPTH * 2 * 2 * DFF * DM * 2;
constexpr size_t WS_WIN  = WS_WD   + (size_t)DEPTH * 2 * DM * DFF * 2;
constexpr size_t WS_WOUT = WS_WIN  + (size_t)DEPTH * NIN * DM * 2;
constexpr size_t WS_WUQ  = WS_WOUT + (size_t)DEPTH * DM * DM * 2;
constexpr size_t WS_WUKV = WS_WUQ  + (size_t)DEPTH * 768 * 512 * 2;
constexpr size_t WS_WC1  = WS_WUKV + (size_t)DEPTH * 1024 * 512 * 2;
constexpr size_t WS_WMQ  = WS_WC1  + (size_t)DEPTH * 2 * 256 * 2048 * 2;
constexpr size_t WS_WMKV = WS_WMQ  + (size_t)DEPTH * 512 * DM * 2;
constexpr size_t WS_WMO  = WS_WMKV + (size_t)DEPTH * 1024 * DM * 2;
constexpr size_t WS_XF   = WS_WMO  + (size_t)DEPTH * DM * 512 * 2;
constexpr size_t WS_XH   = WS_XF   + (size_t)S * DM * 4;
constexpr size_t WS_Z    = WS_XH   + (size_t)S * DM * 2;
constexpr size_t WS_HB   = WS_Z    + (size_t)S * DM * 4;
constexpr size_t WS_MEMH = WS_HB   + (size_t)S * DFF * 2;
constexpr size_t WS_MK   = WS_MEMH + (size_t)MEMLEN * DM * 2;
constexpr size_t WS_MV   = WS_MK   + (size_t)DEPTH * 4 * MEMLEN * 128 * 2;
constexpr size_t WS_T128C = WS_MV  + (size_t)DEPTH * 4 * MEMLEN * 128 * 2;
constexpr size_t WS_T128S = WS_T128C + (size_t)S * 64 * 4;
constexpr size_t WS_T64C  = WS_T128S + (size_t)S * 64 * 4;
constexpr size_t WS_T64S  = WS_T64C + (size_t)S * 32 * 4;
constexpr size_t HEADBUF = (size_t)S * 128 * 2;
constexpr size_t WS_AQ   = WS_T64S + (size_t)S * 32 * 4;
constexpr size_t WS_AK   = WS_AQ + 4 * HEADBUF;
constexpr size_t WS_AV   = WS_AK + 4 * HEADBUF;
constexpr size_t WS_BCQ  = WS_AV + 4 * HEADBUF;
constexpr size_t WS_BCKV = WS_BCQ + (size_t)S * 512 * 2;
constexpr size_t WS_BKR  = WS_BCKV + (size_t)S * 512 * 2;
constexpr size_t WS_Q192 = WS_BKR + (size_t)S * 64 * 2;
constexpr size_t WS_KN   = WS_Q192 + (size_t)4 * S * 192 * 2;
constexpr size_t WS_BV   = WS_KN + 4 * HEADBUF;
constexpr size_t WS_CQRAW = WS_BV + 4 * HEADBUF;
constexpr size_t WS_CQROPE = WS_CQRAW + 4 * HEADBUF;
constexpr size_t WS_KCMP = WS_CQROPE + 4 * HEADBUF;
constexpr size_t WS_VCMP = WS_KCMP + HEADBUF;
constexpr size_t WS_KSLC = WS_VCMP + HEADBUF;
constexpr size_t WS_VSLC = WS_KSLC + HEADBUF;
constexpr size_t WS_KWIN = WS_VSLC + HEADBUF;
constexpr size_t WS_VWIN = WS_KWIN + HEADBUF;
constexpr size_t WS_SMALL = WS_VWIN + HEADBUF;
constexpr size_t WS_DQ   = WS_SMALL + (size_t)S * 32 * 4;
constexpr size_t WS_DK   = WS_DQ + 4 * HEADBUF;
constexpr size_t WS_DV   = WS_DK + 4 * HEADBUF;
constexpr size_t WS_IQ   = WS_DV + 4 * HEADBUF;
constexpr size_t WS_IK   = WS_IQ + (size_t)S * 1024 * 2;
constexpr size_t WS_SSQQ = WS_IK + (size_t)S * 64 * 2;
constexpr size_t WS_SSQKV = WS_SSQQ + (size_t)S * 8 * 4;
constexpr size_t WS_YK   = WS_SSQKV + (size_t)S * 8 * 4;
constexpr size_t WS_YV   = WS_YK + (size_t)512 * 256 * 4;
constexpr size_t WS_KC   = WS_YV + (size_t)512 * 256 * 4;
constexpr size_t WS_VC   = WS_KC + (size_t)512 * 128 * 4;
constexpr size_t WS_CBIAS = WS_VC + (size_t)512 * 128 * 4;
constexpr size_t WS_KMEAN = WS_CBIAS + (size_t)DEPTH * 2 * 128 * 4;
constexpr size_t WS_MOBASEL = WS_KMEAN + (size_t)4 * 32 * 128 * 4;
constexpr size_t WS_OCMP = WS_MOBASEL + (size_t)S * 16 * 4;
constexpr size_t WS_NSASEL = WS_OCMP + (size_t)S * 512 * 4;
constexpr size_t WS_NSAMASK = WS_NSASEL + (size_t)S * 16 * 4;
constexpr size_t WS_DSALIST = WS_NSAMASK + (size_t)S * 4 * 4;
constexpr size_t WS_DSAMASK = WS_DSALIST + (size_t)S * 256 * 4;
constexpr size_t WS_OMIX = WS_DSAMASK + (size_t)S * 128 * 8;
constexpr size_t WS_MQ   = WS_OMIX + (size_t)S * DM * 2;
constexpr size_t WS_MO   = WS_MQ + 4 * HEADBUF;
constexpr size_t WS_KC16 = WS_MO + (size_t)S * 512 * 2;
constexpr size_t WS_VC16 = WS_KC16 + (size_t)512 * 128 * 2;
constexpr size_t WS_LNG = WS_VC16 + (size_t)512 * 128 * 2;
constexpr size_t WS_LNB = WS_LNG + (size_t)16 * DM * 4;
constexpr size_t WS_W2C = WS_LNB + (size_t)16 * DM * 4;
constexpr size_t WS_SCORES = al256(WS_W2C + (size_t)8 * 128 * 128 * 4);
constexpr size_t WS_END  = WS_SCORES + (size_t)S * S * 4;

constexpr int CW_TMO = 0, CW_CODE = 1, CW_BAR = 4096;

constexpr int RING_BYTES = 131072;
constexpr int LDSCTL_OFF = RING_BYTES, MISC_OFF = LDSCTL_OFF + 320;
constexpr int LDS_BYTES = 147456;

#define RLX_AGENT __ATOMIC_RELAXED, __HIP_MEMORY_SCOPE_AGENT
#define LDS_WAIT() asm volatile("s_waitcnt lgkmcnt(0)" ::: "memory")
#define VM_WAIT() asm volatile("s_waitcnt vmcnt(0)" ::: "memory")

__device__ const double ROPE_INV[64] = {
1.0, 0.8659643233600653, 0.7498942093324559, 0.6493816315762113,
0.5623413251903491, 0.4869675251658631, 0.4216965034285822, 0.3651741272548377,
0.31622776601683794, 0.27384196342643613, 0.23713737056616552, 0.2053525026457146,
0.1778279410038923, 0.1539926526059492, 0.1333521432163324, 0.11547819846894582,
0.1, 0.08659643233600653, 0.07498942093324558, 0.06493816315762113,
0.05623413251903491, 0.04869675251658631, 0.042169650342858224, 0.03651741272548377,
0.03162277660168379, 0.027384196342643614, 0.023713737056616554, 0.02053525026457146,
0.01778279410038923, 0.01539926526059492, 0.01333521432163324, 0.011547819846894581,
0.01, 0.008659643233600654, 0.007498942093324558, 0.006493816315762113,
0.005623413251903491, 0.004869675251658631, 0.004216965034285823, 0.003651741272548377,
0.0031622776601683794, 0.0027384196342643613, 0.0023713737056616554, 0.002053525026457146,
0.0017782794100389228, 0.001539926526059492, 0.001333521432163324, 0.0011547819846894581,
0.001, 0.0008659643233600654, 0.0007498942093324559, 0.0006493816315762113,
0.0005623413251903491, 0.0004869675251658631, 0.00042169650342858224, 0.0003651741272548377,
0.00031622776601683794, 0.0002738419634264361, 0.00023713737056616554, 0.0002053525026457146,
0.00017782794100389227, 0.0001539926526059492, 0.0001333521432163324, 0.00011547819846894582
};
namespace pg8 {
constexpr int BM = 256, BK = 64, HALF = 128, HTB = HALF * BK * 2, STAGE_BYTES = 8 * HTB, NXCD = 8, WGM = 8;
__host__ __device__ __forceinline__ int lds_byte(int r, int c) { const int st = (r >> 4) * 2 + (c >> 5), rr = r & 15, cc = c & 31, ob = rr * 64 + cc * 2; return st * 1024 + (ob ^ (((ob >> 9) & 1) << 5)); }
__host__ __device__ __forceinline__ void stage_rc(int b, int& R, int& C) { const int st = b / 1024, sb = b % 1024, swz = sb ^ (((sb >> 9) & 1) << 5); R = (st >> 1) * 16 + swz / 64; C = (st & 1) * 32 + (swz % 64) / 2; }
__host__ __device__ __forceinline__ int perm32(int rho) { const int n = rho >> 4, i = rho & 15; return 8 * (i >> 2) + 4 * n + (i & 3); }
struct Unit { int pm, pn; };
struct Gemm { const h16* A; const h16* Bt; int M, N, K; };
struct StaticOrder {
    int nM, nN, nwg, G, c;
    __host__ __device__ void init(int M, int N, int G_, int c_) { nM = M / BM; nN = N / BM; nwg = nM * nN; G = G_; c = c_; }
    __host__ __device__ bool next(int i, Unit& u) const {
        const long L = (long)i * G + c; if (L >= nwg) return false;
        int wgid = (int)L; { const int q = nwg / NXCD, r = nwg % NXCD, xcd = wgid % NXCD, off = wgid / NXCD; wgid = (xcd < r ? xcd * (q + 1) : r * (q + 1) + (xcd - r) * q) + off; }
        const int nig = WGM * nN, gid = wgid / nig, fm = gid * WGM, gsz = (nM - fm) < WGM ? (nM - fm) : WGM;
        u.pm = fm + ((wgid % nig) % gsz); u.pn = (wgid % nig) / gsz; return true;
    }
    __device__ __forceinline__ void a_ready(const Unit&) const {}
    __device__ __forceinline__ void done(const Unit&) const {}
};
template <class Epi, class Sched, bool ALIGN_EPI = false, bool SP2 = false>
__device__ __forceinline__ void gemm_phase(LAS unsigned char* lds, const Gemm g, const Sched& S, const Epi& E) {
    int tid_ = threadIdx.x; asm volatile("" : "+v"(tid_));
    const int tid = tid_, wid = __builtin_amdgcn_readfirstlane(tid >> 6), lane = tid & 63, wr = wid >> 2, wc = wid & 3, fr = lane & 15, fq = lane >> 4;
    const int K = g.K, nt = K / BK;
    unsigned voffA[2], voffB[2];
#pragma unroll
    for (int i = 0; i < 2; ++i) { int R, C; stage_rc(tid * 16 + i * 8192, R, C); const int Rb = Epi::PERM ? ((R & ~31) + perm32(R & 31)) : R;
        voffA[i] = (unsigned)(R * K + C) * 2u; voffB[i] = (unsigned)(Rb * K + C) * 2u; }
    const size_t kstep = (size_t)(BK * 2);
    const size_t hstep = (size_t)HALF * K * 2;
    const size_t tstep = 2 * hstep;
    const unsigned ldsw = (unsigned)wid * 1024u;
    const int aoff = lds_byte(wr * 64 + fr, fq * 8), boff = lds_byte(wc * 32 + fr, fq * 8);
#define PG8_SA(b, h) (((b) * 2 + (h)) * HTB)
#define PG8_SB(b, h) ((4 + (b) * 2 + (h)) * HTB)
#define PG8_STAGE(bufoff, gbase, voff) do { _Pragma("unroll") for (int _i = 0; _i < 2; ++_i) \
        __builtin_amdgcn_global_load_lds((const unsigned*)((const char*)(gbase) + (voff)[_i]), (LAS unsigned*)(lds + (bufoff) + ldsw + _i * 8192), 16, 0, 0); } while (0)
#define PG8_LDA(dst, b, h) do { _Pragma("unroll") for (int m = 0; m < 4; ++m) _Pragma("unroll") for (int k = 0; k < 2; ++k) dst[m][k] = *(const LAS half8*)(lds + PG8_SA(b, h) + aoff + m * 2048 + k * 1024); } while (0)
#define PG8_LDB(dst, b, h) do { _Pragma("unroll") for (int n = 0; n < 2; ++n) _Pragma("unroll") for (int k = 0; k < 2; ++k) dst[n][k] = *(const LAS half8*)(lds + PG8_SB(b, h) + boff + n * 2048 + k * 1024); } while (0)
#define PG8_MMA(ai, bj, At, Bt) do { __builtin_amdgcn_s_setprio(1); _Pragma("unroll") for (int m = 0; m < 4; ++m) _Pragma("unroll") for (int n = 0; n < 2; ++n) _Pragma("unroll") for (int k = 0; k < 2; ++k) \
        acc[ai][bj][m][n] = __builtin_amdgcn_mfma_f32_16x16x32_f16(Bt[n][k], At[m][k], acc[ai][bj][m][n], 0, 0, 0); __builtin_amdgcn_s_setprio(0); } while (0)
#define PG8_WAIT_V(n) asm volatile("s_waitcnt vmcnt(" #n ")" ::: "memory")
#define PG8_WAIT_L(n) asm volatile("s_waitcnt lgkmcnt(" #n ")" ::: "memory")
#define PG8_BAR __builtin_amdgcn_s_barrier()
#define PG8_SCHED __builtin_amdgcn_sched_barrier(0)
    Unit cur, nxt; int ui = 0;
    if (!S.next(0, cur)) return;
    f32x4 acc[2][2][4][2];
#pragma unroll
    for (int a = 0; a < 2; ++a)
#pragma unroll
        for (int b = 0; b < 2; ++b)
#pragma unroll
            for (int m = 0; m < 4; ++m)
#pragma unroll
                for (int n = 0; n < 2; ++n) acc[a][b][m][n] = (f32x4){0.f, 0.f, 0.f, 0.f};
    half8 At[4][2], B0[2][2], B1[2][2];
    const char* cA = (const char*)g.A + (size_t)cur.pm * tstep; const char* cB = (const char*)g.Bt + (size_t)cur.pn * tstep;
    S.a_ready(cur);
    if constexpr (SP2) {
        PG8_STAGE(PG8_SB(0, 0), cB, voffB); PG8_STAGE(PG8_SB(0, 1), cB + hstep, voffB); PG8_STAGE(PG8_SA(0, 0), cA, voffA); PG8_STAGE(PG8_SA(0, 1), cA + hstep, voffA);
        if (wr == 1) PG8_BAR;
        PG8_WAIT_V(2); PG8_BAR;
        PG8_STAGE(PG8_SB(1, 0), cB + kstep, voffB); PG8_STAGE(PG8_SA(1, 0), cA + kstep, voffA); PG8_STAGE(PG8_SB(1, 1), cB + hstep + kstep, voffB);
        PG8_WAIT_V(6); PG8_BAR;
    } else {
        PG8_STAGE(PG8_SB(0, 0), cB, voffB); PG8_STAGE(PG8_SA(0, 0), cA, voffA); PG8_STAGE(PG8_SB(0, 1), cB + hstep, voffB); PG8_STAGE(PG8_SA(0, 1), cA + hstep, voffA);
        if (wr == 1) PG8_BAR;
        PG8_WAIT_V(4); PG8_BAR;
        PG8_STAGE(PG8_SB(1, 0), cB + kstep, voffB); PG8_STAGE(PG8_SA(1, 0), cA + kstep, voffA); PG8_STAGE(PG8_SB(1, 1), cB + hstep + kstep, voffB);
        PG8_WAIT_V(6); PG8_BAR;
    }
    for (;;) {
        const bool has_next = S.next(ui + 1, nxt);
        const char* nA = has_next ? (const char*)g.A + (size_t)nxt.pm * tstep : cA; const char* nB = has_next ? (const char*)g.Bt + (size_t)nxt.pn * tstep : cB;
        for (int t = 0; t < nt; t += 2) {
            const bool last = (t == nt - 2);
            const char* a1 = cA + (size_t)(t + 1) * kstep;
            const char* a2 = last ? nA : cA + (size_t)(t + 2) * kstep; const char* b2 = last ? nB : cB + (size_t)(t + 2) * kstep;
            const char* a3 = a2 + kstep; const char* b3 = b2 + kstep;
            if (last && has_next) S.a_ready(nxt);
            if constexpr (SP2) {
            PG8_LDB(B0, 0, 0); PG8_LDB(B1, 0, 1); PG8_SCHED; PG8_LDA(At, 0, 0); PG8_STAGE(PG8_SA(1, 1), a1 + hstep, voffA);
            PG8_WAIT_V(8); PG8_WAIT_L(0); PG8_BAR; PG8_MMA(0, 0, At, B0); PG8_MMA(0, 1, At, B1); PG8_BAR; PG8_SCHED;
            PG8_LDA(At, 0, 1); PG8_STAGE(PG8_SB(0, 0), b2, voffB); PG8_STAGE(PG8_SB(0, 1), b2 + hstep, voffB); PG8_STAGE(PG8_SA(0, 0), a2, voffA);
            PG8_WAIT_V(8); PG8_WAIT_L(0); PG8_BAR; PG8_MMA(1, 0, At, B0); PG8_MMA(1, 1, At, B1); PG8_BAR; PG8_SCHED;
            PG8_LDB(B0, 1, 0); PG8_LDB(B1, 1, 1); PG8_SCHED; PG8_LDA(At, 1, 0); PG8_STAGE(PG8_SA(0, 1), a2 + hstep, voffA);
            PG8_WAIT_V(8); PG8_WAIT_L(0); PG8_BAR; PG8_MMA(0, 0, At, B0); PG8_MMA(0, 1, At, B1); PG8_BAR; PG8_SCHED;
            PG8_LDA(At, 1, 1); PG8_STAGE(PG8_SB(1, 0), b3, voffB); PG8_STAGE(PG8_SB(1, 1), b3 + hstep, voffB); PG8_STAGE(PG8_SA(1, 0), a3, voffA);
            PG8_WAIT_V(8); PG8_WAIT_L(0); PG8_BAR; PG8_MMA(1, 0, At, B0); PG8_MMA(1, 1, At, B1); PG8_BAR; PG8_SCHED;
            } else {
            PG8_LDB(B0, 0, 0); PG8_SCHED; PG8_LDA(At, 0, 0); PG8_STAGE(PG8_SA(1, 1), a1 + hstep, voffA);
            PG8_WAIT_L(8); PG8_BAR; PG8_WAIT_L(0); PG8_MMA(0, 0, At, B0); PG8_BAR; PG8_SCHED;
            PG8_LDB(B1, 0, 1); PG8_STAGE(PG8_SB(0, 0), b2, voffB);
            PG8_BAR; PG8_WAIT_L(0); PG8_MMA(0, 1, At, B1); PG8_BAR;
            PG8_LDA(At, 0, 1); PG8_STAGE(PG8_SA(0, 0), a2, voffA);
            PG8_BAR; PG8_WAIT_L(0); PG8_MMA(1, 0, At, B0); PG8_BAR; PG8_SCHED;
            PG8_STAGE(PG8_SB(0, 1), b2 + hstep, voffB);
            PG8_WAIT_V(6); PG8_BAR; PG8_MMA(1, 1, At, B1); PG8_BAR;
            PG8_LDB(B0, 1, 0); PG8_SCHED; PG8_LDA(At, 1, 0); PG8_STAGE(PG8_SA(0, 1), a2 + hstep, voffA);
            PG8_WAIT_L(8); PG8_BAR; PG8_WAIT_L(0); PG8_MMA(0, 0, At, B0); PG8_BAR; PG8_SCHED;
            PG8_LDB(B1, 1, 1); PG8_STAGE(PG8_SB(1, 0), b3, voffB);
            PG8_BAR; PG8_WAIT_L(0); PG8_MMA(0, 1, At, B1); PG8_BAR;
            PG8_LDA(At, 1, 1); PG8_STAGE(PG8_SA(1, 0), a3, voffA);
            PG8_BAR; PG8_WAIT_L(0); PG8_MMA(1, 0, At, B0); PG8_BAR; PG8_SCHED;
            PG8_STAGE(PG8_SB(1, 1), b3 + hstep, voffB);
            PG8_WAIT_V(6); PG8_BAR; PG8_MMA(1, 1, At, B1); PG8_BAR;
            }
        }
        if constexpr (ALIGN_EPI) { if (wr == 0) PG8_BAR; }
        if constexpr (!Epi::AFTER_DRAIN) { E(acc, cur, wr, wc, fr, fq); S.done(cur); }
        if (!has_next) break;
#pragma unroll
        for (int a = 0; a < 2; ++a)
#pragma unroll
            for (int b = 0; b < 2; ++b)
#pragma unroll
                for (int m = 0; m < 4; ++m)
#pragma unroll
                    for (int n = 0; n < 2; ++n) acc[a][b][m][n] = (f32x4){0.f, 0.f, 0.f, 0.f};
        cur = nxt; cA = nA; cB = nB; ++ui;
        if constexpr (ALIGN_EPI) { if (wr == 1) PG8_BAR; }
    }
    PG8_WAIT_V(0);
    if constexpr (!ALIGN_EPI) { if (wr == 0) PG8_BAR; }
    PG8_BAR;
    if constexpr (Epi::AFTER_DRAIN) { E.fused(acc, cur, wr, wc, fr, fq, lds, wid, lane); S.done(cur); }
#undef PG8_SA
#undef PG8_SB
#undef PG8_STAGE
#undef PG8_LDA
#undef PG8_LDB
#undef PG8_MMA
#undef PG8_WAIT_V
#undef PG8_WAIT_L
#undef PG8_BAR
#undef PG8_SCHED
}
}
#define XB_TMO      128
#define XB_XCNT(j)  (256  + 64 * (j))
#define XB_XSUB(j)  (1280 + 64 * (j))
#define XB_XGEN(j)  (2304 + 64 * (j))
#define XB_TOP      3328
#define XB_TOPGEN   3392
#define XCD_BAR_WORDS 3456
#define XB_SPIN_CAP (1u << 18)

__device__ __forceinline__ unsigned xb_ld(unsigned* p)              { return __hip_atomic_load(p, __ATOMIC_RELAXED, __HIP_MEMORY_SCOPE_AGENT); }
__device__ __forceinline__ unsigned xb_add(unsigned* p, unsigned v) { return __hip_atomic_fetch_add(p, v, __ATOMIC_RELAXED, __HIP_MEMORY_SCOPE_AGENT); }
__device__ __forceinline__ unsigned xb_xcc_id() { return (unsigned)__builtin_amdgcn_s_getreg((3 << 11) | 20) & 0xFu; }
#define XB_SPIN(cond, bar) do { unsigned _sp = 0; while (cond) { __builtin_amdgcn_s_sleep(1); \
    if ((++_sp & 255u) == 0u) { if (xb_ld(&(bar)[XB_TMO])) break; if (_sp > XB_SPIN_CAP) { atomicAdd(&(bar)[XB_TMO], 1u); break; } } } } while (0)

struct XcdBarrier {
    unsigned* bar; unsigned x;
    volatile LAS unsigned* st;
};

__device__ __forceinline__ XcdBarrier xcd_barrier_post(unsigned* bar, volatile LAS unsigned* st) {
    XcdBarrier b; b.bar = bar; b.x = xb_xcc_id(); b.st = st;
    if (threadIdx.x == 0) (void)xb_add(&bar[XB_XCNT(b.x)], 1u);
    return b;
}
__device__ __forceinline__ void xcd_barrier_complete(unsigned* bar, unsigned x, unsigned& nloc, unsigned& nx) {
    const unsigned G = gridDim.x * gridDim.y * gridDim.z;
    unsigned sum, cnt, mine, sp = 0u;
    for (;;) {
        sum = 0u; cnt = 0u; mine = 0u;
#pragma unroll
        for (unsigned j = 0; j < 16; ++j) { const unsigned c = xb_ld(&bar[XB_XCNT(j)]); sum += c; cnt += (c > 0u) ? 1u : 0u; mine = (j == x) ? c : mine; }
        if (sum == G) break;
        __builtin_amdgcn_s_sleep(1);
        if ((++sp & 255u) == 0u) { if (xb_ld(&bar[XB_TMO])) break; if (sp > XB_SPIN_CAP) { atomicAdd(&bar[XB_TMO], 1u); break; } }
    }
    nloc = mine > 0u ? mine : 1u; nx = cnt > 0u ? cnt : 1u;
}

__device__ __forceinline__ void xcd_barrier(const XcdBarrier& b) {
    asm volatile("s_waitcnt vmcnt(0)" ::: "memory");
    __syncthreads();
    if (threadIdx.x == 0) {
        unsigned* bar = b.bar;
        __builtin_amdgcn_s_waitcnt(0);
        unsigned nloc = b.st[0], nx = b.st[1];
        if (nloc == 0u) { xcd_barrier_complete(bar, b.x, nloc, nx); b.st[0] = nloc; b.st[1] = nx; }
        const unsigned old = xb_add(&bar[XB_XSUB(b.x)], 1u);
        const unsigned gen = old / nloc;
        if (old + 1u == (gen + 1u) * nloc) {
            __builtin_amdgcn_fence(__ATOMIC_RELEASE, "agent");
            asm volatile("s_waitcnt vmcnt(0)" ::: "memory");
            const unsigned og = xb_add(&bar[XB_TOP], 1u);
            const unsigned tg = og / nx;
            if (og + 1u == (tg + 1u) * nx) xb_add(&bar[XB_TOPGEN], 1u);
            else XB_SPIN(xb_ld(&bar[XB_TOPGEN]) == tg, bar);
            __builtin_amdgcn_fence(__ATOMIC_ACQUIRE, "agent");
            xb_add(&bar[XB_XGEN(b.x)], 1u);
            asm volatile("s_waitcnt vmcnt(0)" ::: "memory");
        } else {
            XB_SPIN(xb_ld(&bar[XB_XGEN(b.x)]) == gen, bar);
            __builtin_amdgcn_fence(__ATOMIC_ACQUIRE, "agent");
            asm volatile("s_waitcnt vmcnt(0)" ::: "memory");
        }
    }
    __syncthreads();
}
struct Frame {
    LAS unsigned char* lds;
    volatile LAS unsigned* MISC;
    unsigned* ctl;
    unsigned char* ws;
    int tid, lane, wave;
    int G;
    const float* in[19];
    float* out;
};
enum { IN_X = 0, IN_MEM, IN_POS, IN_LNG, IN_LNB, IN_WGU, IN_WD, IN_WIN, IN_WOUT, IN_GCQ, IN_GCKV, IN_WUQ, IN_WUKV, IN_PE, IN_W1, IN_W2, IN_MWQ, IN_MWKV, IN_MWO };

__device__ __forceinline__ float wave_sum(float v) {
#pragma unroll
    for (int o = 1; o < 64; o <<= 1) v += __shfl_xor(v, o);
    return v;
}
__device__ __forceinline__ float wave_max(float v) {
#pragma unroll
    for (int o = 1; o < 64; o <<= 1) v = fmaxf(v, __shfl_xor(v, o));
    return v;
}
__device__ __forceinline__ half8 pack_h8(f32x4 a, f32x4 b) {
    half8 r; r[0] = (h16)a[0]; r[1] = (h16)a[1]; r[2] = (h16)a[2]; r[3] = (h16)a[3]; r[4] = (h16)b[0]; r[5] = (h16)b[1]; r[6] = (h16)b[2]; r[7] = (h16)b[3]; return r;
}

struct EpiSwiglu {
    static constexpr bool PERM = true, AFTER_DRAIN = false;
    h16* H;
    __device__ __forceinline__ void operator()(const f32x4 (&acc)[2][2][4][2], const pg8::Unit& u, int wr, int wc, int fr, int fq) const {
        const int row0 = u.pm * 256 + wr * 64 + fr, col0 = u.pn * 128 + wc * 32 + 8 * fq;
#pragma unroll
        for (int ai = 0; ai < 2; ++ai)
#pragma unroll
            for (int m = 0; m < 4; ++m) {
                f32x4 o[2];
#pragma unroll
                for (int n = 0; n < 2; ++n)
#pragma unroll
                    for (int j = 0; j < 4; ++j) { const float g = acc[ai][0][m][n][j], uu = acc[ai][1][m][n][j]; o[n][j] = g * __builtin_amdgcn_rcpf(1.0f + __expf(-g)) * uu; }
                *(half8*)(H + (size_t)(row0 + ai * 128 + m * 16) * DFF + col0) = pack_h8(o[0], o[1]);
            }
    }
};
struct EpiResid {
    static constexpr bool PERM = false, AFTER_DRAIN = false;
    const float* xf; float* z; float s;
    __device__ __forceinline__ void operator()(const f32x4 (&acc)[2][2][4][2], const pg8::Unit& u, int wr, int wc, int fr, int fq) const {
        const int row0 = u.pm * 256 + wr * 64 + fr, col0 = u.pn * 256 + wc * 32 + 4 * fq;
#pragma unroll
        for (int ai = 0; ai < 2; ++ai)
#pragma unroll
            for (int m = 0; m < 4; ++m) { const size_t off = (size_t)(row0 + ai * 128 + m * 16) * DM + col0;
#pragma unroll
                for (int bj = 0; bj < 2; ++bj)
#pragma unroll
                    for (int n = 0; n < 2; ++n) { const f32x4 xv = *(const f32x4*)(xf + off + bj * 128 + n * 16); *(f32x4*)(z + off + bj * 128 + n * 16) = xv * DN_ALPHA + acc[ai][bj][m][n] * s; } }
    }
};

enum { JOB_WIN = 0, JOB_UQ, JOB_UKV, JOB_Y, JOB_MQ, JOB_MKV };
struct WaveDst { h16* p0; h16* p1; int ld; int colA, colB; int rope; h16* raw; float* f32p; float* ssq; int ssq_part; bool none; };
template <int JOB> __device__ __forceinline__ WaveDst proj_dst(unsigned char* ws, int t, int wc, int fq, int aux) {
    WaveDst d; d.p0 = nullptr; d.p1 = nullptr; d.ld = 128; d.rope = 0; d.raw = nullptr; d.f32p = nullptr; d.ssq = nullptr; d.ssq_part = 0; d.none = false;
    const int cp = wc * 32 + 8 * fq;
    d.colA = cp & 63; d.colB = cp & 63;
    const int hs = wc >> 1;
    if constexpr (JOB == JOB_WIN) {
        if (t < 11) {
            d.rope = 1; d.colB = d.colA + 64;
            size_t base;
            if (t < 2) base = WS_AQ + (size_t)(2 * t + hs) * HEADBUF;
            else if (t < 4) base = WS_AK + (size_t)(2 * (t - 2) + hs) * HEADBUF;
            else if (t < 6) { base = WS_CQROPE + (size_t)(2 * (t - 4) + hs) * HEADBUF; d.raw = (h16*)(ws + WS_CQRAW + (size_t)(2 * (t - 4) + hs) * HEADBUF); }
            else if (t == 6) base = hs ? WS_KWIN : WS_KSLC;
            else if (t < 9) base = WS_DQ + (size_t)(2 * (t - 7) + hs) * HEADBUF;
            else base = WS_DK + (size_t)(2 * (t - 9) + hs) * HEADBUF;
            d.p0 = d.p1 = (h16*)(ws + base);
        } else if (t < 15) {
            d.rope = 2; d.colA = cp & 31; d.colB = d.colA + 32; d.ld = 1024;
            d.p0 = d.p1 = (h16*)(ws + WS_IQ) + (4 * (t - 11) + wc) * 64;
        } else if (t == 15) {
            d.colA = cp & 31; d.colB = d.colA + 32; d.ld = 64;
            if (wc == 0) { d.rope = 2; d.p0 = d.p1 = (h16*)(ws + WS_BKR); }
            else if (wc == 1) { d.rope = 2; d.p0 = d.p1 = (h16*)(ws + WS_IK); }
            else if (wc == 2) { d.f32p = (float*)(ws + WS_SMALL); d.ld = 32; }
            else d.none = true;
        } else {
            if (t < 18) { const int h0 = 2 * (t - 16); d.p0 = (h16*)(ws + WS_AV + (size_t)h0 * HEADBUF) + 64 * hs; d.p1 = (h16*)(ws + WS_AV + (size_t)(h0 + 1) * HEADBUF) + 64 * hs; }
            else if (t < 20) { d.ld = 512; d.p0 = (h16*)(ws + WS_BCQ) + 256 * (t - 18) + 64 * hs; d.p1 = d.p0 + 128; d.ssq = (float*)(ws + WS_SSQQ); d.ssq_part = (t - 18) * 4 + wc; }
            else if (t < 22) { d.ld = 512; d.p0 = (h16*)(ws + WS_BCKV) + 256 * (t - 20) + 64 * hs; d.p1 = d.p0 + 128; d.ssq = (float*)(ws + WS_SSQKV); d.ssq_part = (t - 20) * 4 + wc; }
            else if (t == 22) { d.p0 = (h16*)(ws + WS_KCMP) + 64 * hs; d.p1 = (h16*)(ws + WS_VCMP) + 64 * hs; }
            else if (t == 23) { d.p0 = (h16*)(ws + WS_VSLC) + 64 * hs; d.p1 = (h16*)(ws + WS_VWIN) + 64 * hs; }
            else { const int h0 = 2 * (t - 24); d.p0 = (h16*)(ws + WS_DV + (size_t)h0 * HEADBUF) + 64 * hs; d.p1 = (h16*)(ws + WS_DV + (size_t)(h0 + 1) * HEADBUF) + 64 * hs; }
        }
    } else if constexpr (JOB == JOB_UQ) {
        d.ld = 192;
        if (t < 2) { d.p0 = (h16*)(ws + WS_Q192) + (size_t)(2 * t) * S * 192 + 64 * hs; d.p1 = (h16*)(ws + WS_Q192) + (size_t)(2 * t + 1) * S * 192 + 64 * hs; }
        else { d.rope = 2; d.colA = cp & 31; d.colB = d.colA + 32; d.p0 = d.p1 = (h16*)(ws + WS_Q192) + (size_t)wc * S * 192 + 128; }
        d.ssq = (float*)(ws + WS_SSQQ);
    } else if constexpr (JOB == JOB_UKV) {
        d.p0 = (h16*)(ws + WS_KN + (size_t)t * HEADBUF) + 64 * hs; d.p1 = (h16*)(ws + WS_BV + (size_t)t * HEADBUF) + 64 * hs;
        d.ssq = (float*)(ws + WS_SSQKV);
    } else if constexpr (JOB == JOB_Y) {
        d.f32p = (float*)(ws + (aux ? WS_YV : WS_YK)); d.ld = 256;
    } else if constexpr (JOB == JOB_MQ) {
        d.p0 = (h16*)(ws + WS_MQ + (size_t)(2 * t) * HEADBUF) + 64 * hs; d.p1 = (h16*)(ws + WS_MQ + (size_t)(2 * t + 1) * HEADBUF) + 64 * hs;
    } else {
        const int layer = t >> 2, tt = t & 3, h0 = 2 * (tt & 1);
        const size_t kb = (tt >> 1) ? WS_MV : WS_MK;
        d.p0 = (h16*)(ws + kb) + (size_t)((layer * 4 + h0) * MEMLEN) * 128 + 64 * hs; d.p1 = (h16*)(ws + kb) + (size_t)((layer * 4 + h0 + 1) * MEMLEN) * 128 + 64 * hs;
    }
    return d;
}
template <int JOB> struct EpiProj {
    static constexpr bool PERM = true, AFTER_DRAIN = false;
    unsigned char* ws; int aux;
    __device__ __forceinline__ void operator()(const f32x4 (&acc)[2][2][4][2], const pg8::Unit& u, int wr, int wc, int fr, int fq) const {
        const WaveDst d = proj_dst<JOB>(ws, u.pn, wc, fq, aux);
        if (d.none) return;
        const int row0 = u.pm * 256 + wr * 64 + fr;
        const float* tc = (const float*)(ws + (d.rope == 1 ? WS_T128C : WS_T64C)); const float* ts = (const float*)(ws + (d.rope == 1 ? WS_T128S : WS_T64S));
        const int tw = d.rope == 1 ? 64 : 32;
#pragma unroll
        for (int ai = 0; ai < 2; ++ai)
#pragma unroll
            for (int m = 0; m < 4; ++m) {
                const int row = row0 + ai * 128 + m * 16;
                f32x4 a0 = acc[ai][0][m][0], a1 = acc[ai][0][m][1], b0 = acc[ai][1][m][0], b1 = acc[ai][1][m][1];
                if constexpr (JOB == JOB_UQ || JOB == JOB_UKV) {
                    const f32x4 s0 = *(const f32x4*)(d.ssq + (size_t)row * 8), s1 = *(const f32x4*)(d.ssq + (size_t)row * 8 + 4);
                    const float ss = ((s0[0] + s0[1]) + (s0[2] + s0[3])) + ((s1[0] + s1[1]) + (s1[2] + s1[3]));
                    const float rs = 1.0f / sqrtf(ss * (1.0f / 512.0f) + RMS_EPS);
                    a0 = a0 * rs; a1 = a1 * rs; b0 = b0 * rs; b1 = b1 * rs;
                }
                if constexpr (JOB == JOB_WIN) {
                    if (d.ssq) {
                        float q = 0.f;
#pragma unroll
                        for (int j = 0; j < 4; ++j) q += a0[j] * a0[j] + a1[j] * a1[j] + b0[j] * b0[j] + b1[j] * b1[j];
                        q += __shfl_xor(q, 16); q += __shfl_xor(q, 32);
                        if (fq == 0) d.ssq[(size_t)row * 8 + d.ssq_part] = q;
                    }
                    if (d.raw) { *(half8*)(d.raw + (size_t)row * 128 + d.colA) = pack_h8(a0, a1); *(half8*)(d.raw + (size_t)row * 128 + d.colB) = pack_h8(b0, b1); }
                }
                if (d.f32p) {
                    if constexpr (JOB == JOB_Y) { float* p = d.f32p + (size_t)row * 256 + wc * 32 + 8 * fq; *(f32x4*)p = a0; *(f32x4*)(p + 4) = a1; *(f32x4*)(p + 128) = b0; *(f32x4*)(p + 132) = b1; }
                    else { float* p = d.f32p + (size_t)row * 32 + d.colA; *(f32x4*)p = a0; *(f32x4*)(p + 4) = a1; }
                    continue;
                }
                if (d.rope) {
                    const size_t ti = (size_t)row * tw + d.colA;
                    const f32x4 c0 = *(const f32x4*)(tc + ti), c1 = *(const f32x4*)(tc + ti + 4), s0 = *(const f32x4*)(ts + ti), s1 = *(const f32x4*)(ts + ti + 4);
                    const f32x4 o0 = a0 * c0 - b0 * s0, o1 = a1 * c1 - b1 * s1, q0 = a0 * s0 + b0 * c0, q1 = a1 * s1 + b1 * c1;
                    a0 = o0; a1 = o1; b0 = q0; b1 = q1;
                }
                *(half8*)(d.p0 + (size_t)row * d.ld + d.colA) = pack_h8(a0, a1);
                *(half8*)(d.p1 + (size_t)row * d.ld + d.colB) = pack_h8(b0, b1);
            }
    }
};
__device__ __forceinline__ int win_map(int np) {
    const int t = np >> 8, c = np & 255;
    if (t < 11) {
        const int slot = (c >> 6) & 1, d = (c & 63) + 64 * (c >> 7);
        int base;
        if (t < 2) base = 0 + 256 * t + 128 * slot;
        else if (t < 4) base = 512 + 256 * (t - 2) + 128 * slot;
        else if (t < 6) base = 2624 + 256 * (t - 4) + 128 * slot;
        else if (t == 6) base = slot ? 3648 : 3392;
        else if (t < 9) base = 3916 + 256 * (t - 7) + 128 * slot;
        else base = 4428 + 256 * (t - 9) + 128 * slot;
        return base + d;
    }
    if (t < 15) { const int head = (c >> 5) & 3, d = (c & 31) + 32 * (c >> 7); return 5452 + 64 * (4 * (t - 11) + head) + d; }
    if (t == 15) {
        const int head = (c >> 5) & 3, half = c >> 7, d = (c & 31) + 32 * half;
        if (head == 0) return 2560 + d;
        if (head == 1) return 6476 + d;
        if (head == 2) { if (half) return -1; if (d < 12) return 3904 + d; if (d < 28) return 6540 + (d - 12); return -1; }
        return -1;
    }
    if (t < 18) return 1024 + 256 * (t - 16) + c;
    if (t < 20) return 1536 + 256 * (t - 18) + c;
    if (t < 22) return 2048 + 256 * (t - 20) + c;
    if (t == 22) return 3136 + c;
    if (t == 23) return c < 128 ? 3520 + c : 3776 + (c - 128);
    return 4940 + 256 * (t - 24) + c;
}
__device__ __forceinline__ int uq_map(int np) {
    const int t = np >> 8, c = np & 255;
    if (t < 2) { const int slot = c >> 6, head = 2 * t + (slot >> 1), d = 64 * (slot & 1) + (c & 63); return head * 192 + d; }
    const int head = (c >> 5) & 3, d = (c & 31) + 32 * (c >> 7); return head * 192 + 128 + d;
}
enum { WK_GU0 = 0, WK_GU1, WK_D0, WK_D1, WK_IN, WK_OUT, WK_UQ, WK_UKV, WK_C1K, WK_C1V, WK_MQ, WK_MKV, WK_MO, WK_N };
struct WJob { const float* W; h16* dst; int K, NP, kind; const float* kscale; };
__device__ __forceinline__ long wsrc(int kind, int k, int np) {
    switch (kind) {
        case WK_GU0: case WK_GU1: { const int pn = np >> 8, c = np & 255; const int col = c < 128 ? 128 * pn + c : DFF + 128 * pn + (c - 128); return (long)k * (2 * DFF) + col; }
        case WK_D0: case WK_D1: return (long)k * DM + np;
        case WK_IN: { const int col = win_map(np); return col < 0 ? -1 : (long)k * D_IN + col; }
        case WK_OUT: return (long)k * DM + np;
        case WK_UQ: return (long)k * 768 + uq_map(np);
        case WK_UKV: return (long)k * 1024 + np;
        case WK_C1K: case WK_C1V: return (long)((np >> 7) * 2048 + k) * 128 + (np & 127);
        case WK_MQ: return (long)k * 512 + np;
        case WK_MKV: return (long)k * 1024 + np;
        default: return (long)k * DM + np;
    }
}
__device__ __forceinline__ void p0_transpose_item(const WJob& J, LAS float* scr, int item, int lane) {
    const int nblk = J.NP / 32, kb = item / nblk, nb = item % nblk, k0 = 64 * kb, n0 = 32 * nb;
#pragma unroll 8
    for (int i = 0; i < 32; ++i) { const int kk = 2 * i + (lane >> 5); const long so = wsrc(J.kind, k0 + kk, n0 + (lane & 31));
        float v = so >= 0 ? J.W[so] : 0.f; if (J.kscale) v *= J.kscale[k0 + kk]; scr[kk * 33 + (lane & 31)] = v; }
    LDS_WAIT(); asm volatile("" ::: "memory");
    const int c = lane & 7;
#pragma unroll
    for (int j = 0; j < 4; ++j) { const int n = (lane >> 3) + 8 * j; const LAS float* s = scr + (8 * c) * 33 + n;
        half8 o; o[0] = (h16)s[0]; o[1] = (h16)s[33]; o[2] = (h16)s[66]; o[3] = (h16)s[99]; o[4] = (h16)s[132]; o[5] = (h16)s[165]; o[6] = (h16)s[198]; o[7] = (h16)s[231];
        *(half8*)(J.dst + (size_t)(n0 + n) * J.K + k0 + 8 * c) = o; }
    LDS_WAIT(); asm volatile("" ::: "memory");
}
constexpr int WK_ITEMS[WK_N] = { 2 * DFF * DM / 2048, 2 * DFF * DM / 2048, DM * DFF / 2048, DM * DFF / 2048, NIN * DM / 2048, DM * DM / 2048, 768 * 512 / 2048, 1024 * 512 / 2048,
                                 256 * 2048 / 2048, 256 * 2048 / 2048, 512 * DM / 2048, 1024 * DM / 2048, DM * 512 / 2048 };
constexpr int wk_items_per_layer() { int s = 0; for (int i = 0; i < WK_N; ++i) s += WK_ITEMS[i]; return s; }
constexpr int IPL = wk_items_per_layer();
__device__ __forceinline__ WJob wjob(Frame& F, int l, int kind) {
    WJob J; J.kind = kind; J.kscale = nullptr;
    unsigned char* ws = F.ws;
    switch (kind) {
        case WK_GU0: case WK_GU1: { const int f = kind - WK_GU0; J.W = F.in[IN_WGU] + (size_t)(l * 2 + f) * DM * 2 * DFF; J.dst = (h16*)(ws + WS_WGU) + (size_t)(l * 2 + f) * 2 * DFF * DM; J.K = DM; J.NP = 2 * DFF; break; }
        case WK_D0: case WK_D1: { const int f = kind - WK_D0; J.W = F.in[IN_WD] + (size_t)(l * 2 + f) * DFF * DM; J.dst = (h16*)(ws + WS_WD) + (size_t)(l * 2 + f) * DM * DFF; J.K = DFF; J.NP = DM; break; }
        case WK_IN: J.W = F.in[IN_WIN] + (size_t)l * DM * D_IN; J.dst = (h16*)(ws + WS_WIN) + (size_t)l * NIN * DM; J.K = DM; J.NP = NIN; break;
        case WK_OUT: J.W = F.in[IN_WOUT] + (size_t)l * DM * DM; J.dst = (h16*)(ws + WS_WOUT) + (size_t)l * DM * DM; J.K = DM; J.NP = DM; break;
        case WK_UQ: J.W = F.in[IN_WUQ] + (size_t)l * 512 * 768; J.dst = (h16*)(ws + WS_WUQ) + (size_t)l * 768 * 512; J.K = 512; J.NP = 768; J.kscale = F.in[IN_GCQ] + l * 512; break;
        case WK_UKV: J.W = F.in[IN_WUKV] + (size_t)l * 512 * 1024; J.dst = (h16*)(ws + WS_WUKV) + (size_t)l * 1024 * 512; J.K = 512; J.NP = 1024; J.kscale = F.in[IN_GCKV] + l * 512; break;
        case WK_C1K: case WK_C1V: { const int i = kind - WK_C1K; J.W = F.in[IN_W1] + (size_t)(l * 2 + i) * 4096 * 128; J.dst = (h16*)(ws + WS_WC1) + (size_t)(l * 2 + i) * 256 * 2048; J.K = 2048; J.NP = 256; break; }
        case WK_MQ: J.W = F.in[IN_MWQ] + (size_t)l * DM * 512; J.dst = (h16*)(ws + WS_WMQ) + (size_t)l * 512 * DM; J.K = DM; J.NP = 512; break;
        case WK_MKV: J.W = F.in[IN_MWKV] + (size_t)l * DM * 1024; J.dst = (h16*)(ws + WS_WMKV) + (size_t)l * 1024 * DM; J.K = DM; J.NP = 1024; break;
        default: J.W = F.in[IN_MWO] + (size_t)l * 512 * DM; J.dst = (h16*)(ws + WS_WMO) + (size_t)l * DM * 512; J.K = 512; J.NP = DM; break;
    }
    return J;
}
__device__ __forceinline__ void sincos_d(double a, float& sn, float& cs) {
    const double k = __builtin_rint(a * 0.63661977236758134308);
    double r = __builtin_fma(-k, 1.57079632679489655800e+00, a); r = __builtin_fma(-k, 6.12323399573676603587e-17, r);
    const double r2 = r * r;
    double s = -1.0 / 1307674368000.0; s = s * r2 + 1.0 / 6227020800.0; s = s * r2 - 1.0 / 39916800.0; s = s * r2 + 1.0 / 362880.0; s = s * r2 - 1.0 / 5040.0; s = s * r2 + 1.0 / 120.0; s = s * r2 - 1.0 / 6.0; s = s * r2 * r + r;
    double c = 1.0 / 20922789888000.0; c = c * r2 - 1.0 / 87178291200.0; c = c * r2 + 1.0 / 479001600.0; c = c * r2 - 1.0 / 3628800.0; c = c * r2 + 1.0 / 40320.0; c = c * r2 - 1.0 / 720.0; c = c * r2 + 1.0 / 24.0; c = c * r2 - 0.5; c = c * r2 + 1.0;
    const int q = ((int)k) & 3;
    const double ss = (q == 0) ? s : (q == 1) ? c : (q == 2) ? -s : -c;
    const double cc = (q == 0) ? c : (q == 1) ? -s : (q == 2) ? -c : s;
    sn = (float)ss; cs = (float)cc;
}
__device__ __forceinline__ void p0_prologue(Frame& F) { int lane = F.lane; asm volatile("" : "+v"(lane));
    LAS float* scr = (LAS float*)(F.lds + F.wave * 16384);
    const int gw = blockIdx.x * NWAVES + F.wave, NGW = F.G * NWAVES;
    for (int it = gw; it < DEPTH * IPL; it += NGW) {
        const int l = it / IPL; int r = it % IPL; int kind = 0;
#pragma unroll
        for (int k = 0; k < WK_N; ++k) { if (kind == k && r >= WK_ITEMS[k]) { r -= WK_ITEMS[k]; kind = k + 1; } }
        const WJob J = wjob(F, l, kind);
        p0_transpose_item(J, scr, r, lane);
    }
    const int* pos = (const int*)F.in[IN_POS];
    for (int m = gw; m < S; m += NGW) {
        const f32x4* xr = (const f32x4*)(F.in[IN_X] + (size_t)m * DM) + lane;
        f32x4* xo = (f32x4*)((float*)(F.ws + WS_XF) + (size_t)m * DM) + lane;
        half4* xh = (half4*)((h16*)(F.ws + WS_XH) + (size_t)m * DM) + lane;
#pragma unroll
        for (int j = 0; j < 8; ++j) { const f32x4 v = xr[64 * j]; xo[64 * j] = v; half4 h; h[0] = (h16)v[0]; h[1] = (h16)v[1]; h[2] = (h16)v[2]; h[3] = (h16)v[3]; xh[64 * j] = h; }
        const double p = (double)pos[m];
        float sn, cs; sincos_d(p * ROPE_INV[lane], sn, cs);
        ((float*)(F.ws + WS_T128C))[(size_t)m * 64 + lane] = cs; ((float*)(F.ws + WS_T128S))[(size_t)m * 64 + lane] = sn;
        if ((lane & 1) == 0) { ((float*)(F.ws + WS_T64C))[(size_t)m * 32 + (lane >> 1)] = cs; ((float*)(F.ws + WS_T64S))[(size_t)m * 32 + (lane >> 1)] = sn; }
    }
    for (int m = gw; m < MEMLEN; m += NGW) {
        const f32x4* xr = (const f32x4*)(F.in[IN_MEM] + (size_t)m * DM) + lane;
        half4* xh = (half4*)((h16*)(F.ws + WS_MEMH) + (size_t)m * DM) + lane;
#pragma unroll
        for (int j = 0; j < 8; ++j) { const f32x4 v = xr[64 * j]; half4 h; h[0] = (h16)v[0]; h[1] = (h16)v[1]; h[2] = (h16)v[2]; h[3] = (h16)v[3]; xh[64 * j] = h; }
    }
    for (int i = gw * 64 + lane; i < 16 * DM; i += NGW * 64) { ((float*)(F.ws + WS_LNG))[i] = F.in[IN_LNG][i]; ((float*)(F.ws + WS_LNB))[i] = F.in[IN_LNB][i]; }
    for (int i = gw * 64 + lane; i < 8 * 128 * 128; i += NGW * 64) ((float*)(F.ws + WS_W2C))[i] = F.in[IN_W2][i];
    for (int it = gw; it < DEPTH * 2 * 8; it += NGW) {
        const int li = it >> 3, n = (it & 7) * 16 + (lane & 15), kq = lane >> 4;
        const float* pe = F.in[IN_PE] + (size_t)li * 4096; const float* w1 = F.in[IN_W1] + (size_t)li * 4096 * 128;
        float a = 0.f;
        for (int k = kq; k < 4096; k += 4) a += pe[k] * w1[(size_t)k * 128 + n];
        a += __shfl_xor(a, 16); a += __shfl_xor(a, 32);
        if (kq == 0) ((float*)(F.ws + WS_CBIAS))[li * 128 + n] = a;
    }
}
__device__ __forceinline__ void ln_phase(Frame& F, const float* z, const float* g, const float* b, float* of, h16* oh) { int lane = F.lane; asm volatile("" : "+v"(lane));
    const int gw = blockIdx.x * NWAVES + F.wave, NGW = F.G * NWAVES;
    f32x4 gv[8], bv[8];
#pragma unroll
    for (int j = 0; j < 8; ++j) { gv[j] = ((const f32x4*)g)[lane + 64 * j]; bv[j] = ((const f32x4*)b)[lane + 64 * j]; }
    for (int m = gw; m < S; m += NGW) {
        const f32x4* zr = (const f32x4*)(z + (size_t)m * DM) + lane;
        f32x4 v[8]; float s = 0.f;
#pragma unroll
        for (int j = 0; j < 8; ++j) { v[j] = zr[64 * j]; s += (v[j][0] + v[j][1]) + (v[j][2] + v[j][3]); }
        const float mean = wave_sum(s) * (1.f / DM); float s2 = 0.f;
#pragma unroll
        for (int j = 0; j < 8; ++j) { v[j] = v[j] - mean; s2 += (v[j][0] * v[j][0] + v[j][1] * v[j][1]) + (v[j][2] * v[j][2] + v[j][3] * v[j][3]); }
        const float rstd = 1.f / sqrtf(wave_sum(s2) * (1.f / DM) + LN_EPS);
        f32x4* orow = (f32x4*)(of + (size_t)m * DM) + lane; half4* hrow = (half4*)(oh + (size_t)m * DM) + lane;
#pragma unroll
        for (int j = 0; j < 8; ++j) { const f32x4 o = v[j] * rstd * gv[j] + bv[j]; orow[64 * j] = o; half4 h; h[0] = (h16)o[0]; h[1] = (h16)o[1]; h[2] = (h16)o[2]; h[3] = (h16)o[3]; hrow[64 * j] = h; }
    }
}
struct AttnAcc { float m, l, o0, o1; };
__device__ __forceinline__ void attn_init(AttnAcc& a) { a.m = -1e30f; a.l = 0.f; a.o0 = 0.f; a.o1 = 0.f; }
__device__ __forceinline__ float dot_h(const LAS float* qs, const h16* krow, int n16) {
    float acc = 0.f;
#pragma unroll 4
    for (int j = 0; j < n16; ++j) { const half8 w = *(const half8*)(krow + 8 * j); const f32x4 qa = *(const LAS f32x4*)(qs + 8 * j), qb = *(const LAS f32x4*)(qs + 8 * j + 4);
        acc += (float)w[0] * qa[0] + (float)w[1] * qa[1] + (float)w[2] * qa[2] + (float)w[3] * qa[3] + (float)w[4] * qb[0] + (float)w[5] * qb[1] + (float)w[6] * qb[2] + (float)w[7] * qb[3]; }
    return acc;
}
__device__ __forceinline__ void attn_chunk(AttnAcc& a, int key, float logit, const h16* V, int ldv, int lane) {
    const bool valid = key >= 0;
    const float lg = valid ? logit : -__builtin_inff();
    const float cmax = wave_max(lg);
    if (cmax == -__builtin_inff()) return;
    const float mn = fmaxf(a.m, cmax), alpha = __expf(a.m - mn);
    const float p = valid ? __expf(lg - mn) : 0.f;
    a.l = a.l * alpha + wave_sum(p); a.o0 *= alpha; a.o1 *= alpha; a.m = mn;
    u64 mask = __ballot(valid);
    while (mask) { const int j = __builtin_ctzll(mask); mask &= mask - 1;
        const float pj = __builtin_bit_cast(float, __builtin_amdgcn_readlane(__builtin_bit_cast(int, p), j)); const int kj = __builtin_amdgcn_readlane(key, j);
        const half2v v = *(const half2v*)(V + (size_t)kj * ldv + 2 * lane);
        a.o0 += pj * (float)v[0]; a.o1 += pj * (float)v[1]; }
}
__device__ __forceinline__ void load_q(LAS float* qs, const h16* q, int nd, int lane) {
    for (int i = lane; i < nd / 2; i += 64) { const half2v v = *(const half2v*)(q + 2 * i); qs[2 * i] = (float)v[0]; qs[2 * i + 1] = (float)v[1]; }
    LDS_WAIT(); asm volatile("" ::: "memory");
}
__device__ __forceinline__ void store_o(h16* dst, const AttnAcc& a, int lane) {
    const float inv = a.l > 0.f ? 1.0f / a.l : 0.f; half2v o; o[0] = (h16)(a.o0 * inv); o[1] = (h16)(a.o1 * inv); *(half2v*)(dst + 2 * lane) = o;
}
#define WAVE_ITEMS(it, total) for (int it = blockIdx.x * NWAVES + F.wave; it < (total); it += F.G * NWAVES)
constexpr float SC128 = 0.08838834764831845f, SC192 = 0.07216878364870323f;

__device__ __forceinline__ void moba_kmean_phase(Frame& F) { int lane = F.lane; asm volatile("" : "+v"(lane));
    WAVE_ITEMS(it, 4 * 32) { const int h = it >> 5, n = it & 31; const h16* k = (const h16*)(F.ws + WS_AK + (size_t)h * HEADBUF) + (size_t)n * 256 * 128 + 2 * lane;
        float s0 = 0.f, s1 = 0.f;
        for (int r = 0; r < 256; ++r) { const half2v v = *(const half2v*)(k + (size_t)r * 128); s0 += (float)v[0]; s1 += (float)v[1]; }
        float* o = (float*)(F.ws + WS_KMEAN) + (size_t)it * 128 + 2 * lane; o[0] = s0 * (1.f / 256.f); o[1] = s1 * (1.f / 256.f); }
}
__device__ __forceinline__ float gelu_tanh(float x) { const float u = 0.7978845608028654f * (x + 0.044715f * x * x * x); return 0.5f * x * (1.0f + tanhf(u)); }
__device__ __forceinline__ void nsa_cmp2_phase(Frame& F, int l) { int lane = F.lane; asm volatile("" : "+v"(lane));
    LAS float* hs = (LAS float*)(F.lds + F.wave * 16384);
    WAVE_ITEMS(it, 2 * 511) { const int br = it / 511, i = it % 511;
        const float* Y = (const float*)(F.ws + (br ? WS_YV : WS_YK)); const float* cb = (const float*)(F.ws + WS_CBIAS) + (l * 2 + br) * 128;
        const float* w2 = (const float*)(F.ws + WS_W2C) + (size_t)(l * 2 + br) * 128 * 128;
#pragma unroll
        for (int e = 0; e < 2; ++e) { const int n = lane + 64 * e; hs[n] = gelu_tanh(Y[(size_t)i * 256 + n] + Y[(size_t)(i + 1) * 256 + 128 + n] + cb[n]); }
        LDS_WAIT(); asm volatile("" ::: "memory");
        float o0 = 0.f, o1 = 0.f;
        for (int k = 0; k < 128; ++k) { const float hv = hs[k]; o0 += hv * w2[k * 128 + lane]; o1 += hv * w2[k * 128 + 64 + lane]; }
        float* o = (float*)(F.ws + (br ? WS_VC : WS_KC)) + (size_t)i * 128; o[lane] = o0; o[64 + lane] = o1;
        h16* o16 = (h16*)(F.ws + (br ? WS_VC16 : WS_KC16)) + (size_t)i * 128; o16[lane] = (h16)o0; o16[64 + lane] = (h16)o1;
        if (i == 510) { o16[128 + lane] = (h16)0.f; o16[192 + lane] = (h16)0.f; }
        LDS_WAIT(); asm volatile("" ::: "memory"); }
}
__device__ __forceinline__ void moba_gate_phase(Frame& F) { int lane = F.lane; asm volatile("" : "+v"(lane));
    WAVE_ITEMS(it, S * 4) { const int t = it >> 2, h = it & 3, cur = t >> 8;
        int* sel = (int*)(F.ws + WS_MOBASEL) + (size_t)t * 16 + h * 4;
        const int n = lane & 31; float g = -__builtin_inff();
        if (n < cur) { const h16* q = (const h16*)(F.ws + WS_AQ + (size_t)h * HEADBUF) + (size_t)t * 128; const float* km = (const float*)(F.ws + WS_KMEAN) + (size_t)(h * 32 + n) * 128;
            float a = 0.f;
            for (int d = 0; d < 128; d += 8) { const half8 qv = *(const half8*)(q + d); const f32x4 k0 = *(const f32x4*)(km + d), k1 = *(const f32x4*)(km + d + 4);
                a += (float)qv[0] * k0[0] + (float)qv[1] * k0[1] + (float)qv[2] * k0[2] + (float)qv[3] * k0[3] + (float)qv[4] * k1[0] + (float)qv[5] * k1[1] + (float)qv[6] * k1[2] + (float)qv[7] * k1[3]; }
            g = a; }
        if (lane >= 32) g = -__builtin_inff();
#pragma unroll
        for (int r = 0; r < 3; ++r) { const float mx = wave_max(g); int idx = -1;
            if (mx > -__builtin_inff()) { const u64 bm = __ballot(g == mx); idx = __builtin_ctzll(bm); if (lane == idx) g = -__builtin_inff(); }
            if (lane == 0) sel[r] = idx; }
    }
}
__device__ __forceinline__ void dsa_score_phase(Frame& F) { int lane = F.lane; asm volatile("" : "+v"(lane));
    LAS float* qs = (LAS float*)(F.lds + F.wave * 16384);
    WAVE_ITEMS(t, S) {
        const h16* iq = (const h16*)(F.ws + WS_IQ) + (size_t)t * 1024;
#pragma unroll
        for (int e = 0; e < 2; ++e) { const half8 v = *(const half8*)(iq + (lane + 64 * e) * 8);
#pragma unroll
            for (int j = 0; j < 8; ++j) qs[(lane + 64 * e) * 8 + j] = (float)v[j]; }
        if (lane < 16) qs[1024 + lane] = ((const float*)(F.ws + WS_SMALL))[(size_t)t * 32 + 12 + lane] * (0.25f * 0.125f);
        LDS_WAIT(); asm volatile("" ::: "memory");
        float* sc = (float*)(F.ws + WS_SCORES) + (size_t)t * S;
        for (int c = 0; c * 64 <= t; ++c) { const int s = c * 64 + lane; const h16* ik = (const h16*)(F.ws + WS_IK) + (size_t)s * 64;
            float kv[64];
#pragma unroll
            for (int j = 0; j < 8; ++j) { const half8 v = *(const half8*)(ik + 8 * j);
#pragma unroll
                for (int e = 0; e < 8; ++e) kv[8 * j + e] = (float)v[e]; }
            float score = 0.f;
#pragma unroll 1
            for (int h = 0; h < 16; ++h) { float a = 0.f; const LAS float* qh = qs + h * 64;
#pragma unroll
                for (int d = 0; d < 64; d += 4) { const f32x4 q4 = *(const LAS f32x4*)(qh + d); a += q4[0] * kv[d] + q4[1] * kv[d + 1] + q4[2] * kv[d + 2] + q4[3] * kv[d + 3]; }
                score += qs[1024 + h] * fmaxf(a, 0.f); }
            sc[s] = score; }
        LDS_WAIT(); asm volatile("" ::: "memory");
    }
}
__device__ __forceinline__ void nsa_cmp_select_phase(Frame& F) { int lane = F.lane; asm volatile("" : "+v"(lane));
    LAS float* qs = (LAS float*)(F.lds + F.wave * 16384);
    LAS float* pp = qs + 256;
    const float* kc = (const float*)(F.ws + WS_KC); const float* vc = (const float*)(F.ws + WS_VC);
    WAVE_ITEMS(t, S) {
        const int nvis = t >= 31 ? ((t - 31) >> 4) + 1 : 0;
        float P[8];
#pragma unroll
        for (int c = 0; c < 8; ++c) P[c] = 0.f;
        for (int h = 0; h < 4; ++h) {
            load_q(qs, (const h16*)(F.ws + WS_CQRAW + (size_t)h * HEADBUF) + (size_t)t * 128, 128, lane);
            float lg[8]; float mx = -__builtin_inff();
#pragma unroll
            for (int c = 0; c < 8; ++c) { const int n = c * 64 + lane; lg[c] = -__builtin_inff();
                if (c * 64 < nvis) { const bool ok = n < nvis; const float* kr = kc + (size_t)(ok ? n : 0) * 128; float a = 0.f;
#pragma unroll 4
                    for (int d = 0; d < 128; d += 4) { const f32x4 k4 = *(const f32x4*)(kr + d); const f32x4 q4 = *(const LAS f32x4*)(qs + d); a += k4[0] * q4[0] + k4[1] * q4[1] + k4[2] * q4[2] + k4[3] * q4[3]; }
                    if (ok) lg[c] = a * SC128; }
                mx = fmaxf(mx, lg[c]); }
            mx = wave_max(mx);
            float o0 = 0.f, o1 = 0.f;
            if (nvis > 0) {
                float p[8]; float sum = 0.f;
#pragma unroll
                for (int c = 0; c < 8; ++c) { p[c] = lg[c] > -__builtin_inff() ? __expf(lg[c] - mx) : 0.f; sum += p[c]; }
                sum = wave_sum(sum); const float inv = 1.0f / sum;
#pragma unroll
                for (int c = 0; c < 8; ++c) { p[c] *= inv; P[c] += p[c];
                    if (c * 64 < nvis) { const int lim = min(64, nvis - c * 64);
                        for (int j = 0; j < lim; ++j) { const float pj = __builtin_bit_cast(float, __builtin_amdgcn_readlane(__builtin_bit_cast(int, p[c]), j)); const float* vr = vc + (size_t)(c * 64 + j) * 128;
                            o0 += pj * vr[lane]; o1 += pj * vr[64 + lane]; } } }
            }
            float* oc = (float*)(F.ws + WS_OCMP) + ((size_t)t * 4 + h) * 128; oc[lane] = o0; oc[64 + lane] = o1;
            LDS_WAIT(); asm volatile("" ::: "memory");
        }
#pragma unroll
        for (int c = 0; c < 8; ++c) { const int n = c * 64 + lane; if (n < 511) pp[n + 1] = P[c]; }
        if (lane == 0) { pp[0] = 0.f; pp[512] = 0.f; }
        LDS_WAIT(); asm volatile("" ::: "memory");
        const int cur = t >> 6;
        float v0, v1;
        { const int b = lane; float im = 0.f;
#pragma unroll
          for (int r = 0; r < 5; ++r) im += pp[4 * b + r];
          v0 = (b > cur) ? -__builtin_inff() : ((b == 0 || b == cur || b == cur - 1) ? __builtin_inff() : im); }
        { const int b = lane + 64; float im = 0.f;
#pragma unroll
          for (int r = 0; r < 5; ++r) im += pp[4 * b + r];
          v1 = (b > cur) ? -__builtin_inff() : ((b == cur || b == cur - 1) ? __builtin_inff() : im); }
        int* sel = (int*)(F.ws + WS_NSASEL) + (size_t)t * 16; unsigned m0 = 0, m1 = 0, m2 = 0, m3 = 0;
        for (int r = 0; r < 16; ++r) { const float mx = wave_max(fmaxf(v0, v1)); int idx = -1;
            if (mx > -__builtin_inff()) { const u64 b0 = __ballot(v0 == mx), b1 = __ballot(v1 == mx);
                idx = b0 ? __builtin_ctzll(b0) : 64 + __builtin_ctzll(b1);
                if (idx < 64) { if (lane == idx) v0 = -__builtin_inff(); } else { if (lane == idx - 64) v1 = -__builtin_inff(); }
                if (idx < 32) m0 |= 1u << idx; else if (idx < 64) m1 |= 1u << (idx - 32); else if (idx < 96) m2 |= 1u << (idx - 64); else m3 |= 1u << (idx - 96); }
            if (lane == 0) sel[r] = idx; }
        if (lane == 0) { unsigned* mk = (unsigned*)(F.ws + WS_NSAMASK) + (size_t)t * 4; mk[0] = m0; mk[1] = m1; mk[2] = m2; mk[3] = m3; }
        LDS_WAIT(); asm volatile("" ::: "memory");
    }
}
__device__ __forceinline__ unsigned f2key(float f) { const unsigned u = __builtin_bit_cast(unsigned, f); return (u & 0x80000000u) ? ~u : (u | 0x80000000u); }
__device__ __forceinline__ int wave_sum_i(int v) {
#pragma unroll
    for (int o = 1; o < 64; o <<= 1) v += __shfl_xor(v, o);
    return v;
}
__device__ __forceinline__ void dsa_topk_phase(Frame& F) { int lane = F.lane; asm volatile("" : "+v"(lane));
    WAVE_ITEMS(t, S) {
        asm volatile("" : "+v"(lane));
        const float* sc = (const float*)(F.ws + WS_SCORES) + (size_t)t * S + lane;
        int* list = (int*)(F.ws + WS_DSALIST) + (size_t)t * 256; u64* bm = (u64*)(F.ws + WS_DSAMASK) + (size_t)t * 128;
        unsigned u[128];
#pragma unroll
        for (int c = 0; c < 128; ++c) { u[c] = 0u; if (c * 64 <= t) { const bool ok = lane <= t - c * 64; const float v = ok ? sc[c * 64] : 0.f; u[c] = ok ? f2key(v) : 0u; } }
        unsigned T = 0u; int need_eq = 0;
        if (t >= 256) {
            for (int b = 31; b >= 0; --b) { const unsigned cand = T | (1u << b); int cnt = 0;
#pragma unroll
                for (int c = 0; c < 128; ++c) cnt += (u[c] >= cand) ? 1 : 0;
                cnt = wave_sum_i(cnt);
                if (cnt >= 256) T = cand; }
            int gt = 0;
#pragma unroll
            for (int c = 0; c < 128; ++c) gt += (u[c] > T) ? 1 : 0;
            need_eq = 256 - wave_sum_i(gt);
        } else T = 1u;
        int base = 0;
#pragma unroll
        for (int c = 0; c < 128; ++c) {
            bool selv = u[c] > T;
            if (need_eq > 0) { const u64 eq = __ballot(u[c] == T);
                if (eq) { const int rank = __builtin_popcountll(eq & ((1ull << lane) - 1ull)); selv = selv || (u[c] == T && rank < need_eq); need_eq -= min(need_eq, (int)__builtin_popcountll(eq)); } }
            const u64 sm = __ballot(selv);
            if (lane == 0) bm[c] = sm;
            if (selv) list[base + __builtin_popcountll(sm & ((1ull << lane) - 1ull))] = c * 64 + lane;
            base += __builtin_popcountll(sm);
            __builtin_amdgcn_sched_barrier(0);
        }
        for (int i = base + lane; i < 256; i += 64) list[i] = -1;
    }
}
__device__ __forceinline__ void moba_attn_phase(Frame& F) { int lane = F.lane; asm volatile("" : "+v"(lane));
    LAS float* qs = (LAS float*)(F.lds + F.wave * 16384);
    WAVE_ITEMS(it, S * 4) { const int t = it >> 2, h = it & 3, cur = t >> 8;
        const h16* K = (const h16*)(F.ws + WS_AK + (size_t)h * HEADBUF); const h16* V = (const h16*)(F.ws + WS_AV + (size_t)h * HEADBUF);
        load_q(qs, (const h16*)(F.ws + WS_AQ + (size_t)h * HEADBUF) + (size_t)t * 128, 128, lane);
        const int* sel = (const int*)(F.ws + WS_MOBASEL) + (size_t)t * 16 + h * 4;
        AttnAcc a; attn_init(a);
        for (int bi = 0; bi < 4; ++bi) { const int blk = bi == 0 ? cur : sel[bi - 1]; if (blk < 0) continue;
            for (int c = 0; c < 4; ++c) { const int s = blk * 256 + c * 64 + lane; const int key = (s <= t) ? s : -1;
                if (blk * 256 + c * 64 > t) break;
                const float lg = dot_h(qs, K + (size_t)(key < 0 ? 0 : key) * 128, 16) * SC128;
                attn_chunk(a, key, lg, V, 128, lane); } }
        store_o((h16*)(F.ws + WS_OMIX) + (size_t)t * DM + h * 128, a, lane);
        LDS_WAIT(); asm volatile("" ::: "memory"); }
}
__device__ __forceinline__ void mla_attn_phase(Frame& F) { int lane = F.lane; asm volatile("" : "+v"(lane));
    LAS float* qs = (LAS float*)(F.lds + F.wave * 16384);
    WAVE_ITEMS(it, S * 4) { const int t = it >> 2, h = it & 3;
        const h16* K = (const h16*)(F.ws + WS_KN + (size_t)h * HEADBUF); const h16* KR = (const h16*)(F.ws + WS_BKR); const h16* V = (const h16*)(F.ws + WS_BV + (size_t)h * HEADBUF);
        load_q(qs, (const h16*)(F.ws + WS_Q192) + ((size_t)h * S + t) * 192, 192, lane);
        AttnAcc a; attn_init(a);
        for (int c = 0; c * 64 <= t; ++c) { const int s = c * 64 + lane; const int key = (s <= t) ? s : -1; const int ks = key < 0 ? 0 : key;
            const float lg = (dot_h(qs, K + (size_t)ks * 128, 16) + dot_h(qs + 128, KR + (size_t)ks * 64, 8)) * SC192;
            attn_chunk(a, key, lg, V, 128, lane); }
        store_o((h16*)(F.ws + WS_OMIX) + (size_t)t * DM + 512 + h * 128, a, lane);
        LDS_WAIT(); asm volatile("" ::: "memory"); }
}
__device__ __forceinline__ void nsa_attn_phase(Frame& F) { int lane = F.lane; asm volatile("" : "+v"(lane));
    LAS float* qs = (LAS float*)(F.lds + F.wave * 16384);
    WAVE_ITEMS(it, S * 4) { const int t = it >> 2, h = it & 3, cur = t >> 6;
        load_q(qs, (const h16*)(F.ws + WS_CQROPE + (size_t)h * HEADBUF) + (size_t)t * 128, 128, lane);
        const h16* KS = (const h16*)(F.ws + WS_KSLC); const h16* VS = (const h16*)(F.ws + WS_VSLC); const h16* KW = (const h16*)(F.ws + WS_KWIN); const h16* VW = (const h16*)(F.ws + WS_VWIN);
        const int* sel = (const int*)(F.ws + WS_NSASEL) + (size_t)t * 16;
        AttnAcc a; attn_init(a);
        for (int r = 0; r < 16; ++r) { const int blk = sel[r]; if (blk < 0 || blk > cur) continue;
            const int s = blk * 64 + lane; const int key = (s <= t) ? s : -1;
            const float lg = dot_h(qs, KS + (size_t)(key < 0 ? 0 : key) * 128, 16) * SC128;
            attn_chunk(a, key, lg, VS, 128, lane); }
        AttnAcc w; attn_init(w);
        const int lo = t >= 511 ? t - 511 : 0;
        for (int c = lo >> 6; c * 64 <= t; ++c) { const int s = c * 64 + lane; const int key = (s <= t && s >= lo) ? s : -1;
            const float lg = dot_h(qs, KW + (size_t)(key < 0 ? 0 : key) * 128, 16) * SC128;
            attn_chunk(w, key, lg, VW, 128, lane); }
        const float* gl = (const float*)(F.ws + WS_SMALL) + (size_t)t * 32 + h * 3;
        const float g0 = 1.0f / (1.0f + __expf(-gl[0])), g1 = 1.0f / (1.0f + __expf(-gl[1])), g2 = 1.0f / (1.0f + __expf(-gl[2]));
        const float* oc = (const float*)(F.ws + WS_OCMP) + ((size_t)t * 4 + h) * 128 + 2 * lane;
        const float ia = a.l > 0.f ? 1.0f / a.l : 0.f, iw = w.l > 0.f ? 1.0f / w.l : 0.f;
        half2v o; o[0] = (h16)(g0 * oc[0] + g1 * a.o0 * ia + g2 * w.o0 * iw); o[1] = (h16)(g0 * oc[1] + g1 * a.o1 * ia + g2 * w.o1 * iw);
        *(half2v*)((h16*)(F.ws + WS_OMIX) + (size_t)t * DM + 1024 + h * 128 + 2 * lane) = o;
        LDS_WAIT(); asm volatile("" ::: "memory"); }
}
__device__ __forceinline__ void dsa_attn_phase(Frame& F) { int lane = F.lane; asm volatile("" : "+v"(lane));
    LAS float* qs = (LAS float*)(F.lds + F.wave * 16384);
    WAVE_ITEMS(it, S * 4) { const int t = it >> 2, h = it & 3;
        const h16* K = (const h16*)(F.ws + WS_DK + (size_t)h * HEADBUF); const h16* V = (const h16*)(F.ws + WS_DV + (size_t)h * HEADBUF);
        load_q(qs, (const h16*)(F.ws + WS_DQ + (size_t)h * HEADBUF) + (size_t)t * 128, 128, lane);
        const int* list = (const int*)(F.ws + WS_DSALIST) + (size_t)t * 256;
        AttnAcc a; attn_init(a);
        for (int c = 0; c < 4; ++c) { int key = list[c * 64 + lane]; if (key > t) key = -1;
            const float lg = dot_h(qs, K + (size_t)(key < 0 ? 0 : key) * 128, 16) * SC128;
            attn_chunk(a, key, lg, V, 128, lane); }
        store_o((h16*)(F.ws + WS_OMIX) + (size_t)t * DM + 1536 + h * 128, a, lane);
        LDS_WAIT(); asm volatile("" ::: "memory"); }
}
__device__ __forceinline__ void mem_attn_phase(Frame& F, int l) { int lane = F.lane; asm volatile("" : "+v"(lane));
    LAS float* qs = (LAS float*)(F.lds + F.wave * 16384);
    WAVE_ITEMS(it, S * 4) { const int t = it >> 2, h = it & 3;
        const h16* K = (const h16*)(F.ws + WS_MK) + (size_t)((l * 4 + h) * MEMLEN) * 128; const h16* V = (const h16*)(F.ws + WS_MV) + (size_t)((l * 4 + h) * MEMLEN) * 128;
        load_q(qs, (const h16*)(F.ws + WS_MQ + (size_t)h * HEADBUF) + (size_t)t * 128, 128, lane);
        AttnAcc a; attn_init(a);
        for (int c = 0; c < 4; ++c) { const int key = c * 64 + lane;
            const float lg = dot_h(qs, K + (size_t)key * 128, 16) * SC128;
            attn_chunk(a, key, lg, V, 128, lane); }
        store_o((h16*)(F.ws + WS_MO) + (size_t)t * 512 + h * 128, a, lane);
        LDS_WAIT(); asm volatile("" ::: "memory"); }
}
namespace fa {
typedef short s16x4 __attribute__((ext_vector_type(4)));
typedef float f32x16 __attribute__((ext_vector_type(16)));
constexpr int SHM_K = 16384, SHM_V = 16384, SHM_KR = 8192;
constexpr int OFF_V = 0, OFF_K = 2 * SHM_V, OFF_KR = OFF_K + 2 * SHM_K, OFF_WS = OFF_KR + 2 * SHM_KR, OFF_TICKET = OFF_WS + NWAVES * 96 * 4;
enum { K_MLA = 0, K_MOBA, K_SLC, K_WIN, K_DSA, K_MEM, K_CMP };
#define FA_KSWZ(row, colB) ((row) * 256 + ((colB) ^ (((row) & 7) << 4)))
#define FA_KRSWZ(row, colB) ((row) * 128 + ((colB) ^ (((row) & 7) << 4)))
#define FA_SBAR() __builtin_amdgcn_sched_barrier(0)
__device__ __forceinline__ int v_st(int k, int c) { const int kk = (k & ~0xC) | ((k & 4) << 1) | ((k & 8) >> 1); return ((kk >> 3) * 4 + (c >> 5)) * 512 + ((kk & 7) * 32 + (c & 31)) * 2; }
__device__ __forceinline__ int v_rd_base(int lane) { return ((lane & 3) << 3) | (((lane >> 2) & 3) << 6) | (((lane >> 4) & 1) << 5) | (((lane >> 5) & 1) << 8); }
constexpr int v_rd_off(int d0, int ks, int half) { return d0 * 512 + ks * 4096 + half * 2048; }
__device__ __forceinline__ int crow(int r, int hi) { return (r & 3) + 8 * (r >> 2) + 4 * hi; }
__device__ __forceinline__ unsigned cvtpk(float lo, float hi) { half2v h; h[0] = (h16)lo; h[1] = (h16)hi; return __builtin_bit_cast(unsigned, h); }

__device__ __forceinline__ void mask_tile(f32x16& p0, f32x16& p1, int dq, unsigned W) {
    const float NEG = -__builtin_inff();
#pragma unroll
    for (int r = 0; r < 16; ++r) { const int c = (r & 3) + 8 * (r >> 2);
        if ((unsigned)(dq - c) >= W) p0[r] = NEG;
        if ((unsigned)(dq - c - 32) >= W) p1[r] = NEG; }
}
__device__ __forceinline__ void mask_all(f32x16& p0, f32x16& p1, bool keep) {
    const float NEG = -__builtin_inff();
#pragma unroll
    for (int r = 0; r < 16; ++r) { p0[r] = keep ? p0[r] : NEG; p1[r] = keep ? p1[r] : NEG; }
}
__device__ __forceinline__ void mask_bits(f32x16& p0, f32x16& p1, unsigned lo, unsigned hi_w, int hi) {
    const unsigned a = lo >> (4 * hi), b = hi_w >> (4 * hi); const unsigned NEGB = 0xFF800000u;
#pragma unroll
    for (int r = 0; r < 16; ++r) { const int c = (r & 3) + 8 * (r >> 2);
        const unsigned ma = (unsigned)__builtin_amdgcn_sbfe((int)a, c, 1), mb = (unsigned)__builtin_amdgcn_sbfe((int)b, c, 1);
        const float x0 = p0[r], x1 = p1[r];
        p0[r] = __uint_as_float((__float_as_uint(x0) & ma) | (NEGB & ~ma));
        p1[r] = __uint_as_float((__float_as_uint(x1) & mb) | (NEGB & ~mb)); }
}
__device__ __forceinline__ void partialSM(f32x16& p0, f32x16& p1, float& m_reg, float& mn, float& alpha, const float sc, const float C2) {
    float pmax = p0[0];
#pragma unroll
    for (int r = 1; r < 16; ++r) pmax = fmaxf(pmax, p0[r]);
#pragma unroll
    for (int r = 0; r < 16; ++r) pmax = fmaxf(pmax, p1[r]);
    { auto rr = __builtin_amdgcn_permlane32_swap(__float_as_uint(pmax), __float_as_uint(pmax), false, false);
      pmax = fmaxf(__uint_as_float(rr[0]), __uint_as_float(rr[1])); }
    if (__builtin_expect(__all((pmax - m_reg) * sc <= 8.0f), 1)) { mn = m_reg; alpha = 1.f; }
    else { mn = fmaxf(m_reg, pmax); alpha = __builtin_amdgcn_exp2f((m_reg - mn) * C2); m_reg = mn; }
    const float mnL = -mn * C2;
#pragma unroll
    for (int r = 0; r < 16; ++r) p0[r] = __builtin_amdgcn_exp2f(fmaf(p0[r], C2, mnL));
#pragma unroll
    for (int r = 0; r < 16; ++r) p1[r] = __builtin_amdgcn_exp2f(fmaf(p1[r], C2, mnL));
}
__device__ __forceinline__ void finishSM(const f32x16& p0, const f32x16& p1, float alpha, float& l_reg, half8& pa0, half8& pa1, half8& pa2, half8& pa3) {
    float ps = 0;
#pragma unroll
    for (int r = 0; r < 16; ++r) ps += p0[r];
#pragma unroll
    for (int r = 0; r < 16; ++r) ps += p1[r];
    { auto rr = __builtin_amdgcn_permlane32_swap(__float_as_uint(ps), __float_as_uint(ps), false, false);
      ps = __uint_as_float(rr[0]) + __uint_as_float(rr[1]); }
    l_reg = l_reg * alpha + ps;
#define FA_PK4(P, B_, OUT) do { unsigned a0 = cvtpk(P[B_ + 0], P[B_ + 1]), a1 = cvtpk(P[B_ + 2], P[B_ + 3]); unsigned b0 = cvtpk(P[B_ + 4], P[B_ + 5]), b1 = cvtpk(P[B_ + 6], P[B_ + 7]); \
        auto r0 = __builtin_amdgcn_permlane32_swap(a0, b0, false, false); auto r1 = __builtin_amdgcn_permlane32_swap(a1, b1, false, false); \
        u32x4 w = {r0[0], r1[0], r0[1], r1[1]}; OUT = __builtin_bit_cast(half8, w); } while (0)
    FA_PK4(p0, 0, pa0); FA_PK4(p0, 8, pa1); FA_PK4(p1, 0, pa2); FA_PK4(p1, 8, pa3);
#undef FA_PK4
}
template <bool MLA>
__device__ __forceinline__ void qkt(f32x16& p0, f32x16& p1, const LAS char* lds, int kboff, int kroff, int r32, int hi, const half8* qr, bool act) {
    if (!act) { const float NEG = -__builtin_inff();
#pragma unroll
        for (int r = 0; r < 16; ++r) { p0[r] = NEG; p1[r] = NEG; } return; }
#pragma unroll
    for (int r = 0; r < 16; ++r) { p0[r] = 0.f; p1[r] = 0.f; }
    const LAS char* kb[4];
#pragma unroll
    for (int dd = 0; dd < 4; ++dd) kb[dd] = lds + OFF_K + kboff + FA_KSWZ(r32, (dd * 16 + hi * 8) * 2);
#pragma unroll
    for (int d0 = 0; d0 < 8; ++d0) { const LAS char* a = kb[d0 & 3] + (d0 >> 2) * 128;
        const half8 b0 = *(const LAS half8*)a; const half8 b1 = *(const LAS half8*)(a + 32 * 256);
        p0 = __builtin_amdgcn_mfma_f32_32x32x16_f16(b0, qr[d0], p0, 0, 0, 0);
        p1 = __builtin_amdgcn_mfma_f32_32x32x16_f16(b1, qr[d0], p1, 0, 0, 0); }
    if constexpr (MLA) {
#pragma unroll
        for (int d0 = 0; d0 < 4; ++d0) { const LAS char* a = lds + OFF_KR + kroff + FA_KRSWZ(r32, (d0 * 16 + hi * 8) * 2);
            const half8 b0 = *(const LAS half8*)a; const half8 b1 = *(const LAS half8*)(a + 32 * 128);
            p0 = __builtin_amdgcn_mfma_f32_32x32x16_f16(b0, qr[8 + d0], p0, 0, 0, 0);
            p1 = __builtin_amdgcn_mfma_f32_32x32x16_f16(b1, qr[8 + d0], p1, 0, 0, 0); }
    }
}
__device__ __forceinline__ void pv_tile(f32x16* o, int vb0, half8 pa0, half8 pa1, half8 pa2, half8 pa3, bool act) {
    if (!act) return;
#define FA_TRRD(dst, off) asm volatile("ds_read_b64_tr_b16 %0, %1 offset:%2" : "=&v"(dst) : "v"(vb0), "i"(off) : "memory")
#define FA_H8(l, h) __builtin_bit_cast(half8, (short __attribute__((ext_vector_type(8)))){l[0], l[1], l[2], l[3], h[0], h[1], h[2], h[3]})
#define FA_PV_D0(d0) do { s16x4 l0, l1, l2, l3, h0, h1, h2, h3; constexpr int b_ = v_rd_off(d0, 0, 0); \
        FA_TRRD(l0, b_); FA_TRRD(h0, b_ + 2048); FA_TRRD(l1, b_ + 4096); FA_TRRD(h1, b_ + 6144); FA_TRRD(l2, b_ + 8192); FA_TRRD(h2, b_ + 10240); FA_TRRD(l3, b_ + 12288); FA_TRRD(h3, b_ + 14336); \
        asm volatile("s_waitcnt lgkmcnt(0)" ::: "memory"); FA_SBAR(); \
        o[d0] = __builtin_amdgcn_mfma_f32_32x32x16_f16(pa0, FA_H8(l0, h0), o[d0], 0, 0, 0); \
        o[d0] = __builtin_amdgcn_mfma_f32_32x32x16_f16(pa1, FA_H8(l1, h1), o[d0], 0, 0, 0); \
        o[d0] = __builtin_amdgcn_mfma_f32_32x32x16_f16(pa2, FA_H8(l2, h2), o[d0], 0, 0, 0); \
        o[d0] = __builtin_amdgcn_mfma_f32_32x32x16_f16(pa3, FA_H8(l3, h3), o[d0], 0, 0, 0); } while (0)
    FA_PV_D0(0); FA_PV_D0(1); FA_PV_D0(2); FA_PV_D0(3);
#undef FA_PV_D0
#undef FA_H8
#undef FA_TRRD
}
struct UnitArgs {
    const h16* Q; int qld;
    const h16* K; const h16* KR; const h16* V;
    h16* O; int old;
    int P0, j_lo, j_hi;
    const void* mk;
    const float* gate; int gidx;
    const float* ocmp;
    int epi;
};
template <int KIND>
__device__ __forceinline__ void run_unit(LAS char* lds, const UnitArgs& U, int tid_in) {
    constexpr bool MLA = KIND == K_MLA;
    int tid = tid_in; asm volatile("" : "+v"(tid));
    const int wid = __builtin_amdgcn_readfirstlane(tid >> 6), lane = tid & 63, r32 = lane & 31, hi = lane >> 5;
    const int sr = tid >> 4, sc = (tid & 15) * 8;
    const int qlo = U.P0 + wid * 32, rowpos = qlo + r32;
    const float sc_ = MLA ? SC192 : SC128; const float C2 = 1.4426950408889634f * sc_;
    LAS float* wsf = (LAS float*)(lds + OFF_WS) + wid * 96; LAS float* li_l = wsf; LAS float* al_l = wsf + 32; LAS float* g_l = wsf + 64;
    half8 qr[MLA ? 12 : 8];
    { const h16* qp = U.Q + (size_t)(wid * 32 + r32) * U.qld + hi * 8;
#pragma unroll
      for (int d0 = 0; d0 < (MLA ? 12 : 8); ++d0) qr[d0] = *(const half8*)(qp + d0 * 16); }
    unsigned mb0 = 0, mb1 = 0, mb2 = 0, mb3 = 0;
    if constexpr (KIND == K_MOBA) { const int* s = (const int*)U.mk + (size_t)rowpos * 16;
#pragma unroll
        for (int i = 0; i < 3; ++i) { const int b = s[i]; if (b >= 0) mb0 |= 1u << b; } }
    if constexpr (KIND == K_SLC) { const u32x4 m = *(const u32x4*)((const unsigned*)U.mk + (size_t)rowpos * 4); mb0 = m[0]; mb1 = m[1]; mb2 = m[2]; mb3 = m[3]; }
    const int nvis_row = rowpos >= 31 ? ((rowpos - 31) >> 4) + 1 : 0;
    const int NT = U.j_hi - U.j_lo;
    half8 st_k0, st_k1, st_v0, st_v1, st_kr; unsigned dm_lo = 0, dm_hi = 0, dn_lo = 0, dn_hi = 0;
    const int kws = FA_KSWZ(sr, sc * 2), vst0 = v_st(sr, sc), vst1 = v_st(32 + sr, sc), krw = FA_KRSWZ(tid >> 3, (tid & 7) * 16);
    const int vb0 = (int)(unsigned)(size_t)(lds + OFF_V) + v_rd_base(lane);
#define FA_LOADT(j) do { const int k0_ = (j) * 64; st_k0 = *(const half8*)(U.K + (size_t)(k0_ + sr) * 128 + sc); st_k1 = *(const half8*)(U.K + (size_t)(k0_ + 32 + sr) * 128 + sc); \
        st_v0 = *(const half8*)(U.V + (size_t)(k0_ + sr) * 128 + sc); st_v1 = *(const half8*)(U.V + (size_t)(k0_ + 32 + sr) * 128 + sc); \
        if constexpr (MLA) st_kr = *(const half8*)(U.KR + (size_t)(k0_ + (tid >> 3)) * 64 + (tid & 7) * 8); \
        if constexpr (KIND == K_DSA) { const unsigned long long w_ = ((const unsigned long long*)U.mk)[(size_t)rowpos * 128 + (j)]; dn_lo = (unsigned)w_; dn_hi = (unsigned)(w_ >> 32); } } while (0)
#define FA_WRITET(bf) do { *(LAS half8*)(lds + OFF_K + (bf) * SHM_K + kws) = st_k0; *(LAS half8*)(lds + OFF_K + (bf) * SHM_K + kws + 32 * 256) = st_k1; \
        *(LAS half8*)(lds + OFF_V + (bf) * SHM_V + vst0) = st_v0; *(LAS half8*)(lds + OFF_V + (bf) * SHM_V + vst1) = st_v1; \
        if constexpr (MLA) *(LAS half8*)(lds + OFF_KR + (bf) * SHM_KR + krw) = st_kr; } while (0)
    float m_reg = -1e30f, l_reg = 0.f; f32x16 o[4];
#pragma unroll
    for (int d = 0; d < 4; ++d)
#pragma unroll
        for (int r = 0; r < 16; ++r) o[d][r] = 0.f;
    FA_LOADT(U.j_lo); asm volatile("s_waitcnt vmcnt(0)" ::: "memory"); FA_WRITET(0); dm_lo = dn_lo; dm_hi = dn_hi;
    __syncthreads();
    f32x16 pA0, pA1; float mnA, alA; half8 pa0, pa1, pa2, pa3;
#define FA_STEP(t) do { const int kb_ = (U.j_lo + (t)) * 64; int bsel_ = (t) & 1; asm volatile("" : "+v"(bsel_)); \
        bool act_ = kb_ <= qlo + 31; if constexpr (KIND == K_WIN) act_ = act_ && (kb_ + 63 >= qlo - 511); if constexpr (KIND == K_MEM) act_ = true; if constexpr (KIND == K_CMP) act_ = kb_ < (qlo >> 4) + 1; \
        qkt<MLA>(pA0, pA1, lds, bsel_ * SHM_K, bsel_ * SHM_KR, r32, hi, qr, act_); \
        if (act_) { \
            if constexpr (KIND == K_MLA) { if (kb_ + 63 > qlo) mask_tile(pA0, pA1, rowpos - kb_ - 4 * hi, 0x40000000u); } \
            if constexpr (KIND == K_WIN) { if (kb_ + 63 > qlo || kb_ <= qlo + 31 - 512) mask_tile(pA0, pA1, rowpos - kb_ - 4 * hi, 512u); } \
            if constexpr (KIND == K_MOBA) { const int blk_ = kb_ >> 8; if (blk_ == (U.P0 >> 8)) { if (kb_ + 63 > qlo) mask_tile(pA0, pA1, rowpos - kb_ - 4 * hi, 0x40000000u); } else mask_all(pA0, pA1, (mb0 >> blk_) & 1u); } \
            if constexpr (KIND == K_SLC) { const int b_ = kb_ >> 6; const unsigned w_ = (b_ < 32) ? mb0 : (b_ < 64) ? mb1 : (b_ < 96) ? mb2 : mb3; mask_all(pA0, pA1, (w_ >> (b_ & 31)) & 1u); \
                if (kb_ + 63 > qlo) mask_tile(pA0, pA1, rowpos - kb_ - 4 * hi, 0x40000000u); } \
            if constexpr (KIND == K_DSA) mask_bits(pA0, pA1, dm_lo, dm_hi, hi); \
            if constexpr (KIND == K_CMP) mask_tile(pA0, pA1, nvis_row - 1 - kb_ - 4 * hi, 0x40000000u); \
            partialSM(pA0, pA1, m_reg, mnA, alA, sc_, C2); \
            if (__any(alA < 1.f)) { if (hi == 0) al_l[r32] = alA; asm volatile("s_waitcnt lgkmcnt(0)" ::: "memory"); \
                _Pragma("unroll") for (int d_ = 0; d_ < 4; ++d_) _Pragma("unroll") for (int r = 0; r < 16; ++r) o[d_][r] *= al_l[crow(r, hi)]; } \
            finishSM(pA0, pA1, alA, l_reg, pa0, pa1, pa2, pa3); FA_SBAR(); \
            pv_tile(o, vb0 + bsel_ * SHM_V, pa0, pa1, pa2, pa3, true); } } while (0)
    for (int t = 0; t < NT; ++t) {
        if (t + 1 < NT) FA_LOADT(U.j_lo + t + 1);
        FA_SBAR();
        FA_STEP(t);
        FA_SBAR();
        if (t + 1 < NT) { asm volatile("s_waitcnt vmcnt(0)" ::: "memory"); FA_WRITET((t + 1) & 1); dm_lo = dn_lo; dm_hi = dn_hi; }
        __syncthreads();
    }
    float rs = l_reg > 0.f ? 1.0f / l_reg : 0.f;
    if (U.epi != 0) { const float gl = U.gate[(size_t)rowpos * 32 + U.gidx]; rs *= 1.0f / (1.0f + __expf(-gl));
        if (U.epi == 1) { const float g0 = U.gate[(size_t)rowpos * 32 + U.gidx - 1]; if (hi == 0) g_l[r32] = 1.0f / (1.0f + __expf(-g0)); } }
    if (hi == 0) li_l[r32] = rs;
    asm volatile("s_waitcnt lgkmcnt(0)" ::: "memory");
#pragma unroll
    for (int r = 0; r < 16; ++r) { const int orow = wid * 32 + crow(r, hi); const float rli = li_l[crow(r, hi)]; const float g0 = (U.epi == 1) ? g_l[crow(r, hi)] : 0.f;
#pragma unroll
        for (int d0 = 0; d0 < 4; ++d0) { float v = o[d0][r] * rli;
            if (U.epi == 1) v += g0 * U.ocmp[(size_t)(U.P0 + orow) * 512 + d0 * 32 + r32];
            const float vn = __shfl_xor(v, 1);
            if ((r32 & 1) == 0) { unsigned* op = (unsigned*)(U.O + (size_t)orow * U.old + d0 * 32 + r32);
                if (U.epi == 2) { const half2v pv = __builtin_bit_cast(half2v, *op); *op = cvtpk(v + (float)pv[0], vn + (float)pv[1]); }
                else *op = cvtpk(v, vn); } } }
    __syncthreads();
#undef FA_LOADT
#undef FA_WRITET
#undef FA_STEP
}
}

namespace dsx {
constexpr int IK_STAGE = 256;
__device__ __forceinline__ void score_phase(Frame& F) {
    int lane = F.lane; asm volatile("" : "+v"(lane));
    LAS char* lds = (LAS char*)F.lds; unsigned char* ws = F.ws;
    const int wid = F.wave, r32 = lane & 31, hi = lane >> 5;
    const int tid = wid * 64 + lane;
    for (int n = blockIdx.x; n < 1152; n += F.G) {
        int g = 0;
#pragma unroll
        for (int k = 1; k < 8; ++k) if (n >= 16 * k * (k + 1)) g = k;
        const int r = n - 16 * g * (g + 1), qt = 32 * g + r / (g + 1), kc = r % (g + 1);
        const int t0 = 32 * qt + 4 * wid;
        const int kend = min(kc * 1024 + 1024, 32 * qt + 32);
        half8 a[2][4]; float wv[2][16];
#pragma unroll
        for (int tl = 0; tl < 2; ++tl) { const int t = t0 + 2 * tl + (r32 >> 4); const h16* iq = (const h16*)(ws + WS_IQ) + (size_t)t * 1024 + (r32 & 15) * 64 + hi * 8;
#pragma unroll
            for (int d0 = 0; d0 < 4; ++d0) a[tl][d0] = *(const half8*)(iq + d0 * 16);
#pragma unroll
            for (int rr = 0; rr < 16; ++rr) { const int head = (rr & 3) + 8 * ((rr >> 2) & 1) + 4 * hi; wv[tl][rr] = ((const float*)(ws + WS_SMALL))[(size_t)(t0 + 2 * tl + (rr >> 3)) * 32 + 12 + head] * (0.25f * 0.125f); } }
        for (int ks = kc * 1024; ks < kend; ks += IK_STAGE) {
            const int nk = min(IK_STAGE, kend - ks);
            __syncthreads();
#pragma unroll
            for (int i = 0; i < 4; ++i) { const int idx = tid + 512 * i, row = idx >> 3, ch = idx & 7;
                if (row < nk) { const half8 v = *(const half8*)((const h16*)(ws + WS_IK) + (size_t)(ks + row) * 64 + ch * 8); *(LAS half8*)(lds + row * 128 + ((ch * 16) ^ ((row & 7) << 4))) = v; } }
            __syncthreads();
            for (int sub = 0; sub < nk; sub += 32) {
                const int row = sub + r32; half8 b[4];
#pragma unroll
                for (int d0 = 0; d0 < 4; ++d0) b[d0] = *(const LAS half8*)(lds + row * 128 + (((d0 * 2 + hi) * 16) ^ ((row & 7) << 4)));
#pragma unroll
                for (int tl = 0; tl < 2; ++tl) {
                    fa::f32x16 c;
#pragma unroll
                    for (int rr = 0; rr < 16; ++rr) c[rr] = 0.f;
#pragma unroll
                    for (int d0 = 0; d0 < 4; ++d0) c = __builtin_amdgcn_mfma_f32_32x32x16_f16(a[tl][d0], b[d0], c, 0, 0, 0);
                    float s0 = 0.f, s1 = 0.f;
#pragma unroll
                    for (int rr = 0; rr < 8; ++rr) { s0 += wv[tl][rr] * fmaxf(c[rr], 0.f); s1 += wv[tl][8 + rr] * fmaxf(c[8 + rr], 0.f); }
                    auto sw = __builtin_amdgcn_permlane32_swap(__float_as_uint(s0), __float_as_uint(s1), false, false);
                    const float tot = __uint_as_float(sw[0]) + __uint_as_float(sw[1]);
                    ((float*)(ws + WS_SCORES))[(size_t)(t0 + 2 * tl + hi) * S + ks + sub + r32] = tot;
                }
            }
        }
    }
    __syncthreads();
}
}

namespace nsx {
__device__ __forceinline__ void mask16(fa::f32x16& p, int dq) {
    const float NEG = -__builtin_inff();
#pragma unroll
    for (int r = 0; r < 16; ++r) { const int c = (r & 3) + 8 * (r >> 2); if (dq - c < 0) p[r] = NEG; }
}
__device__ __forceinline__ void imp_select_unit(unsigned char* ws, LAS float* impL  , int unit, int lane_in) {
    int lane = lane_in; asm volatile("" : "+v"(lane));
    const int r32 = lane & 31, hi = lane >> 5, t0 = unit * 32, row = t0 + r32;
    const int nvis = row >= 31 ? ((row - 31) >> 4) + 1 : 0;
    const int nvmax = (t0 >> 4) + 1;
    const int NHT = (nvmax + 31) >> 5;
    const float C2 = 1.4426950408889634f * SC128;
    const h16* kc = (const h16*)(ws + WS_KC16);
    float m[4], l[4];
#pragma unroll
    for (int h = 0; h < 4; ++h) { m[h] = -1e30f; l[h] = 0.f; }
    fa::f32x16 p; half8 kf[8], qf[8];
#define NSX_LOADK(ht) do { const h16* kp_ = kc + (size_t)((ht) * 32 + r32) * 128 + hi * 8; _Pragma("unroll") for (int d0 = 0; d0 < 8; ++d0) kf[d0] = *(const half8*)(kp_ + d0 * 16); } while (0)
#define NSX_QK(h) do { const h16* qp_ = (const h16*)(ws + WS_CQRAW + (size_t)(h) * HEADBUF) + (size_t)row * 128 + hi * 8; _Pragma("unroll") for (int d0 = 0; d0 < 8; ++d0) qf[d0] = *(const half8*)(qp_ + d0 * 16); \
        _Pragma("unroll") for (int r = 0; r < 16; ++r) p[r] = 0.f; \
        _Pragma("unroll") for (int d0 = 0; d0 < 8; ++d0) p = __builtin_amdgcn_mfma_f32_32x32x16_f16(kf[d0], qf[d0], p, 0, 0, 0); } while (0)
    for (int ht = 0; ht < NHT; ++ht) {
        NSX_LOADK(ht);
#pragma unroll
        for (int h = 0; h < 4; ++h) {
            NSX_QK(h);
            mask16(p, nvis - 1 - ht * 32 - 4 * hi);
            float pmax = p[0];
#pragma unroll
            for (int r = 1; r < 16; ++r) pmax = fmaxf(pmax, p[r]);
            { auto rr = __builtin_amdgcn_permlane32_swap(__float_as_uint(pmax), __float_as_uint(pmax), false, false); pmax = fmaxf(__uint_as_float(rr[0]), __uint_as_float(rr[1])); }
            const float mn = fmaxf(m[h], pmax), al = __builtin_amdgcn_exp2f((m[h] - mn) * C2), mnL = -mn * C2;
            float ps = 0.f;
#pragma unroll
            for (int r = 0; r < 16; ++r) ps += __builtin_amdgcn_exp2f(fmaf(p[r], C2, mnL));
            { auto rr = __builtin_amdgcn_permlane32_swap(__float_as_uint(ps), __float_as_uint(ps), false, false); ps = __uint_as_float(rr[0]) + __uint_as_float(rr[1]); }
            l[h] = l[h] * al + ps; m[h] = mn;
        }
    }
    float mL[4], il[4];
#pragma unroll
    for (int h = 0; h < 4; ++h) { mL[h] = -m[h] * C2; il[h] = l[h] > 0.f ? 1.0f / l[h] : 0.f; }
#pragma unroll
    for (int i = 0; i < 64; ++i) impL[i * 64 + lane] = 0.f;
    float carry = 0.f;
    for (int ht = 0; ht < NHT; ++ht) {
        {
            NSX_LOADK(ht);
            float G[4], L[4];
#pragma unroll
            for (int g = 0; g < 4; ++g) { G[g] = 0.f; L[g] = 0.f; }
#pragma unroll
            for (int h = 0; h < 4; ++h) {
                NSX_QK(h);
                mask16(p, nvis - 1 - ht * 32 - 4 * hi);
#pragma unroll
                for (int g = 0; g < 4; ++g) {
                    const float a0 = __builtin_amdgcn_exp2f(fmaf(p[4 * g], C2, mL[h])), a1 = __builtin_amdgcn_exp2f(fmaf(p[4 * g + 1], C2, mL[h])), a2 = __builtin_amdgcn_exp2f(fmaf(p[4 * g + 2], C2, mL[h])), a3 = __builtin_amdgcn_exp2f(fmaf(p[4 * g + 3], C2, mL[h]));
                    G[g] += ((a0 + a1) + (a2 + a3)) * il[h]; L[g] += a3 * il[h];
                }
            }
#pragma unroll
            for (int g = 0; g < 4; ++g) {
                const float A = g == 0 ? carry : L[g - 1], B = L[g];
                auto rr = __builtin_amdgcn_permlane32_swap(__float_as_uint(A), __float_as_uint(B), false, false);
                const float prev = hi ? __uint_as_float(rr[0]) : __uint_as_float(rr[1]);
                impL[(4 * ht + g) * 64 + lane] = G[g] + prev;
            }
            carry = L[3];
        }
    }
#undef NSX_LOADK
#undef NSX_QK
    LDS_WAIT(); asm volatile("" ::: "memory");
    const int cur = row >> 6;
    unsigned key[64];
#pragma unroll
    for (int i = 0; i < 64; ++i) { const int b = 8 * (i >> 2) + 2 * (i & 3) + hi;
        const unsigned vb = (__float_as_uint(impL[i * 64 + lane]) & 0xFFFFFF80u) | (unsigned)(127 - b);
        const bool forced = (b == 0) || (b == cur) || (b == cur - 1);
        key[i] = b > cur ? 0u : (forced ? (0x7F800000u | (unsigned)(127 - b)) : vb); }
    unsigned prev = 0xFFFFFFFFu, m0 = 0u, m1 = 0u, m2 = 0u, m3 = 0u;
    for (int rnd = 0; rnd < 16; ++rnd) {
        unsigned best = 0u;
#pragma unroll
        for (int i = 0; i < 64; ++i) { const unsigned c = key[i] < prev ? key[i] : 0u; best = best > c ? best : c; }
        { auto rr = __builtin_amdgcn_permlane32_swap(best, best, false, false); best = rr[0] > rr[1] ? rr[0] : rr[1]; }
        if (best != 0u) { const unsigned b = 127u - (best & 127u), bit = 1u << (b & 31u);
            m0 |= (b < 32u) ? bit : 0u; m1 |= (b >= 32u && b < 64u) ? bit : 0u; m2 |= (b >= 64u && b < 96u) ? bit : 0u; m3 |= (b >= 96u) ? bit : 0u; }
        prev = best;
    }
    if (hi == 0) { u32x4 mk = {m0, m1, m2, m3}; *(u32x4*)((unsigned*)(ws + WS_NSAMASK) + (size_t)row * 4) = mk; }
}
}

constexpr int CW_QUEUE = 8192;
__device__ __forceinline__ int fa_ticket(Frame& F, unsigned* head) {
    LAS int* tk = (LAS int*)(F.lds + fa::OFF_TICKET);
    if (F.tid == 0) *tk = (int)__hip_atomic_fetch_add(head, 1u, __ATOMIC_RELAXED, __HIP_MEMORY_SCOPE_AGENT);
    __syncthreads();
    const int u = *tk;
    __syncthreads();
    return u;
}
__device__ __forceinline__ void fa_mixer_phase(Frame& F, int l) {
    LAS char* lds = (LAS char*)F.lds; unsigned char* ws = F.ws;
    for (;;) {
        const int u = fa_ticket(F, F.ctl + CW_QUEUE + 64 * l);
        if (u >= 512) break;
        const int qb = 31 - (u >> 4), type = (u >> 2) & 3, h = u & 3, P0 = qb * 256;
        if (!((FA_MASK >> type) & 1)) continue;
        fa::UnitArgs U; U.P0 = P0; U.j_lo = 0; U.j_hi = (P0 + 255) / 64 + 1; U.KR = nullptr; U.mk = nullptr; U.gate = nullptr; U.gidx = 0; U.ocmp = nullptr; U.epi = 0; U.old = DM;
        if (type == 0) {
            U.Q = (const h16*)(ws + WS_Q192) + ((size_t)h * S + P0) * 192; U.qld = 192; U.K = (const h16*)(ws + WS_KN + (size_t)h * HEADBUF); U.KR = (const h16*)(ws + WS_BKR); U.V = (const h16*)(ws + WS_BV + (size_t)h * HEADBUF);
            U.O = (h16*)(ws + WS_OMIX) + (size_t)P0 * DM + 512 + h * 128;
            fa::run_unit<fa::K_MLA>(lds, U, F.tid);
        } else if (type == 1) {
            U.Q = (const h16*)(ws + WS_CQROPE + (size_t)h * HEADBUF) + (size_t)P0 * 128; U.qld = 128; U.K = (const h16*)(ws + WS_KSLC); U.V = (const h16*)(ws + WS_VSLC);
            U.O = (h16*)(ws + WS_OMIX) + (size_t)P0 * DM + 1024 + h * 128; U.mk = ws + WS_NSAMASK; U.gate = (const float*)(ws + WS_SMALL); U.gidx = h * 3 + 1; U.epi = 2;
            fa::run_unit<fa::K_SLC>(lds, U, F.tid);
            U.K = (const h16*)(ws + WS_KWIN); U.V = (const h16*)(ws + WS_VWIN); U.j_lo = P0 >= 511 ? (P0 - 511) / 64 : 0; U.gidx = h * 3 + 2; U.epi = 2;
            fa::run_unit<fa::K_WIN>(lds, U, F.tid);
        } else if (type == 2) {
            U.Q = (const h16*)(ws + WS_AQ + (size_t)h * HEADBUF) + (size_t)P0 * 128; U.qld = 128; U.K = (const h16*)(ws + WS_AK + (size_t)h * HEADBUF); U.V = (const h16*)(ws + WS_AV + (size_t)h * HEADBUF);
            U.O = (h16*)(ws + WS_OMIX) + (size_t)P0 * DM + h * 128; U.mk = (const int*)(ws + WS_MOBASEL) + h * 4;
            fa::run_unit<fa::K_MOBA>(lds, U, F.tid);
        } else {
            U.Q = (const h16*)(ws + WS_DQ + (size_t)h * HEADBUF) + (size_t)P0 * 128; U.qld = 128; U.K = (const h16*)(ws + WS_DK + (size_t)h * HEADBUF); U.V = (const h16*)(ws + WS_DV + (size_t)h * HEADBUF);
            U.O = (h16*)(ws + WS_OMIX) + (size_t)P0 * DM + 1536 + h * 128; U.mk = ws + WS_DSAMASK;
            fa::run_unit<fa::K_DSA>(lds, U, F.tid);
        }
    }
}
__device__ __forceinline__ void fa_cmp_phase(Frame& F) {
    LAS char* lds = (LAS char*)F.lds; unsigned char* ws = F.ws;
    for (int u = blockIdx.x; u < 128; u += F.G) {
        const int qb = 31 - (u >> 2), h = u & 3, P0 = qb * 256;
        fa::UnitArgs U; U.P0 = P0; U.j_lo = 0; U.j_hi = ((((P0 + 224) >> 4) + 1) + 63) >> 6; U.KR = nullptr; U.mk = nullptr; U.ocmp = nullptr; U.old = DM;
        U.Q = (const h16*)(ws + WS_CQRAW + (size_t)h * HEADBUF) + (size_t)P0 * 128; U.qld = 128; U.K = (const h16*)(ws + WS_KC16); U.V = (const h16*)(ws + WS_VC16);
        U.O = (h16*)(ws + WS_OMIX) + (size_t)P0 * DM + 1024 + h * 128; U.gate = (const float*)(ws + WS_SMALL); U.gidx = h * 3; U.epi = 3;
        fa::run_unit<fa::K_CMP>(lds, U, F.tid);
    }
}
__device__ __forceinline__ void nsa_imp_phase(Frame& F) {
    if (F.wave == 0) for (int u = blockIdx.x; u < 256; u += F.G) nsx::imp_select_unit(F.ws, (LAS float*)F.lds, u, F.lane);
}
__device__ __forceinline__ void fa_mem_phase(Frame& F, int l) {
    LAS char* lds = (LAS char*)F.lds; unsigned char* ws = F.ws;
    for (int u = blockIdx.x; u < 128; u += F.G) {
        const int qb = u >> 2, h = u & 3, P0 = qb * 256;
        fa::UnitArgs U; U.P0 = P0; U.j_lo = 0; U.j_hi = 4; U.KR = nullptr; U.mk = nullptr; U.gate = nullptr; U.gidx = 0; U.ocmp = nullptr; U.epi = 0;
        U.Q = (const h16*)(ws + WS_MQ + (size_t)h * HEADBUF) + (size_t)P0 * 128; U.qld = 128;
        U.K = (const h16*)(ws + WS_MK) + (size_t)((l * 4 + h) * MEMLEN) * 128; U.V = (const h16*)(ws + WS_MV) + (size_t)((l * 4 + h) * MEMLEN) * 128;
        U.O = (h16*)(ws + WS_MO) + (size_t)P0 * 512 + h * 128; U.old = 512;
        fa::run_unit<fa::K_MEM>(lds, U, F.tid);
    }
}

enum { PHB_P0, PHB_KMEAN, PHB_CMP2, PHB_GATE, PHB_SCORE, PHB_CMPSEL, PHB_TOPK, PHB_MOBA, PHB_MLA, PHB_NSA, PHB_DSA, PHB_MEMA, PHB_LN, PHB_GMKV, PHB_GSWIGLU, PHB_GWIN, PHB_GUQ, PHB_GUKV, PHB_GY, PHB_GMQ, PHB_GRESID };
#ifndef SKIPMASK
#define SKIPMASK 0u
#endif
constexpr int SLOTS = 7, NSTEPS = 2 + 16 * SLOTS;
struct Args { const float* in[19]; float* out; unsigned char* ws; int lo, hi; };
__global__ void __launch_bounds__(NTHREADS, 2) mk_fwd(Args args) {
    extern __shared__ __attribute__((aligned(16))) unsigned char lds_raw[];
    Frame F;
    F.lds = (LAS unsigned char*)lds_raw;
    F.MISC = (volatile LAS unsigned*)(F.lds + MISC_OFF);
    F.tid = threadIdx.x; F.lane = F.tid & 63; F.wave = __builtin_amdgcn_readfirstlane(F.tid >> 6);
    F.G = gridDim.x; F.ws = args.ws; F.ctl = (unsigned*)(args.ws + WS_CTL); F.out = args.out;
#pragma unroll
    for (int i = 0; i < 19; ++i) F.in[i] = args.in[i];
    for (int u = F.tid; u < (LDS_BYTES - LDSCTL_OFF) / 4; u += NTHREADS) ((LAS unsigned*)(F.lds + LDSCTL_OFF))[u] = 0u;
    __syncthreads();
    const int lo = args.lo, hi = args.hi;
    XcdBarrier bar; bar.bar = F.ctl + CW_BAR; bar.x = 0; bar.st = nullptr;
    if (hi - lo > 1) bar = xcd_barrier_post(F.ctl + CW_BAR, F.MISC + 8);
#define PH(name, call) do { if (!(SKIPMASK & (1u << PHB_##name))) { call; } } while (0)
#define IN(k) (lo <= (k) && (k) < hi)
#define END(k) do { if (hi > (k) + 1) xcd_barrier(bar); } while (0)
    unsigned char* ws = args.ws;
    const float* xf = (const float*)(ws + WS_XF); float* z = (float*)(ws + WS_Z); const h16* xh = (const h16*)(ws + WS_XH);

    if (IN(0)) { PH(P0, p0_prologue(F)); END(0); }
    if (IN(1)) {
        pg8::Gemm g{(const h16*)(ws + WS_MEMH), (const h16*)(ws + WS_WMKV), MEMLEN, DEPTH * 1024, DM}; pg8::StaticOrder So; So.init(MEMLEN, DEPTH * 1024, F.G, (int)blockIdx.x);
        EpiProj<JOB_MKV> E{ws, 0};
        PH(GMKV, (pg8::gemm_phase<EpiProj<JOB_MKV>, pg8::StaticOrder, true, true>(F.lds, g, So, E)));
        END(1);
    }
    for (int sb = 0; sb < 16; ++sb) {
        const int l = sb >> 2, kind = sb & 3, base = 2 + sb * SLOTS;
        if (hi <= base || lo >= base + SLOTS) continue;
        const h16* resA; const h16* resB; int resK; float resS; int lnidx;
        if (kind == 0 || kind == 3) {
            const int f = kind == 0 ? 0 : 1;
            resA = (const h16*)(ws + WS_HB); resB = (const h16*)(ws + WS_WD) + (size_t)(l * 2 + f) * DM * DFF; resK = DFF; resS = 0.5f; lnidx = kind;
            if (IN(base)) {
                pg8::Gemm g{xh, (const h16*)(ws + WS_WGU) + (size_t)(l * 2 + f) * 2 * DFF * DM, S, 2 * DFF, DM}; pg8::StaticOrder So; So.init(S, 2 * DFF, F.G, (int)blockIdx.x);
                EpiSwiglu E{(h16*)(ws + WS_HB)};
                PH(GSWIGLU, (pg8::gemm_phase<EpiSwiglu, pg8::StaticOrder, true, true>(F.lds, g, So, E)));
                END(base);
            }
        } else if (kind == 1) {
            resA = (const h16*)(ws + WS_OMIX); resB = (const h16*)(ws + WS_WOUT) + (size_t)l * DM * DM; resK = DM; resS = 1.0f; lnidx = 1;
            if (IN(base)) {
                pg8::Gemm g{xh, (const h16*)(ws + WS_WIN) + (size_t)l * NIN * DM, S, NIN, DM}; pg8::StaticOrder So; So.init(S, NIN, F.G, (int)blockIdx.x);
                EpiProj<JOB_WIN> E{ws, 0};
                PH(GWIN, (pg8::gemm_phase<EpiProj<JOB_WIN>, pg8::StaticOrder, true, true>(F.lds, g, So, E)));
                END(base);
            }
            if (IN(base + 1)) {
                { pg8::Gemm g{(const h16*)(ws + WS_BCQ), (const h16*)(ws + WS_WUQ) + (size_t)l * 768 * 512, S, 768, 512}; pg8::StaticOrder So; So.init(S, 768, F.G, (int)blockIdx.x);
                  EpiProj<JOB_UQ> E{ws, 0}; PH(GUQ, (pg8::gemm_phase<EpiProj<JOB_UQ>, pg8::StaticOrder, true, true>(F.lds, g, So, E))); }
                { pg8::Gemm g{(const h16*)(ws + WS_BCKV), (const h16*)(ws + WS_WUKV) + (size_t)l * 1024 * 512, S, 1024, 512}; pg8::StaticOrder So; So.init(S, 1024, F.G, (int)blockIdx.x);
                  EpiProj<JOB_UKV> E{ws, 0}; PH(GUKV, (pg8::gemm_phase<EpiProj<JOB_UKV>, pg8::StaticOrder, true, true>(F.lds, g, So, E))); }
                for (int br = 0; br < 2; ++br) {
                  pg8::Gemm g{(const h16*)(ws + (br ? WS_VCMP : WS_KCMP)), (const h16*)(ws + WS_WC1) + (size_t)(l * 2 + br) * 256 * 2048, 512, 256, 2048}; pg8::StaticOrder So; So.init(512, 256, F.G, (int)blockIdx.x);
                  EpiProj<JOB_Y> E{ws, br}; PH(GY, (pg8::gemm_phase<EpiProj<JOB_Y>, pg8::StaticOrder, true, true>(F.lds, g, So, E))); }
                __syncthreads();
                PH(KMEAN, moba_kmean_phase(F));
                END(base + 1);
            }
            if (IN(base + 2)) { PH(CMP2, nsa_cmp2_phase(F, l)); PH(GATE, moba_gate_phase(F)); dsx::score_phase(F); END(base + 2); }
            if (IN(base + 3)) {
#if USE_FA
                fa_cmp_phase(F); nsa_imp_phase(F);
#else
                PH(CMPSEL, nsa_cmp_select_phase(F));
#endif
                PH(TOPK, dsa_topk_phase(F)); END(base + 3); }
            if (IN(base + 4)) {
#if USE_FA
                fa_mixer_phase(F, l);
                if (!(FA_MASK & 1)) mla_attn_phase(F);
                if (!(FA_MASK & 2)) nsa_attn_phase(F);
                if (!(FA_MASK & 4)) moba_attn_phase(F);
                if (!(FA_MASK & 8)) dsa_attn_phase(F);
#else
                PH(MOBA, moba_attn_phase(F)); PH(MLA, mla_attn_phase(F)); PH(NSA, nsa_attn_phase(F)); PH(DSA, dsa_attn_phase(F));
#endif
                END(base + 4); }
        } else {
            resA = (const h16*)(ws + WS_MO); resB = (const h16*)(ws + WS_WMO) + (size_t)l * DM * 512; resK = 512; resS = 1.0f; lnidx = 2;
            if (IN(base)) {
                pg8::Gemm g{xh, (const h16*)(ws + WS_WMQ) + (size_t)l * 512 * DM, S, 512, DM}; pg8::StaticOrder So; So.init(S, 512, F.G, (int)blockIdx.x);
                EpiProj<JOB_MQ> E{ws, 0};
                PH(GMQ, (pg8::gemm_phase<EpiProj<JOB_MQ>, pg8::StaticOrder, true, true>(F.lds, g, So, E)));
                END(base);
            }
            if (IN(base + 1)) {
#if USE_FA
                if (FA_MASK & 16) fa_mem_phase(F, l); else mem_attn_phase(F, l);
#else
                PH(MEMA, mem_attn_phase(F, l));
#endif
                END(base + 1); }
        }
        if (IN(base + 5)) {
            pg8::Gemm g{resA, resB, S, DM, resK}; pg8::StaticOrder So; So.init(S, DM, F.G, (int)blockIdx.x);
            EpiResid E{xf, z, resS};
            PH(GRESID, (pg8::gemm_phase<EpiResid, pg8::StaticOrder, true, true>(F.lds, g, So, E)));
            END(base + 5);
        }
        if (IN(base + 6)) {
            const float* g = (const float*)(ws + WS_LNG) + (size_t)(l * 4 + lnidx) * DM; const float* b = (const float*)(ws + WS_LNB) + (size_t)(l * 4 + lnidx) * DM;
            PH(LN, ln_phase(F, z, g, b, sb == 15 ? F.out : (float*)(ws + WS_XF), (h16*)(ws + WS_XH)));
            END(base + 6);
        }
    }
#undef IN
#undef END
}

extern "C" void kernel_launch(void* const* d_in, const int* in_sizes, int n_in, void* d_out, int out_size, void* d_ws, size_t ws_size, hipStream_t stream) {
    static int grid = 0;
    if (grid == 0) {
        if (n_in != 19 || out_size != S * DM || ws_size < WS_END) { fprintf(stderr, "kernel_launch: unexpected shapes (n_in %d, out %d, ws %zu < %zu)\n", n_in, out_size, ws_size, (size_t)WS_END); grid = -1; return; }
        int dev = 0, cus = 0, per_cu = 0;
        if (hipGetDevice(&dev) != hipSuccess || hipDeviceGetAttribute(&cus, hipDeviceAttributeMultiprocessorCount, dev) != hipSuccess) { grid = -1; return; }
        if (hipFuncSetAttribute((const void*)mk_fwd, hipFuncAttributeMaxDynamicSharedMemorySize, LDS_BYTES) != hipSuccess) { fprintf(stderr, "kernel_launch: hipFuncSetAttribute failed\n"); grid = -1; return; }
        if (hipOccupancyMaxActiveBlocksPerMultiprocessor(&per_cu, (const void*)mk_fwd, NTHREADS, LDS_BYTES) != hipSuccess || per_cu < 1) { fprintf(stderr, "kernel_launch: occupancy query says %d\n", per_cu); }
        (void)hipGetLastError();
        grid = cus;
    }
    if (grid < 0) return;
    if (hipMemsetAsync((char*)d_ws + WS_CTL, 0, CTL_BYTES, stream) != hipSuccess) return;
    Args a{};
    for (int i = 0; i < 19; ++i) a.in[i] = (const float*)d_in[i];
    a.out = (float*)d_out; a.ws = (unsigned char*)d_ws;
#if MK_STEP_LAUNCHES
    for (int st = 0; st < NSTEPS; ++st) {
        if (st >= 2) { const int sb = (st - 2) / SLOTS, slot = (st - 2) % SLOTS, kind = sb & 3;
            const bool live = slot >= 5 || slot == 0 || (kind == 1 && slot <= 4) || (kind == 2 && slot == 1);
            if (!live) continue; }
        a.lo = st; a.hi = st + 1;
        hipLaunchKernelGGL(mk_fwd, dim3(grid), dim3(NTHREADS), LDS_BYTES, stream, a);
    }
#else
    a.lo = 0; a.hi = NSTEPS;
    hipLaunchKernelGGL(mk_fwd, dim3(grid), dim3(NTHREADS), LDS_BYTES, stream, a);
#endif
}
```

```cpp
#include <hip/hip_runtime.h>
#include <cstdio>
#include <cstdint>

#ifndef PROBE_P0
#define PROBE_P0 1
#endif
#ifndef USE_FA
#define USE_FA 1
#endif
#ifndef FA_MASK
#define FA_MASK 0x1f
#endif
#ifndef MK_STEP_LAUNCHES
#define MK_STEP_LAUNCHES 0
#endif

#define GAS __attribute__((address_space(1)))
#define LAS __attribute__((address_space(3)))
typedef _Float16 h16;
typedef _Float16 half8 __attribute__((ext_vector_type(8)));
typedef _Float16 half4 __attribute__((ext_vector_type(4)));
typedef _Float16 half2v __attribute__((ext_vector_type(2)));
typedef float f32x4 __attribute__((ext_vector_type(4)));
typedef float f32x2 __attribute__((ext_vector_type(2)));
typedef unsigned u32x4 __attribute__((ext_vector_type(4)));
typedef unsigned long long u64;

constexpr int S = 8192, DM = 2048, DFF = 5632, DEPTH = 4, MEMLEN = 256;
constexpr int D_IN = 6556, NIN = 6656;
constexpr float LN_EPS = 1e-5f, RMS_EPS = 1e-6f;
constexpr float DN_ALPHA = 1.681792830507429f;
constexpr int NWAVES = 8, NTHREADS = 512;

constexpr size_t al256(size_t x) { return (x + 255) & ~(size_t)255; }
constexpr size_t WS_CTL = 0, CTL_BYTES = 1u << 20;
constexpr size_t WS_WGU  = CTL_BYTES;
constexpr size_t WS_WD   = WS_WGU  + (size_t)DEPTH * 2 * 2 * DFF * DM * 2;
constexpr size_t WS_WIN  = WS_WD   + (size_t)DEPTH * 2 * DM * DFF * 2;
constexpr size_t WS_WOUT = WS_WIN  + (size_t)DEPTH * NIN * DM * 2;
constexpr size_t WS_WUQ  = WS_WOUT + (size_t)DEPTH * DM * DM * 2;
constexpr size_t WS_WUKV = WS_WUQ  + (size_t)DEPTH * 768 * 512 * 2;
constexpr size_t WS_WC1  = WS_WUKV + (size_t)DEPTH * 1024 * 512 * 2;
constexpr size_t WS_WMQ  = WS_WC1  + (size_t)DEPTH * 2 * 256 * 2048 * 2;
constexpr size_t WS_WMKV = WS_WMQ  + (size_t)DEPTH * 512 * DM * 2;
constexpr size_t WS_WMO  = WS_WMKV + (size_t)DEPTH * 1024 * DM * 2;
constexpr size_t WS_XF   = WS_WMO  + (size_t)DEPTH * DM * 512 * 2;
constexpr size_t WS_XH   = WS_XF   + (size_t)S * DM * 4;
constexpr size_t WS_Z    = WS_XH   + (size_t)S * DM * 2;
constexpr size_t WS_HB   = WS_Z    + (size_t)S * DM * 4;
constexpr size_t WS_MEMH = WS_HB   + (size_t)S * DFF * 2;
constexpr size_t WS_MK   = WS_MEMH + (size_t)MEMLEN * DM * 2;
constexpr size_t WS_MV   = WS_MK   + (size_t)DEPTH * 4 * MEMLEN * 128 * 2;
constexpr size_t WS_T128C = WS_MV  + (size_t)DEPTH * 4 * MEMLEN * 128 * 2;
constexpr size_t WS_T128S = WS_T128C + (size_t)S * 64 * 4;
constexpr size_t WS_T64C  = WS_T128S + (size_t)S * 64 * 4;
constexpr size_t WS_T64S  = WS_T64C + (size_t)S * 32 * 4;
constexpr size_t HEADBUF = (size_t)S * 128 * 2;
constexpr size_t WS_AQ   = WS_T64S + (size_t)S * 32 * 4;
constexpr size_t WS_AK   = WS_AQ + 4 * HEADBUF;
constexpr size_t WS_AV   = WS_AK + 4 * HEADBUF;
constexpr size_t WS_BCQ  = WS_AV + 4 * HEADBUF;
constexpr size_t WS_BCKV = WS_BCQ + (size_t)S * 512 * 2;
constexpr size_t WS_BKR  = WS_BCKV + (size_t)S * 512 * 2;
constexpr size_t WS_Q192 = WS_BKR + (size_t)S * 64 * 2;
constexpr size_t WS_KN   = WS_Q192 + (size_t)4 * S * 192 * 2;
constexpr size_t WS_BV   = WS_KN + 4 * HEADBUF;
constexpr size_t WS_CQRAW = WS_BV + 4 * HEADBUF;
constexpr size_t WS_CQROPE = WS_CQRAW + 4 * HEADBUF;
constexpr size_t WS_KCMP = WS_CQROPE + 4 * HEADBUF;
constexpr size_t WS_VCMP = WS_KCMP + HEADBUF;
constexpr size_t WS_KSLC = WS_VCMP + HEADBUF;
constexpr size_t WS_VSLC = WS_KSLC + HEADBUF;
constexpr size_t WS_KWIN = WS_VSLC + HEADBUF;
constexpr size_t WS_VWIN = WS_KWIN + HEADBUF;
constexpr size_t WS_SMALL = WS_VWIN + HEADBUF;
constexpr size_t WS_DQ   = WS_SMALL + (size_t)S * 32 * 4;
constexpr size_t WS_DK   = WS_DQ + 4 * HEADBUF;
constexpr size_t WS_DV   = WS_DK + 4 * HEADBUF;
constexpr size_t WS_IQ   = WS_DV + 4 * HEADBUF;
constexpr size_t WS_IK   = WS_IQ + (size_t)S * 1024 * 2;
constexpr size_t WS_SSQQ = WS_IK + (size_t)S * 64 * 2;
constexpr size_t WS_SSQKV = WS_SSQQ + (size_t)S * 8 * 4;
constexpr size_t WS_YK   = WS_SSQKV + (size_t)S * 8 * 4;
constexpr size_t WS_YV   = WS_YK + (size_t)4 * 512 * 256 * 4;
constexpr size_t WS_KC   = WS_YV + (size_t)4 * 512 * 256 * 4;
constexpr size_t WS_VC   = WS_KC + (size_t)512 * 128 * 4;
constexpr size_t WS_CBIAS = WS_VC + (size_t)512 * 128 * 4;
constexpr size_t WS_KMEAN = WS_CBIAS + (size_t)DEPTH * 2 * 128 * 4;
constexpr size_t WS_MOBASEL = WS_KMEAN + (size_t)4 * 32 * 128 * 4;
constexpr size_t WS_OCMP = WS_MOBASEL + (size_t)S * 16 * 4;
constexpr size_t WS_NSASEL = WS_OCMP + (size_t)S * 512 * 4;
constexpr size_t WS_NSAMASK = WS_NSASEL + (size_t)S * 16 * 4;
constexpr size_t WS_DSALIST = WS_NSAMASK + (size_t)S * 4 * 4;
constexpr size_t WS_DSAMASK = WS_DSALIST + (size_t)S * 256 * 4;
constexpr size_t WS_OMIX = WS_DSAMASK + (size_t)S * 128 * 8;
constexpr size_t WS_MQ   = WS_OMIX + (size_t)S * DM * 2;
constexpr size_t WS_MO   = WS_MQ + 4 * HEADBUF;
constexpr size_t WS_KC16 = WS_MO + (size_t)S * 512 * 2;
constexpr size_t WS_VC16 = WS_KC16 + (size_t)512 * 128 * 2;
constexpr size_t WS_LNG = WS_VC16 + (size_t)512 * 128 * 2;
constexpr size_t WS_LNB = WS_LNG + (size_t)16 * DM * 4;
constexpr size_t WS_W2C = WS_LNB + (size_t)16 * DM * 4;
constexpr size_t WS_SCORES = al256(WS_W2C + (size_t)8 * 128 * 128 * 4);
constexpr size_t WS_END  = WS_SCORES + (size_t)S * S * 4;

constexpr int CW_TMO = 0, CW_CODE = 1, CW_BAR = 4096;

constexpr int RING_BYTES = 131072;
constexpr int LDSCTL_OFF = RING_BYTES, MISC_OFF = LDSCTL_OFF + 320;
constexpr int LDS_BYTES = 147456;

#define RLX_AGENT __ATOMIC_RELAXED, __HIP_MEMORY_SCOPE_AGENT
#define LDS_WAIT() asm volatile("s_waitcnt lgkmcnt(0)" ::: "memory")
#define VM_WAIT() asm volatile("s_waitcnt vmcnt(0)" ::: "memory")

__device__ const double ROPE_INV[64] = {
1.0, 0.8659643233600653, 0.7498942093324559, 0.6493816315762113,
0.5623413251903491, 0.4869675251658631, 0.4216965034285822, 0.3651741272548377,
0.31622776601683794, 0.27384196342643613, 0.23713737056616552, 0.2053525026457146,
0.1778279410038923, 0.1539926526059492, 0.1333521432163324, 0.11547819846894582,
0.1, 0.08659643233600653, 0.07498942093324558, 0.06493816315762113,
0.05623413251903491, 0.04869675251658631, 0.042169650342858224, 0.03651741272548377,
0.03162277660168379, 0.027384196342643614, 0.023713737056616554, 0.02053525026457146,
0.01778279410038923, 0.01539926526059492, 0.01333521432163324, 0.011547819846894581,
0.01, 0.008659643233600654, 0.007498942093324558, 0.006493816315762113,
0.005623413251903491, 0.004869675251658631, 0.004216965034285823, 0.003651741272548377,
0.0031622776601683794, 0.0027384196342643613, 0.0023713737056616554, 0.002053525026457146,
0.0017782794100389228, 0.001539926526059492, 0.001333521432163324, 0.0011547819846894581,
0.001, 0.0008659643233600654, 0.0007498942093324559, 0.0006493816315762113,
0.0005623413251903491, 0.0004869675251658631, 0.00042169650342858224, 0.0003651741272548377,
0.00031622776601683794, 0.0002738419634264361, 0.00023713737056616554, 0.0002053525026457146,
0.00017782794100389227, 0.0001539926526059492, 0.0001333521432163324, 0.00011547819846894582
};
namespace pg8 {
constexpr int BM = 256, BK = 64, HALF = 128, HTB = HALF * BK * 2, STAGE_BYTES = 8 * HTB, NXCD = 8, WGM = 8;
__host__ __device__ __forceinline__ int lds_byte(int r, int c) { const int st = (r >> 4) * 2 + (c >> 5), rr = r & 15, cc = c & 31, ob = rr * 64 + cc * 2; return st * 1024 + (ob ^ (((ob >> 9) & 1) << 5)); }
__host__ __device__ __forceinline__ void stage_rc(int b, int& R, int& C) { const int st = b / 1024, sb = b % 1024, swz = sb ^ (((sb >> 9) & 1) << 5); R = (st >> 1) * 16 + swz / 64; C = (st & 1) * 32 + (swz % 64) / 2; }
__host__ __device__ __forceinline__ int perm32(int rho) { const int n = rho >> 4, i = rho & 15; return 8 * (i >> 2) + 4 * n + (i & 3); }
struct Unit { int pm, pn; };
struct Gemm { const h16* A; const h16* Bt; int M, N, K; int lda = 0, ldb = 0; };
struct OneUnit { int pm, pn; bool valid;
    __device__ __forceinline__ bool next(int i, Unit& u) const { if (i != 0 || !valid) return false; u.pm = pm; u.pn = pn; return true; }
    __device__ __forceinline__ void a_ready(const Unit&) const {}
    __device__ __forceinline__ void done(const Unit&) const {} };
struct StaticOrder {
    int nM, nN, nwg, G, c;
    __host__ __device__ void init(int M, int N, int G_, int c_) { nM = M / BM; nN = N / BM; nwg = nM * nN; G = G_; c = c_; }
    __host__ __device__ bool next(int i, Unit& u) const {
        const long L = (long)i * G + c; if (L >= nwg) return false;
        int wgid = (int)L; { const int q = nwg / NXCD, r = nwg % NXCD, xcd = wgid % NXCD, off = wgid / NXCD; wgid = (xcd < r ? xcd * (q + 1) : r * (q + 1) + (xcd - r) * q) + off; }
        const int nig = WGM * nN, gid = wgid / nig, fm = gid * WGM, gsz = (nM - fm) < WGM ? (nM - fm) : WGM;
        u.pm = fm + ((wgid % nig) % gsz); u.pn = (wgid % nig) / gsz; return true;
    }
    __device__ __forceinline__ void a_ready(const Unit&) const {}
    __device__ __forceinline__ void done(const Unit&) const {}
};
template <class Epi, class Sched, bool ALIGN_EPI = false, bool SP2 = false>
__device__ __forceinline__ void gemm_phase(LAS unsigned char* lds, const Gemm g, const Sched& S, const Epi& E) {
    int tid_ = threadIdx.x; asm volatile("" : "+v"(tid_));
    const int tid = tid_, wid = __builtin_amdgcn_readfirstlane(tid >> 6), lane = tid & 63, wr = wid >> 2, wc = wid & 3, fr = lane & 15, fq = lane >> 4;
    const int K = g.K, nt = K / BK, lda = g.lda ? g.lda : K, ldb = g.ldb ? g.ldb : K;
    unsigned voffA[2], voffB[2];
#pragma unroll
    for (int i = 0; i < 2; ++i) { int R, C; stage_rc(tid * 16 + i * 8192, R, C); const int Rb = Epi::PERM ? ((R & ~31) + perm32(R & 31)) : R;
        voffA[i] = (unsigned)(R * lda + C) * 2u; voffB[i] = (unsigned)(Rb * ldb + C) * 2u; }
    const size_t kstep = (size_t)(BK * 2);
    const size_t hstepA = (size_t)HALF * lda * 2, hstepB = (size_t)HALF * ldb * 2;
    const size_t tstepA = 2 * hstepA, tstepB = 2 * hstepB;
    const unsigned ldsw = (unsigned)wid * 1024u;
    const int aoff = lds_byte(wr * 64 + fr, fq * 8), boff = lds_byte(wc * 32 + fr, fq * 8);
#define PG8_SA(b, h) (((b) * 2 + (h)) * HTB)
#define PG8_SB(b, h) ((4 + (b) * 2 + (h)) * HTB)
#define PG8_STAGE(bufoff, gbase, voff) do { _Pragma("unroll") for (int _i = 0; _i < 2; ++_i) \
        __builtin_amdgcn_global_load_lds((const unsigned*)((const char*)(gbase) + (voff)[_i]), (LAS unsigned*)(lds + (bufoff) + ldsw + _i * 8192), 16, 0, 0); } while (0)
#define PG8_LDA(dst, b, h) do { _Pragma("unroll") for (int m = 0; m < 4; ++m) _Pragma("unroll") for (int k = 0; k < 2; ++k) dst[m][k] = *(const LAS half8*)(lds + PG8_SA(b, h) + aoff + m * 2048 + k * 1024); } while (0)
#define PG8_LDB(dst, b, h) do { _Pragma("unroll") for (int n = 0; n < 2; ++n) _Pragma("unroll") for (int k = 0; k < 2; ++k) dst[n][k] = *(const LAS half8*)(lds + PG8_SB(b, h) + boff + n * 2048 + k * 1024); } while (0)
#define PG8_MMA(ai, bj, At, Bt) do { __builtin_amdgcn_s_setprio(1); _Pragma("unroll") for (int m = 0; m < 4; ++m) _Pragma("unroll") for (int n = 0; n < 2; ++n) _Pragma("unroll") for (int k = 0; k < 2; ++k) \
        acc[ai][bj][m][n] = __builtin_amdgcn_mfma_f32_16x16x32_f16(Bt[n][k], At[m][k], acc[ai][bj][m][n], 0, 0, 0); __builtin_amdgcn_s_setprio(0); } while (0)
#define PG8_WAIT_V(n) asm volatile("s_waitcnt vmcnt(" #n ")" ::: "memory")
#define PG8_WAIT_L(n) asm volatile("s_waitcnt lgkmcnt(" #n ")" ::: "memory")
#define PG8_BAR __builtin_amdgcn_s_barrier()
#define PG8_SCHED __builtin_amdgcn_sched_barrier(0)
    Unit cur, nxt; int ui = 0;
    if (!S.next(0, cur)) return;
    f32x4 acc[2][2][4][2];
#pragma unroll
    for (int a = 0; a < 2; ++a)
#pragma unroll
        for (int b = 0; b < 2; ++b)
#pragma unroll
            for (int m = 0; m < 4; ++m)
#pragma unroll
                for (int n = 0; n < 2; ++n) acc[a][b][m][n] = (f32x4){0.f, 0.f, 0.f, 0.f};
    half8 At[4][2], B0[2][2], B1[2][2];
    const char* cA = (const char*)g.A + (size_t)cur.pm * tstepA; const char* cB = (const char*)g.Bt + (size_t)cur.pn * tstepB;
    S.a_ready(cur);
    if constexpr (SP2) {
        PG8_STAGE(PG8_SB(0, 0), cB, voffB); PG8_STAGE(PG8_SB(0, 1), cB + hstepB, voffB); PG8_STAGE(PG8_SA(0, 0), cA, voffA); PG8_STAGE(PG8_SA(0, 1), cA + hstepA, voffA);
        if (wr == 1) PG8_BAR;
        PG8_WAIT_V(2); PG8_BAR;
        PG8_STAGE(PG8_SB(1, 0), cB + kstep, voffB); PG8_STAGE(PG8_SA(1, 0), cA + kstep, voffA); PG8_STAGE(PG8_SB(1, 1), cB + hstepB + kstep, voffB);
        PG8_WAIT_V(6); PG8_BAR;
    } else {
        PG8_STAGE(PG8_SB(0, 0), cB, voffB); PG8_STAGE(PG8_SA(0, 0), cA, voffA); PG8_STAGE(PG8_SB(0, 1), cB + hstepB, voffB); PG8_STAGE(PG8_SA(0, 1), cA + hstepA, voffA);
        if (wr == 1) PG8_BAR;
        PG8_WAIT_V(4); PG8_BAR;
        PG8_STAGE(PG8_SB(1, 0), cB + kstep, voffB); PG8_STAGE(PG8_SA(1, 0), cA + kstep, voffA); PG8_STAGE(PG8_SB(1, 1), cB + hstepB + kstep, voffB);
        PG8_WAIT_V(6); PG8_BAR;
    }
    for (;;) {
        const bool has_next = S.next(ui + 1, nxt);
        const char* nA = has_next ? (const char*)g.A + (size_t)nxt.pm * tstepA : cA; const char* nB = has_next ? (const char*)g.Bt + (size_t)nxt.pn * tstepB : cB;
        for (int t = 0; t < nt; t += 2) {
            const bool last = (t == nt - 2);
            const char* a1 = cA + (size_t)(t + 1) * kstep;
            const char* a2 = last ? nA : cA + (size_t)(t + 2) * kstep; const char* b2 = last ? nB : cB + (size_t)(t + 2) * kstep;
            const char* a3 = a2 + kstep; const char* b3 = b2 + kstep;
            if (last && has_next) S.a_ready(nxt);
            if constexpr (SP2) {
            PG8_LDB(B0, 0, 0); PG8_LDB(B1, 0, 1); PG8_SCHED; PG8_LDA(At, 0, 0); PG8_STAGE(PG8_SA(1, 1), a1 + hstepA, voffA);
            PG8_WAIT_V(8); PG8_WAIT_L(0); PG8_BAR; PG8_MMA(0, 0, At, B0); PG8_MMA(0, 1, At, B1); PG8_BAR; PG8_SCHED;
            PG8_LDA(At, 0, 1); PG8_STAGE(PG8_SB(0, 0), b2, voffB); PG8_STAGE(PG8_SB(0, 1), b2 + hstepB, voffB); PG8_STAGE(PG8_SA(0, 0), a2, voffA);
            PG8_WAIT_V(8); PG8_WAIT_L(0); PG8_BAR; PG8_MMA(1, 0, At, B0); PG8_MMA(1, 1, At, B1); PG8_BAR; PG8_SCHED;
            PG8_LDB(B0, 1, 0); PG8_LDB(B1, 1, 1); PG8_SCHED; PG8_LDA(At, 1, 0); PG8_STAGE(PG8_SA(0, 1), a2 + hstepA, voffA);
            PG8_WAIT_V(8); PG8_WAIT_L(0); PG8_BAR; PG8_MMA(0, 0, At, B0); PG8_MMA(0, 1, At, B1); PG8_BAR; PG8_SCHED;
            PG8_LDA(At, 1, 1); PG8_STAGE(PG8_SB(1, 0), b3, voffB); PG8_STAGE(PG8_SB(1, 1), b3 + hstepB, voffB); PG8_STAGE(PG8_SA(1, 0), a3, voffA);
            PG8_WAIT_V(8); PG8_WAIT_L(0); PG8_BAR; PG8_MMA(1, 0, At, B0); PG8_MMA(1, 1, At, B1); PG8_BAR; PG8_SCHED;
            } else {
            PG8_LDB(B0, 0, 0); PG8_SCHED; PG8_LDA(At, 0, 0); PG8_STAGE(PG8_SA(1, 1), a1 + hstepA, voffA);
            PG8_WAIT_L(8); PG8_BAR; PG8_WAIT_L(0); PG8_MMA(0, 0, At, B0); PG8_BAR; PG8_SCHED;
            PG8_LDB(B1, 0, 1); PG8_STAGE(PG8_SB(0, 0), b2, voffB);
            PG8_BAR; PG8_WAIT_L(0); PG8_MMA(0, 1, At, B1); PG8_BAR;
            PG8_LDA(At, 0, 1); PG8_STAGE(PG8_SA(0, 0), a2, voffA);
            PG8_BAR; PG8_WAIT_L(0); PG8_MMA(1, 0, At, B0); PG8_BAR; PG8_SCHED;
            PG8_STAGE(PG8_SB(0, 1), b2 + hstepB, voffB);
            PG8_WAIT_V(6); PG8_BAR; PG8_MMA(1, 1, At, B1); PG8_BAR;
            PG8_LDB(B0, 1, 0); PG8_SCHED; PG8_LDA(At, 1, 0); PG8_STAGE(PG8_SA(0, 1), a2 + hstepA, voffA);
            PG8_WAIT_L(8); PG8_BAR; PG8_WAIT_L(0); PG8_MMA(0, 0, At, B0); PG8_BAR; PG8_SCHED;
            PG8_LDB(B1, 1, 1); PG8_STAGE(PG8_SB(1, 0), b3, voffB);
            PG8_BAR; PG8_WAIT_L(0); PG8_MMA(0, 1, At, B1); PG8_BAR;
            PG8_LDA(At, 1, 1); PG8_STAGE(PG8_SA(1, 0), a3, voffA);
            PG8_BAR; PG8_WAIT_L(0); PG8_MMA(1, 0, At, B0); PG8_BAR; PG8_SCHED;
            PG8_STAGE(PG8_SB(1, 1), b3 + hstepB, voffB);
            PG8_WAIT_V(6); PG8_BAR; PG8_MMA(1, 1, At, B1); PG8_BAR;
            }
        }
        if constexpr (ALIGN_EPI) { if (wr == 0) PG8_BAR; }
        if constexpr (!Epi::AFTER_DRAIN) { E(acc, cur, wr, wc, fr, fq); S.done(cur); }
        if (!has_next) break;
#pragma unroll
        for (int a = 0; a < 2; ++a)
#pragma unroll
            for (int b = 0; b < 2; ++b)
#pragma unroll
                for (int m = 0; m < 4; ++m)
#pragma unroll
                    for (int n = 0; n < 2; ++n) acc[a][b][m][n] = (f32x4){0.f, 0.f, 0.f, 0.f};
        cur = nxt; cA = nA; cB = nB; ++ui;
        if constexpr (ALIGN_EPI) { if (wr == 1) PG8_BAR; }
    }
    PG8_WAIT_V(0);
    if constexpr (!ALIGN_EPI) { if (wr == 0) PG8_BAR; }
    PG8_BAR;
    if constexpr (Epi::AFTER_DRAIN) { E.fused(acc, cur, wr, wc, fr, fq, lds, wid, lane); S.done(cur); }
#undef PG8_SA
#undef PG8_SB
#undef PG8_STAGE
#undef PG8_LDA
#undef PG8_LDB
#undef PG8_MMA
#undef PG8_WAIT_V
#undef PG8_WAIT_L
#undef PG8_BAR
#undef PG8_SCHED
}
}
#define XB_TMO      128
#define XB_XCNT(j)  (256  + 64 * (j))
#define XB_XSUB(j)  (1280 + 64 * (j))
#define XB_XGEN(j)  (2304 + 64 * (j))
#define XB_TOP      3328
#define XB_TOPGEN   3392
#define XCD_BAR_WORDS 3456
#define XB_SPIN_CAP (1u << 18)

__device__ __forceinline__ unsigned xb_ld(unsigned* p)              { return __hip_atomic_load(p, __ATOMIC_RELAXED, __HIP_MEMORY_SCOPE_AGENT); }
__device__ __forceinline__ unsigned xb_add(unsigned* p, unsigned v) { return __hip_atomic_fetch_add(p, v, __ATOMIC_RELAXED, __HIP_MEMORY_SCOPE_AGENT); }
__device__ __forceinline__ unsigned xb_xcc_id() { return (unsigned)__builtin_amdgcn_s_getreg((3 << 11) | 20) & 0xFu; }
#define XB_SPIN(cond, bar) do { unsigned _sp = 0; while (cond) { __builtin_amdgcn_s_sleep(1); \
    if ((++_sp & 255u) == 0u) { if (xb_ld(&(bar)[XB_TMO])) break; if (_sp > XB_SPIN_CAP) { atomicAdd(&(bar)[XB_TMO], 1u); break; } } } } while (0)

struct XcdBarrier {
    unsigned* bar; unsigned x;
    volatile LAS unsigned* st;
};

__device__ __forceinline__ XcdBarrier xcd_barrier_post(unsigned* bar, volatile LAS unsigned* st) {
    XcdBarrier b; b.bar = bar; b.x = xb_xcc_id(); b.st = st;
    if (threadIdx.x == 0) (void)xb_add(&bar[XB_XCNT(b.x)], 1u);
    return b;
}
__device__ __forceinline__ void xcd_barrier_complete(unsigned* bar, unsigned x, unsigned& nloc, unsigned& nx) {
    const unsigned G = gridDim.x * gridDim.y * gridDim.z;
    unsigned sum, cnt, mine, sp = 0u;
    for (;;) {
        sum = 0u; cnt = 0u; mine = 0u;
#pragma unroll
        for (unsigned j = 0; j < 16; ++j) { const unsigned c = xb_ld(&bar[XB_XCNT(j)]); sum += c; cnt += (c > 0u) ? 1u : 0u; mine = (j == x) ? c : mine; }
        if (sum == G) break;
        __builtin_amdgcn_s_sleep(1);
        if ((++sp & 255u) == 0u) { if (xb_ld(&bar[XB_TMO])) break; if (sp > XB_SPIN_CAP) { atomicAdd(&bar[XB_TMO], 1u); break; } }
    }
    nloc = mine > 0u ? mine : 1u; nx = cnt > 0u ? cnt : 1u;
}

__device__ __forceinline__ void xcd_barrier(const XcdBarrier& b) {
    asm volatile("s_waitcnt vmcnt(0)" ::: "memory");
    __syncthreads();
    if (threadIdx.x == 0) {
        unsigned* bar = b.bar;
        __builtin_amdgcn_s_waitcnt(0);
        unsigned nloc = b.st[0], nx = b.st[1];
        if (nloc == 0u) { xcd_barrier_complete(bar, b.x, nloc, nx); b.st[0] = nloc; b.st[1] = nx; }
        const unsigned old = xb_add(&bar[XB_XSUB(b.x)], 1u);
        const unsigned gen = old / nloc;
        if (old + 1u == (gen + 1u) * nloc) {
            __builtin_amdgcn_fence(__ATOMIC_RELEASE, "agent");
            asm volatile("s_waitcnt vmcnt(0)" ::: "memory");
            const unsigned og = xb_add(&bar[XB_TOP], 1u);
            const unsigned tg = og / nx;
            if (og + 1u == (tg + 1u) * nx) xb_add(&bar[XB_TOPGEN], 1u);
            else XB_SPIN(xb_ld(&bar[XB_TOPGEN]) == tg, bar);
            __builtin_amdgcn_fence(__ATOMIC_ACQUIRE, "agent");
            xb_add(&bar[XB_XGEN(b.x)], 1u);
            asm volatile("s_waitcnt vmcnt(0)" ::: "memory");
        } else {
            XB_SPIN(xb_ld(&bar[XB_XGEN(b.x)]) == gen, bar);
            __builtin_amdgcn_fence(__ATOMIC_ACQUIRE, "agent");
            asm volatile("s_waitcnt vmcnt(0)" ::: "memory");
        }
    }
    __syncthreads();
}
struct Frame {
    LAS unsigned char* lds;
    volatile LAS unsigned* MISC;
    unsigned* ctl;
    unsigned char* ws;
    int tid, lane, wave;
    int G;
    const float* in[19];
    float* out;
};
enum { IN_X = 0, IN_MEM, IN_POS, IN_LNG, IN_LNB, IN_WGU, IN_WD, IN_WIN, IN_WOUT, IN_GCQ, IN_GCKV, IN_WUQ, IN_WUKV, IN_PE, IN_W1, IN_W2, IN_MWQ, IN_MWKV, IN_MWO };

__device__ __forceinline__ float wave_sum(float v) {
#pragma unroll
    for (int o = 1; o < 64; o <<= 1) v += __shfl_xor(v, o);
    return v;
}
__device__ __forceinline__ float wave_max(float v) {
#pragma unroll
    for (int o = 1; o < 64; o <<= 1) v = fmaxf(v, __shfl_xor(v, o));
    return v;
}
__device__ __forceinline__ half8 pack_h8(f32x4 a, f32x4 b) {
    half8 r; r[0] = (h16)a[0]; r[1] = (h16)a[1]; r[2] = (h16)a[2]; r[3] = (h16)a[3]; r[4] = (h16)b[0]; r[5] = (h16)b[1]; r[6] = (h16)b[2]; r[7] = (h16)b[3]; return r;
}

struct EpiSwiglu {
    static constexpr bool PERM = true, AFTER_DRAIN = false;
    h16* H;
    __device__ __forceinline__ void operator()(const f32x4 (&acc)[2][2][4][2], const pg8::Unit& u, int wr, int wc, int fr, int fq) const {
        const int row0 = u.pm * 256 + wr * 64 + fr, col0 = u.pn * 128 + wc * 32 + 8 * fq;
#pragma unroll
        for (int ai = 0; ai < 2; ++ai)
#pragma unroll
            for (int m = 0; m < 4; ++m) {
                f32x4 o[2];
#pragma unroll
                for (int n = 0; n < 2; ++n)
#pragma unroll
                    for (int j = 0; j < 4; ++j) { const float g = acc[ai][0][m][n][j], uu = acc[ai][1][m][n][j]; o[n][j] = g * __builtin_amdgcn_rcpf(1.0f + __expf(-g)) * uu; }
                *(half8*)(H + (size_t)(row0 + ai * 128 + m * 16) * DFF + col0) = pack_h8(o[0], o[1]);
            }
    }
};
struct EpiResid {
    static constexpr bool PERM = false, AFTER_DRAIN = false;
    const float* xf; float* z; float s;
    __device__ __forceinline__ void operator()(const f32x4 (&acc)[2][2][4][2], const pg8::Unit& u, int wr, int wc, int fr, int fq) const {
        const int row0 = u.pm * 256 + wr * 64 + fr, col0 = u.pn * 256 + wc * 32 + 4 * fq;
#pragma unroll
        for (int ai = 0; ai < 2; ++ai)
#pragma unroll
            for (int m = 0; m < 4; ++m) { const size_t off = (size_t)(row0 + ai * 128 + m * 16) * DM + col0;
#pragma unroll
                for (int bj = 0; bj < 2; ++bj)
#pragma unroll
                    for (int n = 0; n < 2; ++n) { const f32x4 xv = *(const f32x4*)(xf + off + bj * 128 + n * 16); *(f32x4*)(z + off + bj * 128 + n * 16) = xv * DN_ALPHA + acc[ai][bj][m][n] * s; } }
    }
};

enum { JOB_WIN = 0, JOB_UQ, JOB_UKV, JOB_Y, JOB_MQ, JOB_MKV };
struct WaveDst { h16* p0; h16* p1; int ld; int colA, colB; int rope; h16* raw; float* f32p; float* ssq; int ssq_part; bool none; };
template <int JOB> __device__ __forceinline__ WaveDst proj_dst(unsigned char* ws, int t, int wc, int fq, int aux) {
    WaveDst d; d.p0 = nullptr; d.p1 = nullptr; d.ld = 128; d.rope = 0; d.raw = nullptr; d.f32p = nullptr; d.ssq = nullptr; d.ssq_part = 0; d.none = false;
    const int cp = wc * 32 + 8 * fq;
    d.colA = cp & 63; d.colB = cp & 63;
    const int hs = wc >> 1;
    if constexpr (JOB == JOB_WIN) {
        if (t < 11) {
            d.rope = 1; d.colB = d.colA + 64;
            size_t base;
            if (t < 2) base = WS_AQ + (size_t)(2 * t + hs) * HEADBUF;
            else if (t < 4) base = WS_AK + (size_t)(2 * (t - 2) + hs) * HEADBUF;
            else if (t < 6) { base = WS_CQROPE + (size_t)(2 * (t - 4) + hs) * HEADBUF; d.raw = (h16*)(ws + WS_CQRAW + (size_t)(2 * (t - 4) + hs) * HEADBUF); }
            else if (t == 6) base = hs ? WS_KWIN : WS_KSLC;
            else if (t < 9) base = WS_DQ + (size_t)(2 * (t - 7) + hs) * HEADBUF;
            else base = WS_DK + (size_t)(2 * (t - 9) + hs) * HEADBUF;
            d.p0 = d.p1 = (h16*)(ws + base);
        } else if (t < 15) {
            d.rope = 2; d.colA = cp & 31; d.colB = d.colA + 32; d.ld = 1024;
            d.p0 = d.p1 = (h16*)(ws + WS_IQ) + (4 * (t - 11) + wc) * 64;
        } else if (t == 15) {
            d.colA = cp & 31; d.colB = d.colA + 32; d.ld = 64;
            if (wc == 0) { d.rope = 2; d.p0 = d.p1 = (h16*)(ws + WS_BKR); }
            else if (wc == 1) { d.rope = 2; d.p0 = d.p1 = (h16*)(ws + WS_IK); }
            else if (wc == 2) { d.f32p = (float*)(ws + WS_SMALL); d.ld = 32; }
            else d.none = true;
        } else {
            if (t < 18) { const int h0 = 2 * (t - 16); d.p0 = (h16*)(ws + WS_AV + (size_t)h0 * HEADBUF) + 64 * hs; d.p1 = (h16*)(ws + WS_AV + (size_t)(h0 + 1) * HEADBUF) + 64 * hs; }
            else if (t < 20) { d.ld = 512; d.p0 = (h16*)(ws + WS_BCQ) + 256 * (t - 18) + 64 * hs; d.p1 = d.p0 + 128; d.ssq = (float*)(ws + WS_SSQQ); d.ssq_part = (t - 18) * 4 + wc; }
            else if (t < 22) { d.ld = 512; d.p0 = (h16*)(ws + WS_BCKV) + 256 * (t - 20) + 64 * hs; d.p1 = d.p0 + 128; d.ssq = (float*)(ws + WS_SSQKV); d.ssq_part = (t - 20) * 4 + wc; }
            else if (t == 22) { d.p0 = (h16*)(ws + WS_KCMP) + 64 * hs; d.p1 = (h16*)(ws + WS_VCMP) + 64 * hs; }
            else if (t == 23) { d.p0 = (h16*)(ws + WS_VSLC) + 64 * hs; d.p1 = (h16*)(ws + WS_VWIN) + 64 * hs; }
            else { const int h0 = 2 * (t - 24); d.p0 = (h16*)(ws + WS_DV + (size_t)h0 * HEADBUF) + 64 * hs; d.p1 = (h16*)(ws + WS_DV + (size_t)(h0 + 1) * HEADBUF) + 64 * hs; }
        }
    } else if constexpr (JOB == JOB_UQ) {
        d.ld = 192;
        if (t < 2) { d.p0 = (h16*)(ws + WS_Q192) + (size_t)(2 * t) * S * 192 + 64 * hs; d.p1 = (h16*)(ws + WS_Q192) + (size_t)(2 * t + 1) * S * 192 + 64 * hs; }
        else { d.rope = 2; d.colA = cp & 31; d.colB = d.colA + 32; d.p0 = d.p1 = (h16*)(ws + WS_Q192) + (size_t)wc * S * 192 + 128; }
        d.ssq = (float*)(ws + WS_SSQQ);
    } else if constexpr (JOB == JOB_UKV) {
        d.p0 = (h16*)(ws + WS_KN + (size_t)t * HEADBUF) + 64 * hs; d.p1 = (h16*)(ws + WS_BV + (size_t)t * HEADBUF) + 64 * hs;
        d.ssq = (float*)(ws + WS_SSQKV);
    } else if constexpr (JOB == JOB_Y) {
        d.f32p = (float*)(ws + ((aux & 1) ? WS_YV : WS_YK)) + (size_t)(aux >> 1) * 512 * 256; d.ld = 256;
    } else if constexpr (JOB == JOB_MQ) {
        d.p0 = (h16*)(ws + WS_MQ + (size_t)(2 * t) * HEADBUF) + 64 * hs; d.p1 = (h16*)(ws + WS_MQ + (size_t)(2 * t + 1) * HEADBUF) + 64 * hs;
    } else {
        const int layer = t >> 2, tt = t & 3, h0 = 2 * (tt & 1);
        const size_t kb = (tt >> 1) ? WS_MV : WS_MK;
        d.p0 = (h16*)(ws + kb) + (size_t)((layer * 4 + h0) * MEMLEN) * 128 + 64 * hs; d.p1 = (h16*)(ws + kb) + (size_t)((layer * 4 + h0 + 1) * MEMLEN) * 128 + 64 * hs;
    }
    return d;
}
template <int JOB> struct EpiProj {
    static constexpr bool PERM = true, AFTER_DRAIN = false;
    unsigned char* ws; int aux;
    __device__ __forceinline__ void operator()(const f32x4 (&acc)[2][2][4][2], const pg8::Unit& u, int wr, int wc, int fr, int fq) const {
        const WaveDst d = proj_dst<JOB>(ws, u.pn, wc, fq, aux);
        if (d.none) return;
        const int row0 = u.pm * 256 + wr * 64 + fr;
        const float* tc = (const float*)(ws + (d.rope == 1 ? WS_T128C : WS_T64C)); const float* ts = (const float*)(ws + (d.rope == 1 ? WS_T128S : WS_T64S));
        const int tw = d.rope == 1 ? 64 : 32;
#pragma unroll
        for (int ai = 0; ai < 2; ++ai)
#pragma unroll
            for (int m = 0; m < 4; ++m) {
                const int row = row0 + ai * 128 + m * 16;
                f32x4 a0 = acc[ai][0][m][0], a1 = acc[ai][0][m][1], b0 = acc[ai][1][m][0], b1 = acc[ai][1][m][1];
                if constexpr (JOB == JOB_UQ || JOB == JOB_UKV) {
                    const f32x4 s0 = *(const f32x4*)(d.ssq + (size_t)row * 8), s1 = *(const f32x4*)(d.ssq + (size_t)row * 8 + 4);
                    const float ss = ((s0[0] + s0[1]) + (s0[2] + s0[3])) + ((s1[0] + s1[1]) + (s1[2] + s1[3]));
                    const float rs = 1.0f / sqrtf(ss * (1.0f / 512.0f) + RMS_EPS);
                    a0 = a0 * rs; a1 = a1 * rs; b0 = b0 * rs; b1 = b1 * rs;
                }
                if constexpr (JOB == JOB_WIN) {
                    if (d.ssq) {
                        float q = 0.f;
#pragma unroll
                        for (int j = 0; j < 4; ++j) q += a0[j] * a0[j] + a1[j] * a1[j] + b0[j] * b0[j] + b1[j] * b1[j];
                        q += __shfl_xor(q, 16); q += __shfl_xor(q, 32);
                        if (fq == 0) d.ssq[(size_t)row * 8 + d.ssq_part] = q;
                    }
                    if (d.raw) { *(half8*)(d.raw + (size_t)row * 128 + d.colA) = pack_h8(a0, a1); *(half8*)(d.raw + (size_t)row * 128 + d.colB) = pack_h8(b0, b1); }
                }
                if (d.f32p) {
                    if constexpr (JOB == JOB_Y) { float* p = d.f32p + (size_t)row * 256 + wc * 32 + 8 * fq; *(f32x4*)p = a0; *(f32x4*)(p + 4) = a1; *(f32x4*)(p + 128) = b0; *(f32x4*)(p + 132) = b1; }
                    else { float* p = d.f32p + (size_t)row * 32 + d.colA; *(f32x4*)p = a0; *(f32x4*)(p + 4) = a1; }
                    continue;
                }
                if (d.rope) {
                    const size_t ti = (size_t)row * tw + d.colA;
                    const f32x4 c0 = *(const f32x4*)(tc + ti), c1 = *(const f32x4*)(tc + ti + 4), s0 = *(const f32x4*)(ts + ti), s1 = *(const f32x4*)(ts + ti + 4);
                    const f32x4 o0 = a0 * c0 - b0 * s0, o1 = a1 * c1 - b1 * s1, q0 = a0 * s0 + b0 * c0, q1 = a1 * s1 + b1 * c1;
                    a0 = o0; a1 = o1; b0 = q0; b1 = q1;
                }
                *(half8*)(d.p0 + (size_t)row * d.ld + d.colA) = pack_h8(a0, a1);
                *(half8*)(d.p1 + (size_t)row * d.ld + d.colB) = pack_h8(b0, b1);
            }
    }
};
__device__ __forceinline__ int win_map(int np) {
    const int t = np >> 8, c = np & 255;
    if (t < 11) {
        const int slot = (c >> 6) & 1, d = (c & 63) + 64 * (c >> 7);
        int base;
        if (t < 2) base = 0 + 256 * t + 128 * slot;
        else if (t < 4) base = 512 + 256 * (t - 2) + 128 * slot;
        else if (t < 6) base = 2624 + 256 * (t - 4) + 128 * slot;
        else if (t == 6) base = slot ? 3648 : 3392;
        else if (t < 9) base = 3916 + 256 * (t - 7) + 128 * slot;
        else base = 4428 + 256 * (t - 9) + 128 * slot;
        return base + d;
    }
    if (t < 15) { const int head = (c >> 5) & 3, d = (c & 31) + 32 * (c >> 7); return 5452 + 64 * (4 * (t - 11) + head) + d; }
    if (t == 15) {
        const int head = (c >> 5) & 3, half = c >> 7, d = (c & 31) + 32 * half;
        if (head == 0) return 2560 + d;
        if (head == 1) return 6476 + d;
        if (head == 2) { if (half) return -1; if (d < 12) return 3904 + d; if (d < 28) return 6540 + (d - 12); return -1; }
        return -1;
    }
    if (t < 18) return 1024 + 256 * (t - 16) + c;
    if (t < 20) return 1536 + 256 * (t - 18) + c;
    if (t < 22) return 2048 + 256 * (t - 20) + c;
    if (t == 22) return 3136 + c;
    if (t == 23) return c < 128 ? 3520 + c : 3776 + (c - 128);
    return 4940 + 256 * (t - 24) + c;
}
__device__ __forceinline__ int uq_map(int np) {
    const int t = np >> 8, c = np & 255;
    if (t < 2) { const int slot = c >> 6, head = 2 * t + (slot >> 1), d = 64 * (slot & 1) + (c & 63); return head * 192 + d; }
    const int head = (c >> 5) & 3, d = (c & 31) + 32 * (c >> 7); return head * 192 + 128 + d;
}
enum { WK_GU0 = 0, WK_GU1, WK_D0, WK_D1, WK_IN, WK_OUT, WK_UQ, WK_UKV, WK_C1K, WK_C1V, WK_MQ, WK_MKV, WK_MO, WK_N };
struct WJob { const float* W; h16* dst; int K, NP, kind; const float* kscale; };
__device__ __forceinline__ long wsrc(int kind, int k, int np) {
    switch (kind) {
        case WK_GU0: case WK_GU1: { const int pn = np >> 8, c = np & 255; const int col = c < 128 ? 128 * pn + c : DFF + 128 * pn + (c - 128); return (long)k * (2 * DFF) + col; }
        case WK_D0: case WK_D1: return (long)k * DM + np;
        case WK_IN: { const int col = win_map(np); return col < 0 ? -1 : (long)k * D_IN + col; }
        case WK_OUT: return (long)k * DM + np;
        case WK_UQ: return (long)k * 768 + uq_map(np);
        case WK_UKV: return (long)k * 1024 + np;
        case WK_C1K: case WK_C1V: return (long)((np >> 7) * 2048 + k) * 128 + (np & 127);
        case WK_MQ: return (long)k * 512 + np;
        case WK_MKV: return (long)k * 1024 + np;
        default: return (long)k * DM + np;
    }
}
__device__ __forceinline__ void p0_transpose_item(const WJob& J, LAS unsigned* scr, int item, int lane) {
    const int nblk = J.NP / 64, kb = item / nblk, nb = item % nblk, k0 = 64 * kb, n0 = 64 * nb;
    const int kp = lane >> 4, nq = lane & 15;
    const long s0 = wsrc(J.kind, 0, n0 + 4 * nq); const long kstride = wsrc(J.kind, 1, n0 + 4 * nq) - s0;
    f32x4 v[16];
#pragma unroll
    for (int p = 0; p < 8; ++p) { const int k = k0 + 8 * p + 2 * kp;
        if (s0 >= 0) { v[2 * p] = *(const f32x4*)(J.W + s0 + (long)k * kstride); v[2 * p + 1] = *(const f32x4*)(J.W + s0 + (long)(k + 1) * kstride); }
        else { v[2 * p] = (f32x4){0.f, 0.f, 0.f, 0.f}; v[2 * p + 1] = (f32x4){0.f, 0.f, 0.f, 0.f}; } }
#pragma unroll
    for (int p = 0; p < 8; ++p) { const int k = 8 * p + 2 * kp; f32x4 x = v[2 * p], y = v[2 * p + 1];
        if (J.kscale) { const float sa = J.kscale[k0 + k], sb = J.kscale[k0 + k + 1]; x = x * sa; y = y * sb; }
#pragma unroll
        for (int i = 0; i < 4; ++i) { half2v h; h[0] = (h16)x[i]; h[1] = (h16)y[i]; scr[(4 * nq + i) * 33 + (k >> 1)] = __builtin_bit_cast(unsigned, h); } }
    LDS_WAIT(); asm volatile("" ::: "memory");
    const int c = lane & 7, nn = lane >> 3;
#pragma unroll
    for (int j = 0; j < 8; ++j) { const int n = nn + 8 * j; const LAS unsigned* s = scr + n * 33 + 4 * c;
        u32x4 o = {s[0], s[1], s[2], s[3]};
        *(u32x4*)(J.dst + (size_t)(n0 + n) * J.K + k0 + 8 * c) = o; }
    LDS_WAIT(); asm volatile("" ::: "memory");
}
constexpr int WK_ITEMS[WK_N] = { 2 * DFF * DM / 4096, 2 * DFF * DM / 4096, DM * DFF / 4096, DM * DFF / 4096, NIN * DM / 4096, DM * DM / 4096, 768 * 512 / 4096, 1024 * 512 / 4096,
                                 256 * 2048 / 4096, 256 * 2048 / 4096, 512 * DM / 4096, 1024 * DM / 4096, DM * 512 / 4096 };
constexpr int wk_items_per_layer() { int s = 0; for (int i = 0; i < WK_N; ++i) s += WK_ITEMS[i]; return s; }
constexpr int IPL = wk_items_per_layer();
__device__ __forceinline__ WJob wjob(Frame& F, int l, int kind) {
    WJob J; J.kind = kind; J.kscale = nullptr;
    unsigned char* ws = F.ws;
    switch (kind) {
        case WK_GU0: case WK_GU1: { const int f = kind - WK_GU0; J.W = F.in[IN_WGU] + (size_t)(l * 2 + f) * DM * 2 * DFF; J.dst = (h16*)(ws + WS_WGU) + (size_t)(l * 2 + f) * 2 * DFF * DM; J.K = DM; J.NP = 2 * DFF; break; }
        case WK_D0: case WK_D1: { const int f = kind - WK_D0; J.W = F.in[IN_WD] + (size_t)(l * 2 + f) * DFF * DM; J.dst = (h16*)(ws + WS_WD) + (size_t)(l * 2 + f) * DM * DFF; J.K = DFF; J.NP = DM; break; }
        case WK_IN: J.W = F.in[IN_WIN] + (size_t)l * DM * D_IN; J.dst = (h16*)(ws + WS_WIN) + (size_t)l * NIN * DM; J.K = DM; J.NP = NIN; break;
        case WK_OUT: J.W = F.in[IN_WOUT] + (size_t)l * DM * DM; J.dst = (h16*)(ws + WS_WOUT) + (size_t)l * DM * DM; J.K = DM; J.NP = DM; break;
        case WK_UQ: J.W = F.in[IN_WUQ] + (size_t)l * 512 * 768; J.dst = (h16*)(ws + WS_WUQ) + (size_t)l * 768 * 512; J.K = 512; J.NP = 768; J.kscale = F.in[IN_GCQ] + l * 512; break;
        case WK_UKV: J.W = F.in[IN_WUKV] + (size_t)l * 512 * 1024; J.dst = (h16*)(ws + WS_WUKV) + (size_t)l * 1024 * 512; J.K = 512; J.NP = 1024; J.kscale = F.in[IN_GCKV] + l * 512; break;
        case WK_C1K: case WK_C1V: { const int i = kind - WK_C1K; J.W = F.in[IN_W1] + (size_t)(l * 2 + i) * 4096 * 128; J.dst = (h16*)(ws + WS_WC1) + (size_t)(l * 2 + i) * 256 * 2048; J.K = 2048; J.NP = 256; break; }
        case WK_MQ: J.W = F.in[IN_MWQ] + (size_t)l * DM * 512; J.dst = (h16*)(ws + WS_WMQ) + (size_t)l * 512 * DM; J.K = DM; J.NP = 512; break;
        case WK_MKV: J.W = F.in[IN_MWKV] + (size_t)l * DM * 1024; J.dst = (h16*)(ws + WS_WMKV) + (size_t)l * 1024 * DM; J.K = DM; J.NP = 1024; break;
        default: J.W = F.in[IN_MWO] + (size_t)l * 512 * DM; J.dst = (h16*)(ws + WS_WMO) + (size_t)l * DM * 512; J.K = 512; J.NP = DM; break;
    }
    return J;
}
__device__ __forceinline__ void sincos_d(double a, float& sn, float& cs) {
    const double k = __builtin_rint(a * 0.63661977236758134308);
    double r = __builtin_fma(-k, 1.57079632679489655800e+00, a); r = __builtin_fma(-k, 6.12323399573676603587e-17, r);
    const double r2 = r * r;
    double s = -1.0 / 1307674368000.0; s = s * r2 + 1.0 / 6227020800.0; s = s * r2 - 1.0 / 39916800.0; s = s * r2 + 1.0 / 362880.0; s = s * r2 - 1.0 / 5040.0; s = s * r2 + 1.0 / 120.0; s = s * r2 - 1.0 / 6.0; s = s * r2 * r + r;
    double c = 1.0 / 20922789888000.0; c = c * r2 - 1.0 / 87178291200.0; c = c * r2 + 1.0 / 479001600.0; c = c * r2 - 1.0 / 3628800.0; c = c * r2 + 1.0 / 40320.0; c = c * r2 - 1.0 / 720.0; c = c * r2 + 1.0 / 24.0; c = c * r2 - 0.5; c = c * r2 + 1.0;
    const int q = ((int)k) & 3;
    const double ss = (q == 0) ? s : (q == 1) ? c : (q == 2) ? -s : -c;
    const double cc = (q == 0) ? c : (q == 1) ? -s : (q == 2) ? -c : s;
    sn = (float)ss; cs = (float)cc;
}
__device__ __forceinline__ void p0_prologue(Frame& F) { int lane = F.lane; asm volatile("" : "+v"(lane));
    LAS unsigned* scr = (LAS unsigned*)(F.lds + F.wave * 16384);
    const int gw = blockIdx.x * NWAVES + F.wave, NGW = F.G * NWAVES;
    for (int it = gw; it < DEPTH * IPL; it += NGW) {
        const int l = it / IPL; int r = it % IPL; int kind = 0;
#pragma unroll
        for (int k = 0; k < WK_N; ++k) { if (kind == k && r >= WK_ITEMS[k]) { r -= WK_ITEMS[k]; kind = k + 1; } }
        const WJob J = wjob(F, l, kind);
        p0_transpose_item(J, scr, r, lane);
    }
    const int* pos = (const int*)F.in[IN_POS];
    for (int m = gw; m < S; m += NGW) {
        const f32x4* xr = (const f32x4*)(F.in[IN_X] + (size_t)m * DM) + lane;
        f32x4* xo = (f32x4*)((float*)(F.ws + WS_XF) + (size_t)m * DM) + lane;
        half4* xh = (half4*)((h16*)(F.ws + WS_XH) + (size_t)m * DM) + lane;
#pragma unroll
        for (int j = 0; j < 8; ++j) { const f32x4 v = xr[64 * j]; xo[64 * j] = v; half4 h; h[0] = (h16)v[0]; h[1] = (h16)v[1]; h[2] = (h16)v[2]; h[3] = (h16)v[3]; xh[64 * j] = h; }
        const double p = (double)pos[m];
        float sn, cs; sincos_d(p * ROPE_INV[lane], sn, cs);
        ((float*)(F.ws + WS_T128C))[(size_t)m * 64 + lane] = cs; ((float*)(F.ws + WS_T128S))[(size_t)m * 64 + lane] = sn;
        if ((lane & 1) == 0) { ((float*)(F.ws + WS_T64C))[(size_t)m * 32 + (lane >> 1)] = cs; ((float*)(F.ws + WS_T64S))[(size_t)m * 32 + (lane >> 1)] = sn; }
    }
    for (int m = gw; m < MEMLEN; m += NGW) {
        const f32x4* xr = (const f32x4*)(F.in[IN_MEM] + (size_t)m * DM) + lane;
        half4* xh = (half4*)((h16*)(F.ws + WS_MEMH) + (size_t)m * DM) + lane;
#pragma unroll
        for (int j = 0; j < 8; ++j) { const f32x4 v = xr[64 * j]; half4 h; h[0] = (h16)v[0]; h[1] = (h16)v[1]; h[2] = (h16)v[2]; h[3] = (h16)v[3]; xh[64 * j] = h; }
    }
    for (int i = gw * 64 + lane; i < 16 * DM; i += NGW * 64) { ((float*)(F.ws + WS_LNG))[i] = F.in[IN_LNG][i]; ((float*)(F.ws + WS_LNB))[i] = F.in[IN_LNB][i]; }
    for (int i = gw * 64 + lane; i < 8 * 128 * 128; i += NGW * 64) ((float*)(F.ws + WS_W2C))[i] = F.in[IN_W2][i];
    for (int it = gw; it < DEPTH * 2 * 8; it += NGW) {
        const int li = it >> 3, n = (it & 7) * 16 + (lane & 15), kq = lane >> 4;
        const float* pe = F.in[IN_PE] + (size_t)li * 4096; const float* w1 = F.in[IN_W1] + (size_t)li * 4096 * 128;
        float a = 0.f;
        for (int k = kq; k < 4096; k += 4) a += pe[k] * w1[(size_t)k * 128 + n];
        a += __shfl_xor(a, 16); a += __shfl_xor(a, 32);
        if (kq == 0) ((float*)(F.ws + WS_CBIAS))[li * 128 + n] = a;
    }
}
__device__ __forceinline__ void ln_phase(Frame& F, const float* z, const float* g, const float* b, float* of, h16* oh) { int lane = F.lane; asm volatile("" : "+v"(lane));
    const int gw = blockIdx.x * NWAVES + F.wave, NGW = F.G * NWAVES;
    f32x4 gv[8], bv[8];
#pragma unroll
    for (int j = 0; j < 8; ++j) { gv[j] = ((const f32x4*)g)[lane + 64 * j]; bv[j] = ((const f32x4*)b)[lane + 64 * j]; }
    for (int m = gw; m < S; m += NGW) {
        const f32x4* zr = (const f32x4*)(z + (size_t)m * DM) + lane;
        f32x4 v[8]; float s = 0.f;
#pragma unroll
        for (int j = 0; j < 8; ++j) { v[j] = zr[64 * j]; s += (v[j][0] + v[j][1]) + (v[j][2] + v[j][3]); }
        const float mean = wave_sum(s) * (1.f / DM); float s2 = 0.f;
#pragma unroll
        for (int j = 0; j < 8; ++j) { v[j] = v[j] - mean; s2 += (v[j][0] * v[j][0] + v[j][1] * v[j][1]) + (v[j][2] * v[j][2] + v[j][3] * v[j][3]); }
        const float rstd = 1.f / sqrtf(wave_sum(s2) * (1.f / DM) + LN_EPS);
        f32x4* orow = (f32x4*)(of + (size_t)m * DM) + lane; half4* hrow = (half4*)(oh + (size_t)m * DM) + lane;
#pragma unroll
        for (int j = 0; j < 8; ++j) { const f32x4 o = v[j] * rstd * gv[j] + bv[j]; orow[64 * j] = o; half4 h; h[0] = (h16)o[0]; h[1] = (h16)o[1]; h[2] = (h16)o[2]; h[3] = (h16)o[3]; hrow[64 * j] = h; }
    }
}
struct AttnAcc { float m, l, o0, o1; };
__device__ __forceinline__ void attn_init(AttnAcc& a) { a.m = -1e30f; a.l = 0.f; a.o0 = 0.f; a.o1 = 0.f; }
__device__ __forceinline__ float dot_h(const LAS float* qs, const h16* krow, int n16) {
    float acc = 0.f;
#pragma unroll 4
    for (int j = 0; j < n16; ++j) { const half8 w = *(const half8*)(krow + 8 * j); const f32x4 qa = *(const LAS f32x4*)(qs + 8 * j), qb = *(const LAS f32x4*)(qs + 8 * j + 4);
        acc += (float)w[0] * qa[0] + (float)w[1] * qa[1] + (float)w[2] * qa[2] + (float)w[3] * qa[3] + (float)w[4] * qb[0] + (float)w[5] * qb[1] + (float)w[6] * qb[2] + (float)w[7] * qb[3]; }
    return acc;
}
__device__ __forceinline__ void attn_chunk(AttnAcc& a, int key, float logit, const h16* V, int ldv, int lane) {
    const bool valid = key >= 0;
    const float lg = valid ? logit : -__builtin_inff();
    const float cmax = wave_max(lg);
    if (cmax == -__builtin_inff()) return;
    const float mn = fmaxf(a.m, cmax), alpha = __expf(a.m - mn);
    const float p = valid ? __expf(lg - mn) : 0.f;
    a.l = a.l * alpha + wave_sum(p); a.o0 *= alpha; a.o1 *= alpha; a.m = mn;
    u64 mask = __ballot(valid);
    while (mask) { const int j = __builtin_ctzll(mask); mask &= mask - 1;
        const float pj = __builtin_bit_cast(float, __builtin_amdgcn_readlane(__builtin_bit_cast(int, p), j)); const int kj = __builtin_amdgcn_readlane(key, j);
        const half2v v = *(const half2v*)(V + (size_t)kj * ldv + 2 * lane);
        a.o0 += pj * (float)v[0]; a.o1 += pj * (float)v[1]; }
}
__device__ __forceinline__ void load_q(LAS float* qs, const h16* q, int nd, int lane) {
    for (int i = lane; i < nd / 2; i += 64) { const half2v v = *(const half2v*)(q + 2 * i); qs[2 * i] = (float)v[0]; qs[2 * i + 1] = (float)v[1]; }
    LDS_WAIT(); asm volatile("" ::: "memory");
}
__device__ __forceinline__ void store_o(h16* dst, const AttnAcc& a, int lane) {
    const float inv = a.l > 0.f ? 1.0f / a.l : 0.f; half2v o; o[0] = (h16)(a.o0 * inv); o[1] = (h16)(a.o1 * inv); *(half2v*)(dst + 2 * lane) = o;
}
#define WAVE_ITEMS(it, total) for (int it = blockIdx.x * NWAVES + F.wave; it < (total); it += F.G * NWAVES)
constexpr float SC128 = 0.08838834764831845f, SC192 = 0.07216878364870323f;

__device__ __forceinline__ void moba_kmean_phase(Frame& F, int slot) { int lane = F.lane; asm volatile("" : "+v"(lane));
    const int it = slot * 8 + F.wave, h = it >> 5, n = it & 31; const h16* k = (const h16*)(F.ws + WS_AK + (size_t)h * HEADBUF) + (size_t)n * 256 * 128 + 2 * lane;
    float s0 = 0.f, s1 = 0.f;
#pragma unroll 16
    for (int r = 0; r < 256; ++r) { const half2v v = *(const half2v*)(k + (size_t)r * 128); s0 += (float)v[0]; s1 += (float)v[1]; }
    float* o = (float*)(F.ws + WS_KMEAN) + (size_t)it * 128 + 2 * lane; o[0] = s0 * (1.f / 256.f); o[1] = s1 * (1.f / 256.f);
}
__device__ __forceinline__ float gelu_tanh(float x) { const float u = 0.7978845608028654f * (x + 0.044715f * x * x * x); return 0.5f * x * (1.0f + tanhf(u)); }
__device__ __forceinline__ void nsa_cmp2_phase(Frame& F, int l) { int lane = F.lane; asm volatile("" : "+v"(lane));
    LAS float* hs = (LAS float*)(F.lds + F.wave * 16384);
    WAVE_ITEMS(it, 2 * 511) { const int br = it / 511, i = it % 511;
        const float* Y = (const float*)(F.ws + (br ? WS_YV : WS_YK)); const float* cb = (const float*)(F.ws + WS_CBIAS) + (l * 2 + br) * 128;
        const float* w2 = (const float*)(F.ws + WS_W2C) + (size_t)(l * 2 + br) * 128 * 128;
#pragma unroll
        for (int e = 0; e < 2; ++e) { const int n = lane + 64 * e; float a = cb[n];
#pragma unroll
            for (int ks = 0; ks < 4; ++ks) a += Y[(size_t)ks * 512 * 256 + (size_t)i * 256 + n] + Y[(size_t)ks * 512 * 256 + (size_t)(i + 1) * 256 + 128 + n];
            hs[n] = gelu_tanh(a); }
        LDS_WAIT(); asm volatile("" ::: "memory");
        float o0 = 0.f, o1 = 0.f;
        for (int k = 0; k < 128; ++k) { const float hv = hs[k]; o0 += hv * w2[k * 128 + lane]; o1 += hv * w2[k * 128 + 64 + lane]; }
        float* o = (float*)(F.ws + (br ? WS_VC : WS_KC)) + (size_t)i * 128; o[lane] = o0; o[64 + lane] = o1;
        h16* o16 = (h16*)(F.ws + (br ? WS_VC16 : WS_KC16)) + (size_t)i * 128; o16[lane] = (h16)o0; o16[64 + lane] = (h16)o1;
        if (i == 510) { o16[128 + lane] = (h16)0.f; o16[192 + lane] = (h16)0.f; }
        LDS_WAIT(); asm volatile("" ::: "memory"); }
}
__device__ __forceinline__ void moba_gate_phase(Frame& F) { int lane = F.lane; asm volatile("" : "+v"(lane));
    WAVE_ITEMS(it, S * 4) { const int t = it >> 2, h = it & 3, cur = t >> 8;
        int* sel = (int*)(F.ws + WS_MOBASEL) + (size_t)t * 16 + h * 4;
        const int n = lane & 31; float g = -__builtin_inff();
        if (n < cur) { const h16* q = (const h16*)(F.ws + WS_AQ + (size_t)h * HEADBUF) + (size_t)t * 128; const float* km = (const float*)(F.ws + WS_KMEAN) + (size_t)(h * 32 + n) * 128;
            float a = 0.f;
            for (int d = 0; d < 128; d += 8) { const half8 qv = *(const half8*)(q + d); const f32x4 k0 = *(const f32x4*)(km + d), k1 = *(const f32x4*)(km + d + 4);
                a += (float)qv[0] * k0[0] + (float)qv[1] * k0[1] + (float)qv[2] * k0[2] + (float)qv[3] * k0[3] + (float)qv[4] * k1[0] + (float)qv[5] * k1[1] + (float)qv[6] * k1[2] + (float)qv[7] * k1[3]; }
            g = a; }
        if (lane >= 32) g = -__builtin_inff();
#pragma unroll
        for (int r = 0; r < 3; ++r) { const float mx = wave_max(g); int idx = -1;
            if (mx > -__builtin_inff()) { const u64 bm = __ballot(g == mx); idx = __builtin_ctzll(bm); if (lane == idx) g = -__builtin_inff(); }
            if (lane == 0) sel[r] = idx; }
    }
}
__device__ __forceinline__ void dsa_score_phase(Frame& F) { int lane = F.lane; asm volatile("" : "+v"(lane));
    LAS float* qs = (LAS float*)(F.lds + F.wave * 16384);
    WAVE_ITEMS(t, S) {
        const h16* iq = (const h16*)(F.ws + WS_IQ) + (size_t)t * 1024;
#pragma unroll
        for (int e = 0; e < 2; ++e) { const half8 v = *(const half8*)(iq + (lane + 64 * e) * 8);
#pragma unroll
            for (int j = 0; j < 8; ++j) qs[(lane + 64 * e) * 8 + j] = (float)v[j]; }
        if (lane < 16) qs[1024 + lane] = ((const float*)(F.ws + WS_SMALL))[(size_t)t * 32 + 12 + lane] * (0.25f * 0.125f);
        LDS_WAIT(); asm volatile("" ::: "memory");
        float* sc = (float*)(F.ws + WS_SCORES) + (size_t)t * S;
        for (int c = 0; c * 64 <= t; ++c) { const int s = c * 64 + lane; const h16* ik = (const h16*)(F.ws + WS_IK) + (size_t)s * 64;
            float kv[64];
#pragma unroll
            for (int j = 0; j < 8; ++j) { const half8 v = *(const half8*)(ik + 8 * j);
#pragma unroll
                for (int e = 0; e < 8; ++e) kv[8 * j + e] = (float)v[e]; }
            float score = 0.f;
#pragma unroll 1
            for (int h = 0; h < 16; ++h) { float a = 0.f; const LAS float* qh = qs + h * 64;
#pragma unroll
                for (int d = 0; d < 64; d += 4) { const f32x4 q4 = *(const LAS f32x4*)(qh + d); a += q4[0] * kv[d] + q4[1] * kv[d + 1] + q4[2] * kv[d + 2] + q4[3] * kv[d + 3]; }
                score += qs[1024 + h] * fmaxf(a, 0.f); }
            sc[s] = score; }
        LDS_WAIT(); asm volatile("" ::: "memory");
    }
}
__device__ __forceinline__ void nsa_cmp_select_phase(Frame& F) { int lane = F.lane; asm volatile("" : "+v"(lane));
    LAS float* qs = (LAS float*)(F.lds + F.wave * 16384);
    LAS float* pp = qs + 256;
    const float* kc = (const float*)(F.ws + WS_KC); const float* vc = (const float*)(F.ws + WS_VC);
    WAVE_ITEMS(t, S) {
        const int nvis = t >= 31 ? ((t - 31) >> 4) + 1 : 0;
        float P[8];
#pragma unroll
        for (int c = 0; c < 8; ++c) P[c] = 0.f;
        for (int h = 0; h < 4; ++h) {
            load_q(qs, (const h16*)(F.ws + WS_CQRAW + (size_t)h * HEADBUF) + (size_t)t * 128, 128, lane);
            float lg[8]; float mx = -__builtin_inff();
#pragma unroll
            for (int c = 0; c < 8; ++c) { const int n = c * 64 + lane; lg[c] = -__builtin_inff();
                if (c * 64 < nvis) { const bool ok = n < nvis; const float* kr = kc + (size_t)(ok ? n : 0) * 128; float a = 0.f;
#pragma unroll 4
                    for (int d = 0; d < 128; d += 4) { const f32x4 k4 = *(const f32x4*)(kr + d); const f32x4 q4 = *(const LAS f32x4*)(qs + d); a += k4[0] * q4[0] + k4[1] * q4[1] + k4[2] * q4[2] + k4[3] * q4[3]; }
                    if (ok) lg[c] = a * SC128; }
                mx = fmaxf(mx, lg[c]); }
            mx = wave_max(mx);
            float o0 = 0.f, o1 = 0.f;
            if (nvis > 0) {
                float p[8]; float sum = 0.f;
#pragma unroll
                for (int c = 0; c < 8; ++c) { p[c] = lg[c] > -__builtin_inff() ? __expf(lg[c] - mx) : 0.f; sum += p[c]; }
                sum = wave_sum(sum); const float inv = 1.0f / sum;
#pragma unroll
                for (int c = 0; c < 8; ++c) { p[c] *= inv; P[c] += p[c];
                    if (c * 64 < nvis) { const int lim = min(64, nvis - c * 64);
                        for (int j = 0; j < lim; ++j) { const float pj = __builtin_bit_cast(float, __builtin_amdgcn_readlane(__builtin_bit_cast(int, p[c]), j)); const float* vr = vc + (size_t)(c * 64 + j) * 128;
                            o0 += pj * vr[lane]; o1 += pj * vr[64 + lane]; } } }
            }
            float* oc = (float*)(F.ws + WS_OCMP) + ((size_t)t * 4 + h) * 128; oc[lane] = o0; oc[64 + lane] = o1;
            LDS_WAIT(); asm volatile("" ::: "memory");
        }
#pragma unroll
        for (int c = 0; c < 8; ++c) { const int n = c * 64 + lane; if (n < 511) pp[n + 1] = P[c]; }
        if (lane == 0) { pp[0] = 0.f; pp[512] = 0.f; }
        LDS_WAIT(); asm volatile("" ::: "memory");
        const int cur = t >> 6;
        float v0, v1;
        { const int b = lane; float im = 0.f;
#pragma unroll
          for (int r = 0; r < 5; ++r) im += pp[4 * b + r];
          v0 = (b > cur) ? -__builtin_inff() : ((b == 0 || b == cur || b == cur - 1) ? __builtin_inff() : im); }
        { const int b = lane + 64; float im = 0.f;
#pragma unroll
          for (int r = 0; r < 5; ++r) im += pp[4 * b + r];
          v1 = (b > cur) ? -__builtin_inff() : ((b == cur || b == cur - 1) ? __builtin_inff() : im); }
        int* sel = (int*)(F.ws + WS_NSASEL) + (size_t)t * 16; unsigned m0 = 0, m1 = 0, m2 = 0, m3 = 0;
        for (int r = 0; r < 16; ++r) { const float mx = wave_max(fmaxf(v0, v1)); int idx = -1;
            if (mx > -__builtin_inff()) { const u64 b0 = __ballot(v0 == mx), b1 = __ballot(v1 == mx);
                idx = b0 ? __builtin_ctzll(b0) : 64 + __builtin_ctzll(b1);
                if (idx < 64) { if (lane == idx) v0 = -__builtin_inff(); } else { if (lane == idx - 64) v1 = -__builtin_inff(); }
                if (idx < 32) m0 |= 1u << idx; else if (idx < 64) m1 |= 1u << (idx - 32); else if (idx < 96) m2 |= 1u << (idx - 64); else m3 |= 1u << (idx - 96); }
            if (lane == 0) sel[r] = idx; }
        if (lane == 0) { unsigned* mk = (unsigned*)(F.ws + WS_NSAMASK) + (size_t)t * 4; mk[0] = m0; mk[1] = m1; mk[2] = m2; mk[3] = m3; }
        LDS_WAIT(); asm volatile("" ::: "memory");
    }
}
__device__ __forceinline__ unsigned f2key(float f) { const unsigned u = __builtin_bit_cast(unsigned, f); return (u & 0x80000000u) ? ~u : (u | 0x80000000u); }
__device__ __forceinline__ int wave_sum_i(int v) {
#pragma unroll
    for (int o = 1; o < 64; o <<= 1) v += __shfl_xor(v, o);
    return v;
}
__device__ __forceinline__ void dsa_topk_phase(Frame& F) { int lane = F.lane; asm volatile("" : "+v"(lane));
    WAVE_ITEMS(t, S) {
        asm volatile("" : "+v"(lane));
        const float* sc = (const float*)(F.ws + WS_SCORES) + (size_t)t * S + lane;
        int* list = (int*)(F.ws + WS_DSALIST) + (size_t)t * 256; u64* bm = (u64*)(F.ws + WS_DSAMASK) + (size_t)t * 128;
        unsigned u[128];
#pragma unroll
        for (int c = 0; c < 128; ++c) { u[c] = 0u; if (c * 64 <= t) { const bool ok = lane <= t - c * 64; const float v = ok ? sc[c * 64] : 0.f; u[c] = ok ? f2key(v) : 0u; } }
        unsigned T = 0u; int need_eq = 0;
        if (t >= 256) {
            for (int b = 31; b >= 0; --b) { const unsigned cand = T | (1u << b); int cnt = 0;
#pragma unroll
                for (int c = 0; c < 128; ++c) cnt += (u[c] >= cand) ? 1 : 0;
                cnt = wave_sum_i(cnt);
                if (cnt >= 256) T = cand; }
            int gt = 0;
#pragma unroll
            for (int c = 0; c < 128; ++c) gt += (u[c] > T) ? 1 : 0;
            need_eq = 256 - wave_sum_i(gt);
        } else T = 1u;
        int base = 0;
#pragma unroll
        for (int c = 0; c < 128; ++c) {
            bool selv = u[c] > T;
            if (need_eq > 0) { const u64 eq = __ballot(u[c] == T);
                if (eq) { const int rank = __builtin_popcountll(eq & ((1ull << lane) - 1ull)); selv = selv || (u[c] == T && rank < need_eq); need_eq -= min(need_eq, (int)__builtin_popcountll(eq)); } }
            const u64 sm = __ballot(selv);
            if (lane == 0) bm[c] = sm;
            if (selv) list[base + __builtin_popcountll(sm & ((1ull << lane) - 1ull))] = c * 64 + lane;
            base += __builtin_popcountll(sm);
            __builtin_amdgcn_sched_barrier(0);
        }
        for (int i = base + lane; i < 256; i += 64) list[i] = -1;
    }
}
__device__ __forceinline__ void moba_attn_phase(Frame& F) { int lane = F.lane; asm volatile("" : "+v"(lane));
    LAS float* qs = (LAS float*)(F.lds + F.wave * 16384);
    WAVE_ITEMS(it, S * 4) { const int t = it >> 2, h = it & 3, cur = t >> 8;
        const h16* K = (const h16*)(F.ws + WS_AK + (size_t)h * HEADBUF); const h16* V = (const h16*)(F.ws + WS_AV + (size_t)h * HEADBUF);
        load_q(qs, (const h16*)(F.ws + WS_AQ + (size_t)h * HEADBUF) + (size_t)t * 128, 128, lane);
        const int* sel = (const int*)(F.ws + WS_MOBASEL) + (size_t)t * 16 + h * 4;
        AttnAcc a; attn_init(a);
        for (int bi = 0; bi < 4; ++bi) { const int blk = bi == 0 ? cur : sel[bi - 1]; if (blk < 0) continue;
            for (int c = 0; c < 4; ++c) { const int s = blk * 256 + c * 64 + lane; const int key = (s <= t) ? s : -1;
                if (blk * 256 + c * 64 > t) break;
                const float lg = dot_h(qs, K + (size_t)(key < 0 ? 0 : key) * 128, 16) * SC128;
                attn_chunk(a, key, lg, V, 128, lane); } }
        store_o((h16*)(F.ws + WS_OMIX) + (size_t)t * DM + h * 128, a, lane);
        LDS_WAIT(); asm volatile("" ::: "memory"); }
}
__device__ __forceinline__ void mla_attn_phase(Frame& F) { int lane = F.lane; asm volatile("" : "+v"(lane));
    LAS float* qs = (LAS float*)(F.lds + F.wave * 16384);
    WAVE_ITEMS(it, S * 4) { const int t = it >> 2, h = it & 3;
        const h16* K = (const h16*)(F.ws + WS_KN + (size_t)h * HEADBUF); const h16* KR = (const h16*)(F.ws + WS_BKR); const h16* V = (const h16*)(F.ws + WS_BV + (size_t)h * HEADBUF);
        load_q(qs, (const h16*)(F.ws + WS_Q192) + ((size_t)h * S + t) * 192, 192, lane);
        AttnAcc a; attn_init(a);
        for (int c = 0; c * 64 <= t; ++c) { const int s = c * 64 + lane; const int key = (s <= t) ? s : -1; const int ks = key < 0 ? 0 : key;
            const float lg = (dot_h(qs, K + (size_t)ks * 128, 16) + dot_h(qs + 128, KR + (size_t)ks * 64, 8)) * SC192;
            attn_chunk(a, key, lg, V, 128, lane); }
        store_o((h16*)(F.ws + WS_OMIX) + (size_t)t * DM + 512 + h * 128, a, lane);
        LDS_WAIT(); asm volatile("" ::: "memory"); }
}
__device__ __forceinline__ void nsa_attn_phase(Frame& F) { int lane = F.lane; asm volatile("" : "+v"(lane));
    LAS float* qs = (LAS float*)(F.lds + F.wave * 16384);
    WAVE_ITEMS(it, S * 4) { const int t = it >> 2, h = it & 3, cur = t >> 6;
        load_q(qs, (const h16*)(F.ws + WS_CQROPE + (size_t)h * HEADBUF) + (size_t)t * 128, 128, lane);
        const h16* KS = (const h16*)(F.ws + WS_KSLC); const h16* VS = (const h16*)(F.ws + WS_VSLC); const h16* KW = (const h16*)(F.ws + WS_KWIN); const h16* VW = (const h16*)(F.ws + WS_VWIN);
        const int* sel = (const int*)(F.ws + WS_NSASEL) + (size_t)t * 16;
        AttnAcc a; attn_init(a);
        for (int r = 0; r < 16; ++r) { const int blk = sel[r]; if (blk < 0 || blk > cur) continue;
            const int s = blk * 64 + lane; const int key = (s <= t) ? s : -1;
            const float lg = dot_h(qs, KS + (size_t)(key < 0 ? 0 : key) * 128, 16) * SC128;
            attn_chunk(a, key, lg, VS, 128, lane); }
        AttnAcc w; attn_init(w);
        const int lo = t >= 511 ? t - 511 : 0;
        for (int c = lo >> 6; c * 64 <= t; ++c) { const int s = c * 64 + lane; const int key = (s <= t && s >= lo) ? s : -1;
            const float lg = dot_h(qs, KW + (size_t)(key < 0 ? 0 : key) * 128, 16) * SC128;
            attn_chunk(w, key, lg, VW, 128, lane); }
        const float* gl = (const float*)(F.ws + WS_SMALL) + (size_t)t * 32 + h * 3;
        const float g0 = 1.0f / (1.0f + __expf(-gl[0])), g1 = 1.0f / (1.0f + __expf(-gl[1])), g2 = 1.0f / (1.0f + __expf(-gl[2]));
        const float* oc = (const float*)(F.ws + WS_OCMP) + ((size_t)t * 4 + h) * 128 + 2 * lane;
        const float ia = a.l > 0.f ? 1.0f / a.l : 0.f, iw = w.l > 0.f ? 1.0f / w.l : 0.f;
        half2v o; o[0] = (h16)(g0 * oc[0] + g1 * a.o0 * ia + g2 * w.o0 * iw); o[1] = (h16)(g0 * oc[1] + g1 * a.o1 * ia + g2 * w.o1 * iw);
        *(half2v*)((h16*)(F.ws + WS_OMIX) + (size_t)t * DM + 1024 + h * 128 + 2 * lane) = o;
        LDS_WAIT(); asm volatile("" ::: "memory"); }
}
__device__ __forceinline__ void dsa_attn_phase(Frame& F) { int lane = F.lane; asm volatile("" : "+v"(lane));
    LAS float* qs = (LAS float*)(F.lds + F.wave * 16384);
    WAVE_ITEMS(it, S * 4) { const int t = it >> 2, h = it & 3;
        const h16* K = (const h16*)(F.ws + WS_DK + (size_t)h * HEADBUF); const h16* V = (const h16*)(F.ws + WS_DV + (size_t)h * HEADBUF);
        load_q(qs, (const h16*)(F.ws + WS_DQ + (size_t)h * HEADBUF) + (size_t)t * 128, 128, lane);
        const int* list = (const int*)(F.ws + WS_DSALIST) + (size_t)t * 256;
        AttnAcc a; attn_init(a);
        for (int c = 0; c < 4; ++c) { int key = list[c * 64 + lane]; if (key > t) key = -1;
            const float lg = dot_h(qs, K + (size_t)(key < 0 ? 0 : key) * 128, 16) * SC128;
            attn_chunk(a, key, lg, V, 128, lane); }
        store_o((h16*)(F.ws + WS_OMIX) + (size_t)t * DM + 1536 + h * 128, a, lane);
        LDS_WAIT(); asm volatile("" ::: "memory"); }
}
__device__ __forceinline__ void mem_attn_phase(Frame& F, int l) { int lane = F.lane; asm volatile("" : "+v"(lane));
    LAS float* qs = (LAS float*)(F.lds + F.wave * 16384);
    WAVE_ITEMS(it, S * 4) { const int t = it >> 2, h = it & 3;
        const h16* K = (const h16*)(F.ws + WS_MK) + (size_t)((l * 4 + h) * MEMLEN) * 128; const h16* V = (const h16*)(F.ws + WS_MV) + (size_t)((l * 4 + h) * MEMLEN) * 128;
        load_q(qs, (const h16*)(F.ws + WS_MQ + (size_t)h * HEADBUF) + (size_t)t * 128, 128, lane);
        AttnAcc a; attn_init(a);
        for (int c = 0; c < 4; ++c) { const int key = c * 64 + lane;
            const float lg = dot_h(qs, K + (size_t)key * 128, 16) * SC128;
            attn_chunk(a, key, lg, V, 128, lane); }
        store_o((h16*)(F.ws + WS_MO) + (size_t)t * 512 + h * 128, a, lane);
        LDS_WAIT(); asm volatile("" ::: "memory"); }
}
namespace fa {
typedef short s16x4 __attribute__((ext_vector_type(4)));
typedef float f32x16 __attribute__((ext_vector_type(16)));
constexpr int SHM_K = 16384, SHM_V = 16384, SHM_KR = 8192;
constexpr int OFF_V = 0, OFF_K = 2 * SHM_V, OFF_KR = OFF_K + 2 * SHM_K, OFF_WS = OFF_KR + 2 * SHM_KR, OFF_TICKET = OFF_WS + NWAVES * 96 * 4;
enum { K_MLA = 0, K_MOBA, K_SLC, K_WIN, K_DSA, K_MEM, K_CMP };
#define FA_KSWZ(row, colB) ((row) * 256 + ((colB) ^ (((row) & 7) << 4)))
#define FA_KRSWZ(row, colB) ((row) * 128 + ((colB) ^ (((row) & 7) << 4)))
#define FA_SBAR() __builtin_amdgcn_sched_barrier(0)
__device__ __forceinline__ int v_st(int k, int c) { const int kk = (k & ~0xC) | ((k & 4) << 1) | ((k & 8) >> 1); return ((kk >> 3) * 4 + (c >> 5)) * 512 + ((kk & 7) * 32 + (c & 31)) * 2; }
__device__ __forceinline__ int v_rd_base(int lane) { return ((lane & 3) << 3) | (((lane >> 2) & 3) << 6) | (((lane >> 4) & 1) << 5) | (((lane >> 5) & 1) << 8); }
constexpr int v_rd_off(int d0, int ks, int half) { return d0 * 512 + ks * 4096 + half * 2048; }
__device__ __forceinline__ int crow(int r, int hi) { return (r & 3) + 8 * (r >> 2) + 4 * hi; }
__device__ __forceinline__ unsigned cvtpk(float lo, float hi) { half2v h; h[0] = (h16)lo; h[1] = (h16)hi; return __builtin_bit_cast(unsigned, h); }

__device__ __forceinline__ void mask_tile(f32x16& p0, f32x16& p1, int dq, unsigned W) {
    const float NEG = -__builtin_inff();
#pragma unroll
    for (int r = 0; r < 16; ++r) { const int c = (r & 3) + 8 * (r >> 2);
        if ((unsigned)(dq - c) >= W) p0[r] = NEG;
        if ((unsigned)(dq - c - 32) >= W) p1[r] = NEG; }
}
__device__ __forceinline__ void mask_all(f32x16& p0, f32x16& p1, bool keep) {
    const float NEG = -__builtin_inff();
#pragma unroll
    for (int r = 0; r < 16; ++r) { p0[r] = keep ? p0[r] : NEG; p1[r] = keep ? p1[r] : NEG; }
}
__device__ __forceinline__ void mask_bits(f32x16& p0, f32x16& p1, unsigned lo, unsigned hi_w, int hi) {
    const unsigned a = lo >> (4 * hi), b = hi_w >> (4 * hi); const unsigned NEGB = 0xFF800000u;
#pragma unroll
    for (int r = 0; r < 16; ++r) { const int c = (r & 3) + 8 * (r >> 2);
        const unsigned ma = (unsigned)__builtin_amdgcn_sbfe((int)a, c, 1), mb = (unsigned)__builtin_amdgcn_sbfe((int)b, c, 1);
        const float x0 = p0[r], x1 = p1[r];
        p0[r] = __uint_as_float((__float_as_uint(x0) & ma) | (NEGB & ~ma));
        p1[r] = __uint_as_float((__float_as_uint(x1) & mb) | (NEGB & ~mb)); }
}
__device__ __forceinline__ void partialSM(f32x16& p0, f32x16& p1, float& m_reg, float& mn, float& alpha, const float sc, const float C2) {
    float pmax = p0[0];
#pragma unroll
    for (int r = 1; r < 16; ++r) pmax = fmaxf(pmax, p0[r]);
#pragma unroll
    for (int r = 0; r < 16; ++r) pmax = fmaxf(pmax, p1[r]);
    { auto rr = __builtin_amdgcn_permlane32_swap(__float_as_uint(pmax), __float_as_uint(pmax), false, false);
      pmax = fmaxf(__uint_as_float(rr[0]), __uint_as_float(rr[1])); }
    if (__builtin_expect(__all((pmax - m_reg) * sc <= 8.0f), 1)) { mn = m_reg; alpha = 1.f; }
    else { mn = fmaxf(m_reg, pmax); alpha = __builtin_amdgcn_exp2f((m_reg - mn) * C2); m_reg = mn; }
    const float mnL = -mn * C2;
#pragma unroll
    for (int r = 0; r < 16; ++r) p0[r] = __builtin_amdgcn_exp2f(fmaf(p0[r], C2, mnL));
#pragma unroll
    for (int r = 0; r < 16; ++r) p1[r] = __builtin_amdgcn_exp2f(fmaf(p1[r], C2, mnL));
}
__device__ __forceinline__ void finishSM(const f32x16& p0, const f32x16& p1, float alpha, float& l_reg, half8& pa0, half8& pa1, half8& pa2, half8& pa3) {
    float ps = 0;
#pragma unroll
    for (int r = 0; r < 16; ++r) ps += p0[r];
#pragma unroll
    for (int r = 0; r < 16; ++r) ps += p1[r];
    { auto rr = __builtin_amdgcn_permlane32_swap(__float_as_uint(ps), __float_as_uint(ps), false, false);
      ps = __uint_as_float(rr[0]) + __uint_as_float(rr[1]); }
    l_reg = l_reg * alpha + ps;
#define FA_PK4(P, B_, OUT) do { unsigned a0 = cvtpk(P[B_ + 0], P[B_ + 1]), a1 = cvtpk(P[B_ + 2], P[B_ + 3]); unsigned b0 = cvtpk(P[B_ + 4], P[B_ + 5]), b1 = cvtpk(P[B_ + 6], P[B_ + 7]); \
        auto r0 = __builtin_amdgcn_permlane32_swap(a0, b0, false, false); auto r1 = __builtin_amdgcn_permlane32_swap(a1, b1, false, false); \
        u32x4 w = {r0[0], r1[0], r0[1], r1[1]}; OUT = __builtin_bit_cast(half8, w); } while (0)
    FA_PK4(p0, 0, pa0); FA_PK4(p0, 8, pa1); FA_PK4(p1, 0, pa2); FA_PK4(p1, 8, pa3);
#undef FA_PK4
}
template <bool MLA>
__device__ __forceinline__ void qkt(f32x16& p0, f32x16& p1, const LAS char* lds, int kboff, int kroff, int r32, int hi, const half8* qr, bool act) {
    if (!act) { const float NEG = -__builtin_inff();
#pragma unroll
        for (int r = 0; r < 16; ++r) { p0[r] = NEG; p1[r] = NEG; } return; }
#pragma unroll
    for (int r = 0; r < 16; ++r) { p0[r] = 0.f; p1[r] = 0.f; }
    const LAS char* kb[4];
#pragma unroll
    for (int dd = 0; dd < 4; ++dd) kb[dd] = lds + OFF_K + kboff + FA_KSWZ(r32, (dd * 16 + hi * 8) * 2);
#pragma unroll
    for (int d0 = 0; d0 < 8; ++d0) { const LAS char* a = kb[d0 & 3] + (d0 >> 2) * 128;
        const half8 b0 = *(const LAS half8*)a; const half8 b1 = *(const LAS half8*)(a + 32 * 256);
        p0 = __builtin_amdgcn_mfma_f32_32x32x16_f16(b0, qr[d0], p0, 0, 0, 0);
        p1 = __builtin_amdgcn_mfma_f32_32x32x16_f16(b1, qr[d0], p1, 0, 0, 0); }
    if constexpr (MLA) {
#pragma unroll
        for (int d0 = 0; d0 < 4; ++d0) { const LAS char* a = lds + OFF_KR + kroff + FA_KRSWZ(r32, (d0 * 16 + hi * 8) * 2);
            const half8 b0 = *(const LAS half8*)a; const half8 b1 = *(const LAS half8*)(a + 32 * 128);
            p0 = __builtin_amdgcn_mfma_f32_32x32x16_f16(b0, qr[8 + d0], p0, 0, 0, 0);
            p1 = __builtin_amdgcn_mfma_f32_32x32x16_f16(b1, qr[8 + d0], p1, 0, 0, 0); }
    }
}
__device__ __forceinline__ void pv_tile(f32x16* o, int vb0, half8 pa0, half8 pa1, half8 pa2, half8 pa3, bool act) {
    if (!act) return;
#define FA_TRRD(dst, off) asm volatile("ds_read_b64_tr_b16 %0, %1 offset:%2" : "=&v"(dst) : "v"(vb0), "i"(off) : "memory")
#define FA_H8(l, h) __builtin_bit_cast(half8, (short __attribute__((ext_vector_type(8)))){l[0], l[1], l[2], l[3], h[0], h[1], h[2], h[3]})
#define FA_PV_D0(d0) do { s16x4 l0, l1, l2, l3, h0, h1, h2, h3; constexpr int b_ = v_rd_off(d0, 0, 0); \
        FA_TRRD(l0, b_); FA_TRRD(h0, b_ + 2048); FA_TRRD(l1, b_ + 4096); FA_TRRD(h1, b_ + 6144); FA_TRRD(l2, b_ + 8192); FA_TRRD(h2, b_ + 10240); FA_TRRD(l3, b_ + 12288); FA_TRRD(h3, b_ + 14336); \
        asm volatile("s_waitcnt lgkmcnt(0)" ::: "memory"); FA_SBAR(); \
        o[d0] = __builtin_amdgcn_mfma_f32_32x32x16_f16(pa0, FA_H8(l0, h0), o[d0], 0, 0, 0); \
        o[d0] = __builtin_amdgcn_mfma_f32_32x32x16_f16(pa1, FA_H8(l1, h1), o[d0], 0, 0, 0); \
        o[d0] = __builtin_amdgcn_mfma_f32_32x32x16_f16(pa2, FA_H8(l2, h2), o[d0], 0, 0, 0); \
        o[d0] = __builtin_amdgcn_mfma_f32_32x32x16_f16(pa3, FA_H8(l3, h3), o[d0], 0, 0, 0); } while (0)
    FA_PV_D0(0); FA_PV_D0(1); FA_PV_D0(2); FA_PV_D0(3);
#undef FA_PV_D0
#undef FA_H8
#undef FA_TRRD
}
struct UnitArgs {
    const h16* Q; int qld;
    const h16* K; const h16* KR; const h16* V;
    h16* O; int old;
    int P0, j_lo, j_hi;
    const void* mk;
    const float* gate; int gidx;
    const float* ocmp;
    int epi;
};
template <int KIND>
__device__ __forceinline__ void run_unit(LAS char* lds, const UnitArgs& U, int tid_in) {
    constexpr bool MLA = KIND == K_MLA;
    int tid = tid_in; asm volatile("" : "+v"(tid));
    const int wid = __builtin_amdgcn_readfirstlane(tid >> 6), lane = tid & 63, r32 = lane & 31, hi = lane >> 5;
    const int sr = tid >> 4, sc = (tid & 15) * 8;
    const int qlo = U.P0 + wid * 32, rowpos = qlo + r32;
    const float sc_ = MLA ? SC192 : SC128; const float C2 = 1.4426950408889634f * sc_;
    LAS float* wsf = (LAS float*)(lds + OFF_WS) + wid * 96; LAS float* li_l = wsf; LAS float* al_l = wsf + 32; LAS float* g_l = wsf + 64;
    half8 qr[MLA ? 12 : 8];
    { const h16* qp = U.Q + (size_t)(wid * 32 + r32) * U.qld + hi * 8;
#pragma unroll
      for (int d0 = 0; d0 < (MLA ? 12 : 8); ++d0) qr[d0] = *(const half8*)(qp + d0 * 16); }
    unsigned mb0 = 0, mb1 = 0, mb2 = 0, mb3 = 0;
    if constexpr (KIND == K_MOBA) { const int* s = (const int*)U.mk + (size_t)rowpos * 16;
#pragma unroll
        for (int i = 0; i < 3; ++i) { const int b = s[i]; if (b >= 0) mb0 |= 1u << b; } }
    if constexpr (KIND == K_SLC) { const u32x4 m = *(const u32x4*)((const unsigned*)U.mk + (size_t)rowpos * 4); mb0 = m[0]; mb1 = m[1]; mb2 = m[2]; mb3 = m[3]; }
    const int nvis_row = rowpos >= 31 ? ((rowpos - 31) >> 4) + 1 : 0;
    const int NT = U.j_hi - U.j_lo;
    half8 st_k0, st_k1, st_v0, st_v1, st_kr; unsigned dm_lo = 0, dm_hi = 0, dn_lo = 0, dn_hi = 0;
    const int kws = FA_KSWZ(sr, sc * 2), vst0 = v_st(sr, sc), vst1 = v_st(32 + sr, sc), krw = FA_KRSWZ(tid >> 3, (tid & 7) * 16);
    const int vb0 = (int)(unsigned)(size_t)(lds + OFF_V) + v_rd_base(lane);
#define FA_LOADT(j) do { const int k0_ = (j) * 64; st_k0 = *(const half8*)(U.K + (size_t)(k0_ + sr) * 128 + sc); st_k1 = *(const half8*)(U.K + (size_t)(k0_ + 32 + sr) * 128 + sc); \
        st_v0 = *(const half8*)(U.V + (size_t)(k0_ + sr) * 128 + sc); st_v1 = *(const half8*)(U.V + (size_t)(k0_ + 32 + sr) * 128 + sc); \
        if constexpr (MLA) st_kr = *(const half8*)(U.KR + (size_t)(k0_ + (tid >> 3)) * 64 + (tid & 7) * 8); \
        if constexpr (KIND == K_DSA) { const unsigned long long w_ = ((const unsigned long long*)U.mk)[(size_t)rowpos * 128 + (j)]; dn_lo = (unsigned)w_; dn_hi = (unsigned)(w_ >> 32); } } while (0)
#define FA_WRITET(bf) do { *(LAS half8*)(lds + OFF_K + (bf) * SHM_K + kws) = st_k0; *(LAS half8*)(lds + OFF_K + (bf) * SHM_K + kws + 32 * 256) = st_k1; \
        *(LAS half8*)(lds + OFF_V + (bf) * SHM_V + vst0) = st_v0; *(LAS half8*)(lds + OFF_V + (bf) * SHM_V + vst1) = st_v1; \
        if constexpr (MLA) *(LAS half8*)(lds + OFF_KR + (bf) * SHM_KR + krw) = st_kr; } while (0)
    float m_reg = -1e30f, l_reg = 0.f; f32x16 o[4];
#pragma unroll
    for (int d = 0; d < 4; ++d)
#pragma unroll
        for (int r = 0; r < 16; ++r) o[d][r] = 0.f;
    FA_LOADT(U.j_lo); asm volatile("s_waitcnt vmcnt(0)" ::: "memory"); FA_WRITET(0); dm_lo = dn_lo; dm_hi = dn_hi;
    __syncthreads();
    f32x16 pA0, pA1; float mnA, alA; half8 pa0, pa1, pa2, pa3;
#define FA_STEP(t) do { const int kb_ = (U.j_lo + (t)) * 64; int bsel_ = (t) & 1; asm volatile("" : "+v"(bsel_)); \
        bool act_ = kb_ <= qlo + 31; if constexpr (KIND == K_WIN) act_ = act_ && (kb_ + 63 >= qlo - 511); if constexpr (KIND == K_MEM) act_ = true; if constexpr (KIND == K_CMP) act_ = kb_ < (qlo >> 4) + 1; \
        qkt<MLA>(pA0, pA1, lds, bsel_ * SHM_K, bsel_ * SHM_KR, r32, hi, qr, act_); \
        if (act_) { \
            if constexpr (KIND == K_MLA) { if (kb_ + 63 > qlo) mask_tile(pA0, pA1, rowpos - kb_ - 4 * hi, 0x40000000u); } \
            if constexpr (KIND == K_WIN) { if (kb_ + 63 > qlo || kb_ <= qlo + 31 - 512) mask_tile(pA0, pA1, rowpos - kb_ - 4 * hi, 512u); } \
            if constexpr (KIND == K_MOBA) { const int blk_ = kb_ >> 8; if (blk_ == (U.P0 >> 8)) { if (kb_ + 63 > qlo) mask_tile(pA0, pA1, rowpos - kb_ - 4 * hi, 0x40000000u); } else mask_all(pA0, pA1, (mb0 >> blk_) & 1u); } \
            if constexpr (KIND == K_SLC) { const int b_ = kb_ >> 6; const unsigned w_ = (b_ < 32) ? mb0 : (b_ < 64) ? mb1 : (b_ < 96) ? mb2 : mb3; mask_all(pA0, pA1, (w_ >> (b_ & 31)) & 1u); \
                if (kb_ + 63 > qlo) mask_tile(pA0, pA1, rowpos - kb_ - 4 * hi, 0x40000000u); } \
            if constexpr (KIND == K_DSA) mask_bits(pA0, pA1, dm_lo, dm_hi, hi); \
            if constexpr (KIND == K_CMP) mask_tile(pA0, pA1, nvis_row - 1 - kb_ - 4 * hi, 0x40000000u); \
            partialSM(pA0, pA1, m_reg, mnA, alA, sc_, C2); \
            if (__any(alA < 1.f)) { if (hi == 0) al_l[r32] = alA; asm volatile("s_waitcnt lgkmcnt(0)" ::: "memory"); \
                _Pragma("unroll") for (int d_ = 0; d_ < 4; ++d_) _Pragma("unroll") for (int r = 0; r < 16; ++r) o[d_][r] *= al_l[crow(r, hi)]; } \
            finishSM(pA0, pA1, alA, l_reg, pa0, pa1, pa2, pa3); FA_SBAR(); \
            pv_tile(o, vb0 + bsel_ * SHM_V, pa0, pa1, pa2, pa3, true); } } while (0)
    for (int t = 0; t < NT; ++t) {
        if (t + 1 < NT) FA_LOADT(U.j_lo + t + 1);
        FA_SBAR();
        FA_STEP(t);
        FA_SBAR();
        if (t + 1 < NT) { asm volatile("s_waitcnt vmcnt(0)" ::: "memory"); FA_WRITET((t + 1) & 1); dm_lo = dn_lo; dm_hi = dn_hi; }
        __syncthreads();
    }
    float rs = l_reg > 0.f ? 1.0f / l_reg : 0.f;
    if (U.epi != 0) { const float gl = U.gate[(size_t)rowpos * 32 + U.gidx]; rs *= 1.0f / (1.0f + __expf(-gl));
        if (U.epi == 1) { const float g0 = U.gate[(size_t)rowpos * 32 + U.gidx - 1]; if (hi == 0) g_l[r32] = 1.0f / (1.0f + __expf(-g0)); } }
    if (hi == 0) li_l[r32] = rs;
    asm volatile("s_waitcnt lgkmcnt(0)" ::: "memory");
#pragma unroll
    for (int r = 0; r < 16; ++r) { const int orow = wid * 32 + crow(r, hi); const float rli = li_l[crow(r, hi)]; const float g0 = (U.epi == 1) ? g_l[crow(r, hi)] : 0.f;
#pragma unroll
        for (int d0 = 0; d0 < 4; ++d0) { float v = o[d0][r] * rli;
            if (U.epi == 1) v += g0 * U.ocmp[(size_t)(U.P0 + orow) * 512 + d0 * 32 + r32];
            const float vn = __shfl_xor(v, 1);
            if ((r32 & 1) == 0) { unsigned* op = (unsigned*)(U.O + (size_t)orow * U.old + d0 * 32 + r32);
                if (U.epi == 2) { const half2v pv = __builtin_bit_cast(half2v, *op); *op = cvtpk(v + (float)pv[0], vn + (float)pv[1]); }
                else *op = cvtpk(v, vn); } } }
    __syncthreads();
#undef FA_LOADT
#undef FA_WRITET
#undef FA_STEP
}
}

namespace dsx {
constexpr int IK_STAGE = 256;
__device__ __forceinline__ void score_phase(Frame& F) {
    int lane = F.lane; asm volatile("" : "+v"(lane));
    LAS char* lds = (LAS char*)F.lds; unsigned char* ws = F.ws;
    const int wid = F.wave, r32 = lane & 31, hi = lane >> 5;
    const int tid = wid * 64 + lane;
    for (int n = blockIdx.x; n < 1152; n += F.G) {
        int g = 0;
#pragma unroll
        for (int k = 1; k < 8; ++k) if (n >= 16 * k * (k + 1)) g = k;
        const int r = n - 16 * g * (g + 1), qt = 32 * g + r / (g + 1), kc = r % (g + 1);
        const int t0 = 32 * qt + 4 * wid;
        const int kend = min(kc * 1024 + 1024, 32 * qt + 32);
        half8 a[2][4]; float wv[2][16];
#pragma unroll
        for (int tl = 0; tl < 2; ++tl) { const int t = t0 + 2 * tl + (r32 >> 4); const h16* iq = (const h16*)(ws + WS_IQ) + (size_t)t * 1024 + (r32 & 15) * 64 + hi * 8;
#pragma unroll
            for (int d0 = 0; d0 < 4; ++d0) a[tl][d0] = *(const half8*)(iq + d0 * 16);
#pragma unroll
            for (int rr = 0; rr < 16; ++rr) { const int head = (rr & 3) + 8 * ((rr >> 2) & 1) + 4 * hi; wv[tl][rr] = ((const float*)(ws + WS_SMALL))[(size_t)(t0 + 2 * tl + (rr >> 3)) * 32 + 12 + head] * (0.25f * 0.125f); } }
        for (int ks = kc * 1024; ks < kend; ks += IK_STAGE) {
            const int nk = min(IK_STAGE, kend - ks);
            __syncthreads();
#pragma unroll
            for (int i = 0; i < 4; ++i) { const int idx = tid + 512 * i, row = idx >> 3, ch = idx & 7;
                if (row < nk) { const half8 v = *(const half8*)((const h16*)(ws + WS_IK) + (size_t)(ks + row) * 64 + ch * 8); *(LAS half8*)(lds + row * 128 + ((ch * 16) ^ ((row & 7) << 4))) = v; } }
            __syncthreads();
            for (int sub = 0; sub < nk; sub += 32) {
                const int row = sub + r32; half8 b[4];
#pragma unroll
                for (int d0 = 0; d0 < 4; ++d0) b[d0] = *(const LAS half8*)(lds + row * 128 + (((d0 * 2 + hi) * 16) ^ ((row & 7) << 4)));
#pragma unroll
                for (int tl = 0; tl < 2; ++tl) {
                    fa::f32x16 c;
#pragma unroll
                    for (int rr = 0; rr < 16; ++rr) c[rr] = 0.f;
#pragma unroll
                    for (int d0 = 0; d0 < 4; ++d0) c = __builtin_amdgcn_mfma_f32_32x32x16_f16(a[tl][d0], b[d0], c, 0, 0, 0);
                    float s0 = 0.f, s1 = 0.f;
#pragma unroll
                    for (int rr = 0; rr < 8; ++rr) { s0 += wv[tl][rr] * fmaxf(c[rr], 0.f); s1 += wv[tl][8 + rr] * fmaxf(c[8 + rr], 0.f); }
                    auto sw = __builtin_amdgcn_permlane32_swap(__float_as_uint(s0), __float_as_uint(s1), false, false);
                    const float tot = __uint_as_float(sw[0]) + __uint_as_float(sw[1]);
                    ((float*)(ws + WS_SCORES))[(size_t)(t0 + 2 * tl + hi) * S + ks + sub + r32] = tot;
                }
            }
        }
    }
    __syncthreads();
}
}

namespace nsx {
__device__ __forceinline__ void mask16(fa::f32x16& p, int dq) {
    const float NEG = -__builtin_inff();
#pragma unroll
    for (int r = 0; r < 16; ++r) { const int c = (r & 3) + 8 * (r >> 2); if (dq - c < 0) p[r] = NEG; }
}
__device__ __forceinline__ void imp_select_unit(unsigned char* ws, LAS float* impL  , int unit, int lane_in) {
    int lane = lane_in; asm volatile("" : "+v"(lane));
    const int r32 = lane & 31, hi = lane >> 5, t0 = unit * 32, row = t0 + r32;
    const int nvis = row >= 31 ? ((row - 31) >> 4) + 1 : 0;
    const int nvmax = (t0 >> 4) + 1;
    const int NHT = (nvmax + 31) >> 5;
    const float C2 = 1.4426950408889634f * SC128;
    const h16* kc = (const h16*)(ws + WS_KC16);
    float m[4], l[4];
#pragma unroll
    for (int h = 0; h < 4; ++h) { m[h] = -1e30f; l[h] = 0.f; }
    fa::f32x16 p; half8 kf[8], qf[8];
#define NSX_LOADK(ht) do { const h16* kp_ = kc + (size_t)((ht) * 32 + r32) * 128 + hi * 8; _Pragma("unroll") for (int d0 = 0; d0 < 8; ++d0) kf[d0] = *(const half8*)(kp_ + d0 * 16); } while (0)
#define NSX_QK(h) do { const h16* qp_ = (const h16*)(ws + WS_CQRAW + (size_t)(h) * HEADBUF) + (size_t)row * 128 + hi * 8; _Pragma("unroll") for (int d0 = 0; d0 < 8; ++d0) qf[d0] = *(const half8*)(qp_ + d0 * 16); \
        _Pragma("unroll") for (int r = 0; r < 16; ++r) p[r] = 0.f; \
        _Pragma("unroll") for (int d0 = 0; d0 < 8; ++d0) p = __builtin_amdgcn_mfma_f32_32x32x16_f16(kf[d0], qf[d0], p, 0, 0, 0); } while (0)
    for (int ht = 0; ht < NHT; ++ht) {
        NSX_LOADK(ht);
#pragma unroll
        for (int h = 0; h < 4; ++h) {
            NSX_QK(h);
            mask16(p, nvis - 1 - ht * 32 - 4 * hi);
            float pmax = p[0];
#pragma unroll
            for (int r = 1; r < 16; ++r) pmax = fmaxf(pmax, p[r]);
            { auto rr = __builtin_amdgcn_permlane32_swap(__float_as_uint(pmax), __float_as_uint(pmax), false, false); pmax = fmaxf(__uint_as_float(rr[0]), __uint_as_float(rr[1])); }
            const float mn = fmaxf(m[h], pmax), al = __builtin_amdgcn_exp2f((m[h] - mn) * C2), mnL = -mn * C2;
            float ps = 0.f;
#pragma unroll
            for (int r = 0; r < 16; ++r) ps += __builtin_amdgcn_exp2f(fmaf(p[r], C2, mnL));
            { auto rr = __builtin_amdgcn_permlane32_swap(__float_as_uint(ps), __float_as_uint(ps), false, false); ps = __uint_as_float(rr[0]) + __uint_as_float(rr[1]); }
            l[h] = l[h] * al + ps; m[h] = mn;
        }
    }
    float mL[4], il[4];
#pragma unroll
    for (int h = 0; h < 4; ++h) { mL[h] = -m[h] * C2; il[h] = l[h] > 0.f ? 1.0f / l[h] : 0.f; }
#pragma unroll
    for (int i = 0; i < 64; ++i) impL[i * 64 + lane] = 0.f;
    float carry = 0.f;
    for (int ht = 0; ht < NHT; ++ht) {
        {
            NSX_LOADK(ht);
            float G[4], L[4];
#pragma unroll
            for (int g = 0; g < 4; ++g) { G[g] = 0.f; L[g] = 0.f; }
#pragma unroll
            for (int h = 0; h < 4; ++h) {
                NSX_QK(h);
                mask16(p, nvis - 1 - ht * 32 - 4 * hi);
#pragma unroll
                for (int g = 0; g < 4; ++g) {
                    const float a0 = __builtin_amdgcn_exp2f(fmaf(p[4 * g], C2, mL[h])), a1 = __builtin_amdgcn_exp2f(fmaf(p[4 * g + 1], C2, mL[h])), a2 = __builtin_amdgcn_exp2f(fmaf(p[4 * g + 2], C2, mL[h])), a3 = __builtin_amdgcn_exp2f(fmaf(p[4 * g + 3], C2, mL[h]));
                    G[g] += ((a0 + a1) + (a2 + a3)) * il[h]; L[g] += a3 * il[h];
                }
            }
#pragma unroll
            for (int g = 0; g < 4; ++g) {
                const float A = g == 0 ? carry : L[g - 1], B = L[g];
                auto rr = __builtin_amdgcn_permlane32_swap(__float_as_uint(A), __float_as_uint(B), false, false);
                const float prev = hi ? __uint_as_float(rr[0]) : __uint_as_float(rr[1]);
                impL[(4 * ht + g) * 64 + lane] = G[g] + prev;
            }
            carry = L[3];
        }
    }
#undef NSX_LOADK
#undef NSX_QK
    LDS_WAIT(); asm volatile("" ::: "memory");
    const int cur = row >> 6;
    unsigned key[64];
#pragma unroll
    for (int i = 0; i < 64; ++i) { const int b = 8 * (i >> 2) + 2 * (i & 3) + hi;
        const unsigned vb = (__float_as_uint(impL[i * 64 + lane]) & 0xFFFFFF80u) | (unsigned)(127 - b);
        const bool forced = (b == 0) || (b == cur) || (b == cur - 1);
        key[i] = b > cur ? 0u : (forced ? (0x7F800000u | (unsigned)(127 - b)) : vb); }
    unsigned prev = 0xFFFFFFFFu, m0 = 0u, m1 = 0u, m2 = 0u, m3 = 0u;
    for (int rnd = 0; rnd < 16; ++rnd) {
        unsigned best = 0u;
#pragma unroll
        for (int i = 0; i < 64; ++i) { const unsigned c = key[i] < prev ? key[i] : 0u; best = best > c ? best : c; }
        { auto rr = __builtin_amdgcn_permlane32_swap(best, best, false, false); best = rr[0] > rr[1] ? rr[0] : rr[1]; }
        if (best != 0u) { const unsigned b = 127u - (best & 127u), bit = 1u << (b & 31u);
            m0 |= (b < 32u) ? bit : 0u; m1 |= (b >= 32u && b < 64u) ? bit : 0u; m2 |= (b >= 64u && b < 96u) ? bit : 0u; m3 |= (b >= 96u) ? bit : 0u; }
        prev = best;
    }
    if (hi == 0) { u32x4 mk = {m0, m1, m2, m3}; *(u32x4*)((unsigned*)(ws + WS_NSAMASK) + (size_t)row * 4) = mk; }
}
}

constexpr int CW_QUEUE = 8192;
__device__ __forceinline__ int fa_ticket(Frame& F, unsigned* head) {
    LAS int* tk = (LAS int*)(F.lds + fa::OFF_TICKET);
    if (F.tid == 0) *tk = (int)__hip_atomic_fetch_add(head, 1u, __ATOMIC_RELAXED, __HIP_MEMORY_SCOPE_AGENT);
    __syncthreads();
    const int u = *tk;
    __syncthreads();
    return u;
}
__device__ __forceinline__ void fa_mixer_phase(Frame& F, int l) {
    LAS char* lds = (LAS char*)F.lds; unsigned char* ws = F.ws;
    for (;;) {
        const int u = fa_ticket(F, F.ctl + CW_QUEUE + 64 * l);
        if (u >= 512) break;
        const int qb = 31 - (u >> 4), type = (u >> 2) & 3, h = u & 3, P0 = qb * 256;
        if (!((FA_MASK >> type) & 1)) continue;
        fa::UnitArgs U; U.P0 = P0; U.j_lo = 0; U.j_hi = (P0 + 255) / 64 + 1; U.KR = nullptr; U.mk = nullptr; U.gate = nullptr; U.gidx = 0; U.ocmp = nullptr; U.epi = 0; U.old = DM;
        if (type == 0) {
            U.Q = (const h16*)(ws + WS_Q192) + ((size_t)h * S + P0) * 192; U.qld = 192; U.K = (const h16*)(ws + WS_KN + (size_t)h * HEADBUF); U.KR = (const h16*)(ws + WS_BKR); U.V = (const h16*)(ws + WS_BV + (size_t)h * HEADBUF);
            U.O = (h16*)(ws + WS_OMIX) + (size_t)P0 * DM + 512 + h * 128;
            fa::run_unit<fa::K_MLA>(lds, U, F.tid);
        } else if (type == 1) {
            U.Q = (const h16*)(ws + WS_CQROPE + (size_t)h * HEADBUF) + (size_t)P0 * 128; U.qld = 128; U.K = (const h16*)(ws + WS_KSLC); U.V = (const h16*)(ws + WS_VSLC);
            U.O = (h16*)(ws + WS_OMIX) + (size_t)P0 * DM + 1024 + h * 128; U.mk = ws + WS_NSAMASK; U.gate = (const float*)(ws + WS_SMALL); U.gidx = h * 3 + 1; U.epi = 2;
            fa::run_unit<fa::K_SLC>(lds, U, F.tid);
            U.K = (const h16*)(ws + WS_KWIN); U.V = (const h16*)(ws + WS_VWIN); U.j_lo = P0 >= 511 ? (P0 - 511) / 64 : 0; U.gidx = h * 3 + 2; U.epi = 2;
            fa::run_unit<fa::K_WIN>(lds, U, F.tid);
        } else if (type == 2) {
            U.Q = (const h16*)(ws + WS_AQ + (size_t)h * HEADBUF) + (size_t)P0 * 128; U.qld = 128; U.K = (const h16*)(ws + WS_AK + (size_t)h * HEADBUF); U.V = (const h16*)(ws + WS_AV + (size_t)h * HEADBUF);
            U.O = (h16*)(ws + WS_OMIX) + (size_t)P0 * DM + h * 128; U.mk = (const int*)(ws + WS_MOBASEL) + h * 4;
            fa::run_unit<fa::K_MOBA>(lds, U, F.tid);
        } else {
            U.Q = (const h16*)(ws + WS_DQ + (size_t)h * HEADBUF) + (size_t)P0 * 128; U.qld = 128; U.K = (const h16*)(ws + WS_DK + (size_t)h * HEADBUF); U.V = (const h16*)(ws + WS_DV + (size_t)h * HEADBUF);
            U.O = (h16*)(ws + WS_OMIX) + (size_t)P0 * DM + 1536 + h * 128; U.mk = ws + WS_DSAMASK;
            fa::run_unit<fa::K_DSA>(lds, U, F.tid);
        }
    }
}
__device__ __forceinline__ void fa_cmp_phase(Frame& F) {
    LAS char* lds = (LAS char*)F.lds; unsigned char* ws = F.ws;
    for (int u = blockIdx.x; u < 128; u += F.G) {
        const int qb = 31 - (u >> 2), h = u & 3, P0 = qb * 256;
        fa::UnitArgs U; U.P0 = P0; U.j_lo = 0; U.j_hi = ((((P0 + 224) >> 4) + 1) + 63) >> 6; U.KR = nullptr; U.mk = nullptr; U.ocmp = nullptr; U.old = DM;
        U.Q = (const h16*)(ws + WS_CQRAW + (size_t)h * HEADBUF) + (size_t)P0 * 128; U.qld = 128; U.K = (const h16*)(ws + WS_KC16); U.V = (const h16*)(ws + WS_VC16);
        U.O = (h16*)(ws + WS_OMIX) + (size_t)P0 * DM + 1024 + h * 128; U.gate = (const float*)(ws + WS_SMALL); U.gidx = h * 3; U.epi = 3;
        fa::run_unit<fa::K_CMP>(lds, U, F.tid);
    }
}
__device__ __forceinline__ void nsa_imp_phase(Frame& F) {
    if (F.wave == 0) for (int u = blockIdx.x; u < 256; u += F.G) nsx::imp_select_unit(F.ws, (LAS float*)F.lds, u, F.lane);
}
__device__ __forceinline__ void fa_mem_phase(Frame& F, int l) {
    LAS char* lds = (LAS char*)F.lds; unsigned char* ws = F.ws;
    for (int u = blockIdx.x; u < 128; u += F.G) {
        const int qb = u >> 2, h = u & 3, P0 = qb * 256;
        fa::UnitArgs U; U.P0 = P0; U.j_lo = 0; U.j_hi = 4; U.KR = nullptr; U.mk = nullptr; U.gate = nullptr; U.gidx = 0; U.ocmp = nullptr; U.epi = 0;
        U.Q = (const h16*)(ws + WS_MQ + (size_t)h * HEADBUF) + (size_t)P0 * 128; U.qld = 128;
        U.K = (const h16*)(ws + WS_MK) + (size_t)((l * 4 + h) * MEMLEN) * 128; U.V = (const h16*)(ws + WS_MV) + (size_t)((l * 4 + h) * MEMLEN) * 128;
        U.O = (h16*)(ws + WS_MO) + (size_t)P0 * 512 + h * 128; U.old = 512;
        fa::run_unit<fa::K_MEM>(lds, U, F.tid);
    }
}

enum { PHB_P0, PHB_KMEAN, PHB_CMP2, PHB_GATE, PHB_SCORE, PHB_CMPSEL, PHB_TOPK, PHB_MOBA, PHB_MLA, PHB_NSA, PHB_DSA, PHB_MEMA, PHB_LN, PHB_GMKV, PHB_GSWIGLU, PHB_GWIN, PHB_GUQ, PHB_GUKV, PHB_GY, PHB_GMQ, PHB_GRESID };
#ifndef SKIPMASK
#define SKIPMASK 0u
#endif
constexpr int SLOTS = 7, NSTEPS = 2 + 16 * SLOTS;
struct Args { const float* in[19]; float* out; unsigned char* ws; int lo, hi; };
__global__ void __launch_bounds__(NTHREADS, 2) mk_fwd(Args args) {
    extern __shared__ __attribute__((aligned(16))) unsigned char lds_raw[];
    Frame F;
    F.lds = (LAS unsigned char*)lds_raw;
    F.MISC = (volatile LAS unsigned*)(F.lds + MISC_OFF);
    F.tid = threadIdx.x; F.lane = F.tid & 63; F.wave = __builtin_amdgcn_readfirstlane(F.tid >> 6);
    F.G = gridDim.x; F.ws = args.ws; F.ctl = (unsigned*)(args.ws + WS_CTL); F.out = args.out;
#pragma unroll
    for (int i = 0; i < 19; ++i) F.in[i] = args.in[i];
    for (int u = F.tid; u < (LDS_BYTES - LDSCTL_OFF) / 4; u += NTHREADS) ((LAS unsigned*)(F.lds + LDSCTL_OFF))[u] = 0u;
    __syncthreads();
    const int lo = args.lo, hi = args.hi;
    XcdBarrier bar; bar.bar = F.ctl + CW_BAR; bar.x = 0; bar.st = nullptr;
    if (hi - lo > 1) bar = xcd_barrier_post(F.ctl + CW_BAR, F.MISC + 8);
#define PH(name, call) do { if (!(SKIPMASK & (1u << PHB_##name))) { call; } } while (0)
#define IN(k) (lo <= (k) && (k) < hi)
#define END(k) do { if (hi > (k) + 1) xcd_barrier(bar); } while (0)
    unsigned char* ws = args.ws;
    const float* xf = (const float*)(ws + WS_XF); float* z = (float*)(ws + WS_Z); const h16* xh = (const h16*)(ws + WS_XH);

    for (int rep_ = 0; rep_ < PROBE_P0; ++rep_) if (IN(0)) { PH(P0, p0_prologue(F)); END(0); }
    if (IN(1)) {
        pg8::Gemm g{(const h16*)(ws + WS_MEMH), (const h16*)(ws + WS_WMKV), MEMLEN, DEPTH * 1024, DM}; pg8::StaticOrder So; So.init(MEMLEN, DEPTH * 1024, F.G, (int)blockIdx.x);
        EpiProj<JOB_MKV> E{ws, 0};
        PH(GMKV, (pg8::gemm_phase<EpiProj<JOB_MKV>, pg8::StaticOrder, true, true>(F.lds, g, So, E)));
        END(1);
    }
    for (int sb = 0; sb < 16; ++sb) {
        const int l = sb >> 2, kind = sb & 3, base = 2 + sb * SLOTS;
        if (hi <= base || lo >= base + SLOTS) continue;
        const h16* resA; const h16* resB; int resK; float resS; int lnidx;
        if (kind == 0 || kind == 3) {
            const int f = kind == 0 ? 0 : 1;
            resA = (const h16*)(ws + WS_HB); resB = (const h16*)(ws + WS_WD) + (size_t)(l * 2 + f) * DM * DFF; resK = DFF; resS = 0.5f; lnidx = kind;
            if (IN(base)) {
                pg8::Gemm g{xh, (const h16*)(ws + WS_WGU) + (size_t)(l * 2 + f) * 2 * DFF * DM, S, 2 * DFF, DM}; pg8::StaticOrder So; So.init(S, 2 * DFF, F.G, (int)blockIdx.x);
                EpiSwiglu E{(h16*)(ws + WS_HB)};
                PH(GSWIGLU, (pg8::gemm_phase<EpiSwiglu, pg8::StaticOrder, true, true>(F.lds, g, So, E)));
                END(base);
            }
        } else if (kind == 1) {
            resA = (const h16*)(ws + WS_OMIX); resB = (const h16*)(ws + WS_WOUT) + (size_t)l * DM * DM; resK = DM; resS = 1.0f; lnidx = 1;
            if (IN(base)) {
                pg8::Gemm g{xh, (const h16*)(ws + WS_WIN) + (size_t)l * NIN * DM, S, NIN, DM}; pg8::StaticOrder So; So.init(S, NIN, F.G, (int)blockIdx.x);
                EpiProj<JOB_WIN> E{ws, 0};
                PH(GWIN, (pg8::gemm_phase<EpiProj<JOB_WIN>, pg8::StaticOrder, true, true>(F.lds, g, So, E)));
                END(base);
            }
            if (IN(base + 1)) {
                const int nb = (int)blockIdx.x, Gn = F.G;
                for (int it = nb; it < 256; it += Gn) {
                    if (it < 96) { pg8::Gemm g{(const h16*)(ws + WS_BCQ), (const h16*)(ws + WS_WUQ) + (size_t)l * 768 * 512, S, 768, 512}; pg8::OneUnit So{it / 3, it % 3, true};
                        EpiProj<JOB_UQ> E{ws, 0}; pg8::gemm_phase<EpiProj<JOB_UQ>, pg8::OneUnit, true, true>(F.lds, g, So, E); }
                    else if (it < 224) { const int i2 = it - 96; pg8::Gemm g{(const h16*)(ws + WS_BCKV), (const h16*)(ws + WS_WUKV) + (size_t)l * 1024 * 512, S, 1024, 512}; pg8::OneUnit So{i2 >> 2, i2 & 3, true};
                        EpiProj<JOB_UKV> E{ws, 0}; pg8::gemm_phase<EpiProj<JOB_UKV>, pg8::OneUnit, true, true>(F.lds, g, So, E); }
                    else if (it < 240) { const int i3 = it - 224, br = i3 & 1, pm = (i3 >> 1) & 1, ks = i3 >> 2;
                        pg8::Gemm g{(const h16*)(ws + (br ? WS_VCMP : WS_KCMP)) + ks * 512, (const h16*)(ws + WS_WC1) + (size_t)(l * 2 + br) * 256 * 2048 + ks * 512, 512, 256, 512, 2048, 2048}; pg8::OneUnit So{pm, 0, true};
                        EpiProj<JOB_Y> E{ws, br + 2 * ks}; pg8::gemm_phase<EpiProj<JOB_Y>, pg8::OneUnit, true, true>(F.lds, g, So, E); }
                    else PH(KMEAN, moba_kmean_phase(F, it - 240));
                }
                END(base + 1);
            }
            if (IN(base + 2)) { PH(CMP2, nsa_cmp2_phase(F, l)); PH(GATE, moba_gate_phase(F)); dsx::score_phase(F); END(base + 2); }
            if (IN(base + 3)) {
#if USE_FA
                fa_cmp_phase(F); nsa_imp_phase(F);
#else
                PH(CMPSEL, nsa_cmp_select_phase(F));
#endif
                PH(TOPK, dsa_topk_phase(F)); END(base + 3); }
            if (IN(base + 4)) {
#if USE_FA
                fa_mixer_phase(F, l);
                if (!(FA_MASK & 1)) mla_attn_phase(F);
                if (!(FA_MASK & 2)) nsa_attn_phase(F);
                if (!(FA_MASK & 4)) moba_attn_phase(F);
                if (!(FA_MASK & 8)) dsa_attn_phase(F);
#else
                PH(MOBA, moba_attn_phase(F)); PH(MLA, mla_attn_phase(F)); PH(NSA, nsa_attn_phase(F)); PH(DSA, dsa_attn_phase(F));
#endif
                END(base + 4); }
        } else {
            resA = (const h16*)(ws + WS_MO); resB = (const h16*)(ws + WS_WMO) + (size_t)l * DM * 512; resK = 512; resS = 1.0f; lnidx = 2;
            if (IN(base)) {
                pg8::Gemm g{xh, (const h16*)(ws + WS_WMQ) + (size_t)l * 512 * DM, S, 512, DM}; pg8::StaticOrder So; So.init(S, 512, F.G, (int)blockIdx.x);
                EpiProj<JOB_MQ> E{ws, 0};
                PH(GMQ, (pg8::gemm_phase<EpiProj<JOB_MQ>, pg8::StaticOrder, true, true>(F.lds, g, So, E)));
                END(base);
            }
            if (IN(base + 1)) {
#if USE_FA
                if (FA_MASK & 16) fa_mem_phase(F, l); else mem_attn_phase(F, l);
#else
                PH(MEMA, mem_attn_phase(F, l));
#endif
                END(base + 1); }
        }
        if (IN(base + 5)) {
            pg8::Gemm g{resA, resB, S, DM, resK}; pg8::StaticOrder So; So.init(S, DM, F.G, (int)blockIdx.x);
            EpiResid E{xf, z, resS};
            PH(GRESID, (pg8::gemm_phase<EpiResid, pg8::StaticOrder, true, true>(F.lds, g, So, E)));
            END(base + 5);
        }
        if (IN(base + 6)) {
            const float* g = (const float*)(ws + WS_LNG) + (size_t)(l * 4 + lnidx) * DM; const float* b = (const float*)(ws + WS_LNB) + (size_t)(l * 4 + lnidx) * DM;
            PH(LN, ln_phase(F, z, g, b, sb == 15 ? F.out : (float*)(ws + WS_XF), (h16*)(ws + WS_XH)));
            END(base + 6);
        }
    }
#undef IN
#undef END
}

extern "C" void kernel_launch(void* const* d_in, const int* in_sizes, int n_in, void* d_out, int out_size, void* d_ws, size_t ws_size, hipStream_t stream) {
    static int grid = 0;
    if (grid == 0) {
        if (n_in != 19 || out_size != S * DM || ws_size < WS_END) { fprintf(stderr, "kernel_launch: unexpected shapes (n_in %d, out %d, ws %zu < %zu)\n", n_in, out_size, ws_size, (size_t)WS_END); grid = -1; return; }
        int dev = 0, cus = 0, per_cu = 0;
        if (hipGetDevice(&dev) != hipSuccess || hipDeviceGetAttribute(&cus, hipDeviceAttributeMultiprocessorCount, dev) != hipSuccess) { grid = -1; return; }
        if (hipFuncSetAttribute((const void*)mk_fwd, hipFuncAttributeMaxDynamicSharedMemorySize, LDS_BYTES) != hipSuccess) { fprintf(stderr, "kernel_launch: hipFuncSetAttribute failed\n"); grid = -1; return; }
        if (hipOccupancyMaxActiveBlocksPerMultiprocessor(&per_cu, (const void*)mk_fwd, NTHREADS, LDS_BYTES) != hipSuccess || per_cu < 1) { fprintf(stderr, "kernel_launch: occupancy query says %d\n", per_cu); }
        (void)hipGetLastError();
        grid = cus;
    }
    if (grid < 0) return;
    if (hipMemsetAsync((char*)d_ws + WS_CTL, 0, CTL_BYTES, stream) != hipSuccess) return;
    Args a{};
    for (int i = 0; i < 19; ++i) a.in[i] = (const float*)d_in[i];
    a.out = (float*)d_out; a.ws = (unsigned char*)d_ws;
#if MK_STEP_LAUNCHES
    for (int st = 0; st < NSTEPS; ++st) {
        if (st >= 2) { const int sb = (st - 2) / SLOTS, slot = (st - 2) % SLOTS, kind = sb & 3;
            const bool live = slot >= 5 || slot == 0 || (kind == 1 && slot <= 4) || (kind == 2 && slot == 1);
            if (!live) continue; }
        a.lo = st; a.hi = st + 1;
        hipLaunchKernelGGL(mk_fwd, dim3(grid), dim3(NTHREADS), LDS_BYTES, stream, a);
    }
#else
    a.lo = 0; a.hi = NSTEPS;
    hipLaunchKernelGGL(mk_fwd, dim3(grid), dim3(NTHREADS), LDS_BYTES, stream, a);
#endif
}
```

```cpp
#include <hip/hip_runtime.h>
#include <cstdio>
#include <cstdint>

#ifndef PROBE_P0
#define PROBE_P0 1
#endif
#ifndef PROBE_TOPK_N
#define PROBE_TOPK_N 1
#define PROBE_IMP_N 1
#endif
#ifndef USE_FA
#define USE_FA 1
#endif
#ifndef FA_MASK
#define FA_MASK 0x1f
#endif
#ifndef MK_STEP_LAUNCHES
#define MK_STEP_LAUNCHES 0
#endif

#define GAS __attribute__((address_space(1)))
#define LAS __attribute__((address_space(3)))
typedef _Float16 h16;
typedef _Float16 half8 __attribute__((ext_vector_type(8)));
typedef _Float16 half4 __attribute__((ext_vector_type(4)));
typedef _Float16 half2v __attribute__((ext_vector_type(2)));
typedef float f32x4 __attribute__((ext_vector_type(4)));
typedef float f32x2 __attribute__((ext_vector_type(2)));
typedef unsigned u32x4 __attribute__((ext_vector_type(4)));
typedef unsigned long long u64;

constexpr int S = 8192, DM = 2048, DFF = 5632, DEPTH = 4, MEMLEN = 256;
constexpr int D_IN = 6556, NIN = 6656;
constexpr float LN_EPS = 1e-5f, RMS_EPS = 1e-6f;
constexpr float DN_ALPHA = 1.681792830507429f;
constexpr int NWAVES = 8, NTHREADS = 512;

constexpr size_t al256(size_t x) { return (x + 255) & ~(size_t)255; }
constexpr size_t WS_CTL = 0, CTL_BYTES = 1u << 20;
constexpr size_t WS_WGU  = CTL_BYTES;
constexpr size_t WS_WD   = WS_WGU  + (size_t)DEPTH * 2 * 2 * DFF * DM * 2;
constexpr size_t WS_WIN  = WS_WD   + (size_t)DEPTH * 2 * DM * DFF * 2;
constexpr size_t WS_WOUT = WS_WIN  + (size_t)DEPTH * NIN * DM * 2;
constexpr size_t WS_WUQ  = WS_WOUT + (size_t)DEPTH * DM * DM * 2;
constexpr size_t WS_WUKV = WS_WUQ  + (size_t)DEPTH * 768 * 512 * 2;
constexpr size_t WS_WC1  = WS_WUKV + (size_t)DEPTH * 1024 * 512 * 2;
constexpr size_t WS_WMQ  = WS_WC1  + (size_t)DEPTH * 2 * 256 * 2048 * 2;
constexpr size_t WS_WMKV = WS_WMQ  + (size_t)DEPTH * 512 * DM * 2;
constexpr size_t WS_WMO  = WS_WMKV + (size_t)DEPTH * 1024 * DM * 2;
constexpr size_t WS_XF   = WS_WMO  + (size_t)DEPTH * DM * 512 * 2;
constexpr size_t WS_XH   = WS_XF   + (size_t)S * DM * 4;
constexpr size_t WS_Z    = WS_XH   + (size_t)S * DM * 2;
constexpr size_t WS_HB   = WS_Z    + (size_t)S * DM * 4;
constexpr size_t WS_MEMH = WS_HB   + (size_t)S * DFF * 2;
constexpr size_t WS_MK   = WS_MEMH + (size_t)MEMLEN * DM * 2;
constexpr size_t WS_MV   = WS_MK   + (size_t)DEPTH * 4 * MEMLEN * 128 * 2;
constexpr size_t WS_T128C = WS_MV  + (size_t)DEPTH * 4 * MEMLEN * 128 * 2;
constexpr size_t WS_T128S = WS_T128C + (size_t)S * 64 * 4;
constexpr size_t WS_T64C  = WS_T128S + (size_t)S * 64 * 4;
constexpr size_t WS_T64S  = WS_T64C + (size_t)S * 32 * 4;
constexpr size_t HEADBUF = (size_t)S * 128 * 2;
constexpr size_t WS_AQ   = WS_T64S + (size_t)S * 32 * 4;
constexpr size_t WS_AK   = WS_AQ + 4 * HEADBUF;
constexpr size_t WS_AV   = WS_AK + 4 * HEADBUF;
constexpr size_t WS_BCQ  = WS_AV + 4 * HEADBUF;
constexpr size_t WS_BCKV = WS_BCQ + (size_t)S * 512 * 2;
constexpr size_t WS_BKR  = WS_BCKV + (size_t)S * 512 * 2;
constexpr size_t WS_Q192 = WS_BKR + (size_t)S * 64 * 2;
constexpr size_t WS_KN   = WS_Q192 + (size_t)4 * S * 192 * 2;
constexpr size_t WS_BV   = WS_KN + 4 * HEADBUF;
constexpr size_t WS_CQRAW = WS_BV + 4 * HEADBUF;
constexpr size_t WS_CQROPE = WS_CQRAW + 4 * HEADBUF;
constexpr size_t WS_KCMP = WS_CQROPE + 4 * HEADBUF;
constexpr size_t WS_VCMP = WS_KCMP + HEADBUF;
constexpr size_t WS_KSLC = WS_VCMP + HEADBUF;
constexpr size_t WS_VSLC = WS_KSLC + HEADBUF;
constexpr size_t WS_KWIN = WS_VSLC + HEADBUF;
constexpr size_t WS_VWIN = WS_KWIN + HEADBUF;
constexpr size_t WS_SMALL = WS_VWIN + HEADBUF;
constexpr size_t WS_DQ   = WS_SMALL + (size_t)S * 32 * 4;
constexpr size_t WS_DK   = WS_DQ + 4 * HEADBUF;
constexpr size_t WS_DV   = WS_DK + 4 * HEADBUF;
constexpr size_t WS_IQ   = WS_DV + 4 * HEADBUF;
constexpr size_t WS_IK   = WS_IQ + (size_t)S * 1024 * 2;
constexpr size_t WS_SSQQ = WS_IK + (size_t)S * 64 * 2;
constexpr size_t WS_SSQKV = WS_SSQQ + (size_t)S * 8 * 4;
constexpr size_t WS_YK   = WS_SSQKV + (size_t)S * 8 * 4;
constexpr size_t WS_YV   = WS_YK + (size_t)4 * 512 * 256 * 4;
constexpr size_t WS_KC   = WS_YV + (size_t)4 * 512 * 256 * 4;
constexpr size_t WS_VC   = WS_KC + (size_t)512 * 128 * 4;
constexpr size_t WS_CBIAS = WS_VC + (size_t)512 * 128 * 4;
constexpr size_t WS_KMEAN = WS_CBIAS + (size_t)DEPTH * 2 * 128 * 4;
constexpr size_t WS_MOBASEL = WS_KMEAN + (size_t)4 * 32 * 128 * 4;
constexpr size_t WS_OCMP = WS_MOBASEL + (size_t)S * 16 * 4;
constexpr size_t WS_NSASEL = WS_OCMP + (size_t)S * 512 * 4;
constexpr size_t WS_NSAMASK = WS_NSASEL + (size_t)S * 16 * 4;
constexpr size_t WS_DSALIST = WS_NSAMASK + (size_t)S * 4 * 4;
constexpr size_t WS_DSAMASK = WS_DSALIST + (size_t)S * 256 * 4;
constexpr size_t WS_OMIX = WS_DSAMASK + (size_t)S * 128 * 8;
constexpr size_t WS_MQ   = WS_OMIX + (size_t)S * DM * 2;
constexpr size_t WS_MO   = WS_MQ + 4 * HEADBUF;
constexpr size_t WS_KC16 = WS_MO + (size_t)S * 512 * 2;
constexpr size_t WS_VC16 = WS_KC16 + (size_t)512 * 128 * 2;
constexpr size_t WS_KMH = WS_VC16 + (size_t)512 * 128 * 2;
constexpr size_t WS_KML = WS_KMH + (size_t)4 * 32 * 128 * 2;
constexpr size_t WS_LNG = WS_KML + (size_t)4 * 32 * 128 * 2;
constexpr size_t WS_LNB = WS_LNG + (size_t)16 * DM * 4;
constexpr size_t WS_W2C = WS_LNB + (size_t)16 * DM * 4;
constexpr size_t WS_SCORES = al256(WS_W2C + (size_t)8 * 128 * 128 * 4);
constexpr size_t WS_END  = WS_SCORES + (size_t)S * S * 4;

constexpr int CW_TMO = 0, CW_CODE = 1, CW_BAR = 4096;

constexpr int RING_BYTES = 131072;
constexpr int LDSCTL_OFF = RING_BYTES, MISC_OFF = LDSCTL_OFF + 320;
constexpr int LDS_BYTES = 147456;

#define RLX_AGENT __ATOMIC_RELAXED, __HIP_MEMORY_SCOPE_AGENT
#define LDS_WAIT() asm volatile("s_waitcnt lgkmcnt(0)" ::: "memory")
#define VM_WAIT() asm volatile("s_waitcnt vmcnt(0)" ::: "memory")

__device__ const double ROPE_INV[64] = {
1.0, 0.8659643233600653, 0.7498942093324559, 0.6493816315762113,
0.5623413251903491, 0.4869675251658631, 0.4216965034285822, 0.3651741272548377,
0.31622776601683794, 0.27384196342643613, 0.23713737056616552, 0.2053525026457146,
0.1778279410038923, 0.1539926526059492, 0.1333521432163324, 0.11547819846894582,
0.1, 0.08659643233600653, 0.07498942093324558, 0.06493816315762113,
0.05623413251903491, 0.04869675251658631, 0.042169650342858224, 0.03651741272548377,
0.03162277660168379, 0.027384196342643614, 0.023713737056616554, 0.02053525026457146,
0.01778279410038923, 0.01539926526059492, 0.01333521432163324, 0.011547819846894581,
0.01, 0.008659643233600654, 0.007498942093324558, 0.006493816315762113,
0.005623413251903491, 0.004869675251658631, 0.004216965034285823, 0.003651741272548377,
0.0031622776601683794, 0.0027384196342643613, 0.0023713737056616554, 0.002053525026457146,
0.0017782794100389228, 0.001539926526059492, 0.001333521432163324, 0.0011547819846894581,
0.001, 0.0008659643233600654, 0.0007498942093324559, 0.0006493816315762113,
0.0005623413251903491, 0.0004869675251658631, 0.00042169650342858224, 0.0003651741272548377,
0.00031622776601683794, 0.0002738419634264361, 0.00023713737056616554, 0.0002053525026457146,
0.00017782794100389227, 0.0001539926526059492, 0.0001333521432163324, 0.00011547819846894582
};
namespace pg8 {
constexpr int BM = 256, BK = 64, HALF = 128, HTB = HALF * BK * 2, STAGE_BYTES = 8 * HTB, NXCD = 8, WGM = 8;
__host__ __device__ __forceinline__ int lds_byte(int r, int c) { const int st = (r >> 4) * 2 + (c >> 5), rr = r & 15, cc = c & 31, ob = rr * 64 + cc * 2; return st * 1024 + (ob ^ (((ob >> 9) & 1) << 5)); }
__host__ __device__ __forceinline__ void stage_rc(int b, int& R, int& C) { const int st = b / 1024, sb = b % 1024, swz = sb ^ (((sb >> 9) & 1) << 5); R = (st >> 1) * 16 + swz / 64; C = (st & 1) * 32 + (swz % 64) / 2; }
__host__ __device__ __forceinline__ int perm32(int rho) { const int n = rho >> 4, i = rho & 15; return 8 * (i >> 2) + 4 * n + (i & 3); }
struct Unit { int pm, pn; };
struct Gemm { const h16* A; const h16* Bt; int M, N, K; int lda = 0, ldb = 0; };
struct OneUnit { int pm, pn; bool valid;
    __device__ __forceinline__ bool next(int i, Unit& u) const { if (i != 0 || !valid) return false; u.pm = pm; u.pn = pn; return true; }
    __device__ __forceinline__ void a_ready(const Unit&) const {}
    __device__ __forceinline__ void done(const Unit&) const {} };
struct StaticOrder {
    int nM, nN, nwg, G, c;
    __host__ __device__ void init(int M, int N, int G_, int c_) { nM = M / BM; nN = N / BM; nwg = nM * nN; G = G_; c = c_; }
    __host__ __device__ bool next(int i, Unit& u) const {
        const long L = (long)i * G + c; if (L >= nwg) return false;
        int wgid = (int)L; { const int q = nwg / NXCD, r = nwg % NXCD, xcd = wgid % NXCD, off = wgid / NXCD; wgid = (xcd < r ? xcd * (q + 1) : r * (q + 1) + (xcd - r) * q) + off; }
        const int nig = WGM * nN, gid = wgid / nig, fm = gid * WGM, gsz = (nM - fm) < WGM ? (nM - fm) : WGM;
        u.pm = fm + ((wgid % nig) % gsz); u.pn = (wgid % nig) / gsz; return true;
    }
    __device__ __forceinline__ void a_ready(const Unit&) const {}
    __device__ __forceinline__ void done(const Unit&) const {}
};
template <class Epi, class Sched, bool ALIGN_EPI = false, bool SP2 = false>
__device__ __forceinline__ void gemm_phase(LAS unsigned char* lds, const Gemm g, const Sched& S, const Epi& E) {
    int tid_ = threadIdx.x; asm volatile("" : "+v"(tid_));
    const int tid = tid_, wid = __builtin_amdgcn_readfirstlane(tid >> 6), lane = tid & 63, wr = wid >> 2, wc = wid & 3, fr = lane & 15, fq = lane >> 4;
    const int K = g.K, nt = K / BK, lda = g.lda ? g.lda : K, ldb = g.ldb ? g.ldb : K;
    unsigned voffA[2], voffB[2];
#pragma unroll
    for (int i = 0; i < 2; ++i) { int R, C; stage_rc(tid * 16 + i * 8192, R, C); const int Rb = Epi::PERM ? ((R & ~31) + perm32(R & 31)) : R;
        voffA[i] = (unsigned)(R * lda + C) * 2u; voffB[i] = (unsigned)(Rb * ldb + C) * 2u; }
    const size_t kstep = (size_t)(BK * 2);
    const size_t hstepA = (size_t)HALF * lda * 2, hstepB = (size_t)HALF * ldb * 2;
    const size_t tstepA = 2 * hstepA, tstepB = 2 * hstepB;
    const unsigned ldsw = (unsigned)wid * 1024u;
    const int aoff = lds_byte(wr * 64 + fr, fq * 8), boff = lds_byte(wc * 32 + fr, fq * 8);
#define PG8_SA(b, h) (((b) * 2 + (h)) * HTB)
#define PG8_SB(b, h) ((4 + (b) * 2 + (h)) * HTB)
#define PG8_STAGE(bufoff, gbase, voff) do { _Pragma("unroll") for (int _i = 0; _i < 2; ++_i) \
        __builtin_amdgcn_global_load_lds((const unsigned*)((const char*)(gbase) + (voff)[_i]), (LAS unsigned*)(lds + (bufoff) + ldsw + _i * 8192), 16, 0, 0); } while (0)
#define PG8_LDA(dst, b, h) do { _Pragma("unroll") for (int m = 0; m < 4; ++m) _Pragma("unroll") for (int k = 0; k < 2; ++k) dst[m][k] = *(const LAS half8*)(lds + PG8_SA(b, h) + aoff + m * 2048 + k * 1024); } while (0)
#define PG8_LDB(dst, b, h) do { _Pragma("unroll") for (int n = 0; n < 2; ++n) _Pragma("unroll") for (int k = 0; k < 2; ++k) dst[n][k] = *(const LAS half8*)(lds + PG8_SB(b, h) + boff + n * 2048 + k * 1024); } while (0)
#define PG8_MMA(ai, bj, At, Bt) do { __builtin_amdgcn_s_setprio(1); _Pragma("unroll") for (int m = 0; m < 4; ++m) _Pragma("unroll") for (int n = 0; n < 2; ++n) _Pragma("unroll") for (int k = 0; k < 2; ++k) \
        acc[ai][bj][m][n] = __builtin_amdgcn_mfma_f32_16x16x32_f16(Bt[n][k], At[m][k], acc[ai][bj][m][n], 0, 0, 0); __builtin_amdgcn_s_setprio(0); } while (0)
#define PG8_WAIT_V(n) asm volatile("s_waitcnt vmcnt(" #n ")" ::: "memory")
#define PG8_WAIT_L(n) asm volatile("s_waitcnt lgkmcnt(" #n ")" ::: "memory")
#define PG8_BAR __builtin_amdgcn_s_barrier()
#define PG8_SCHED __builtin_amdgcn_sched_barrier(0)
    Unit cur, nxt; int ui = 0;
    if (!S.next(0, cur)) return;
    f32x4 acc[2][2][4][2];
#pragma unroll
    for (int a = 0; a < 2; ++a)
#pragma unroll
        for (int b = 0; b < 2; ++b)
#pragma unroll
            for (int m = 0; m < 4; ++m)
#pragma unroll
                for (int n = 0; n < 2; ++n) acc[a][b][m][n] = (f32x4){0.f, 0.f, 0.f, 0.f};
    half8 At[4][2], B0[2][2], B1[2][2];
    const char* cA = (const char*)g.A + (size_t)cur.pm * tstepA; const char* cB = (const char*)g.Bt + (size_t)cur.pn * tstepB;
    S.a_ready(cur);
    if constexpr (SP2) {
        PG8_STAGE(PG8_SB(0, 0), cB, voffB); PG8_STAGE(PG8_SB(0, 1), cB + hstepB, voffB); PG8_STAGE(PG8_SA(0, 0), cA, voffA); PG8_STAGE(PG8_SA(0, 1), cA + hstepA, voffA);
        if (wr == 1) PG8_BAR;
        PG8_WAIT_V(2); PG8_BAR;
        PG8_STAGE(PG8_SB(1, 0), cB + kstep, voffB); PG8_STAGE(PG8_SA(1, 0), cA + kstep, voffA); PG8_STAGE(PG8_SB(1, 1), cB + hstepB + kstep, voffB);
        PG8_WAIT_V(6); PG8_BAR;
    } else {
        PG8_STAGE(PG8_SB(0, 0), cB, voffB); PG8_STAGE(PG8_SA(0, 0), cA, voffA); PG8_STAGE(PG8_SB(0, 1), cB + hstepB, voffB); PG8_STAGE(PG8_SA(0, 1), cA + hstepA, voffA);
        if (wr == 1) PG8_BAR;
        PG8_WAIT_V(4); PG8_BAR;
        PG8_STAGE(PG8_SB(1, 0), cB + kstep, voffB); PG8_STAGE(PG8_SA(1, 0), cA + kstep, voffA); PG8_STAGE(PG8_SB(1, 1), cB + hstepB + kstep, voffB);
        PG8_WAIT_V(6); PG8_BAR;
    }
    for (;;) {
        const bool has_next = S.next(ui + 1, nxt);
        const char* nA = has_next ? (const char*)g.A + (size_t)nxt.pm * tstepA : cA; const char* nB = has_next ? (const char*)g.Bt + (size_t)nxt.pn * tstepB : cB;
        for (int t = 0; t < nt; t += 2) {
            const bool last = (t == nt - 2);
            const char* a1 = cA + (size_t)(t + 1) * kstep;
            const char* a2 = last ? nA : cA + (size_t)(t + 2) * kstep; const char* b2 = last ? nB : cB + (size_t)(t + 2) * kstep;
            const char* a3 = a2 + kstep; const char* b3 = b2 + kstep;
            if (last && has_next) S.a_ready(nxt);
            if constexpr (SP2) {
            PG8_LDB(B0, 0, 0); PG8_LDB(B1, 0, 1); PG8_SCHED; PG8_LDA(At, 0, 0); PG8_STAGE(PG8_SA(1, 1), a1 + hstepA, voffA);
            PG8_WAIT_V(8); PG8_WAIT_L(0); PG8_BAR; PG8_MMA(0, 0, At, B0); PG8_MMA(0, 1, At, B1); PG8_BAR; PG8_SCHED;
            PG8_LDA(At, 0, 1); PG8_STAGE(PG8_SB(0, 0), b2, voffB); PG8_STAGE(PG8_SB(0, 1), b2 + hstepB, voffB); PG8_STAGE(PG8_SA(0, 0), a2, voffA);
            PG8_WAIT_V(8); PG8_WAIT_L(0); PG8_BAR; PG8_MMA(1, 0, At, B0); PG8_MMA(1, 1, At, B1); PG8_BAR; PG8_SCHED;
            PG8_LDB(B0, 1, 0); PG8_LDB(B1, 1, 1); PG8_SCHED; PG8_LDA(At, 1, 0); PG8_STAGE(PG8_SA(0, 1), a2 + hstepA, voffA);
            PG8_WAIT_V(8); PG8_WAIT_L(0); PG8_BAR; PG8_MMA(0, 0, At, B0); PG8_MMA(0, 1, At, B1); PG8_BAR; PG8_SCHED;
            PG8_LDA(At, 1, 1); PG8_STAGE(PG8_SB(1, 0), b3, voffB); PG8_STAGE(PG8_SB(1, 1), b3 + hstepB, voffB); PG8_STAGE(PG8_SA(1, 0), a3, voffA);
            PG8_WAIT_V(8); PG8_WAIT_L(0); PG8_BAR; PG8_MMA(1, 0, At, B0); PG8_MMA(1, 1, At, B1); PG8_BAR; PG8_SCHED;
            } else {
            PG8_LDB(B0, 0, 0); PG8_SCHED; PG8_LDA(At, 0, 0); PG8_STAGE(PG8_SA(1, 1), a1 + hstepA, voffA);
            PG8_WAIT_L(8); PG8_BAR; PG8_WAIT_L(0); PG8_MMA(0, 0, At, B0); PG8_BAR; PG8_SCHED;
            PG8_LDB(B1, 0, 1); PG8_STAGE(PG8_SB(0, 0), b2, voffB);
            PG8_BAR; PG8_WAIT_L(0); PG8_MMA(0, 1, At, B1); PG8_BAR;
            PG8_LDA(At, 0, 1); PG8_STAGE(PG8_SA(0, 0), a2, voffA);
            PG8_BAR; PG8_WAIT_L(0); PG8_MMA(1, 0, At, B0); PG8_BAR; PG8_SCHED;
            PG8_STAGE(PG8_SB(0, 1), b2 + hstepB, voffB);
            PG8_WAIT_V(6); PG8_BAR; PG8_MMA(1, 1, At, B1); PG8_BAR;
            PG8_LDB(B0, 1, 0); PG8_SCHED; PG8_LDA(At, 1, 0); PG8_STAGE(PG8_SA(0, 1), a2 + hstepA, voffA);
            PG8_WAIT_L(8); PG8_BAR; PG8_WAIT_L(0); PG8_MMA(0, 0, At, B0); PG8_BAR; PG8_SCHED;
            PG8_LDB(B1, 1, 1); PG8_STAGE(PG8_SB(1, 0), b3, voffB);
            PG8_BAR; PG8_WAIT_L(0); PG8_MMA(0, 1, At, B1); PG8_BAR;
            PG8_LDA(At, 1, 1); PG8_STAGE(PG8_SA(1, 0), a3, voffA);
            PG8_BAR; PG8_WAIT_L(0); PG8_MMA(1, 0, At, B0); PG8_BAR; PG8_SCHED;
            PG8_STAGE(PG8_SB(1, 1), b3 + hstepB, voffB);
            PG8_WAIT_V(6); PG8_BAR; PG8_MMA(1, 1, At, B1); PG8_BAR;
            }
        }
        if constexpr (ALIGN_EPI) { if (wr == 0) PG8_BAR; }
        if constexpr (!Epi::AFTER_DRAIN) { E(acc, cur, wr, wc, fr, fq); S.done(cur); }
        if (!has_next) break;
#pragma unroll
        for (int a = 0; a < 2; ++a)
#pragma unroll
            for (int b = 0; b < 2; ++b)
#pragma unroll
                for (int m = 0; m < 4; ++m)
#pragma unroll
                    for (int n = 0; n < 2; ++n) acc[a][b][m][n] = (f32x4){0.f, 0.f, 0.f, 0.f};
        cur = nxt; cA = nA; cB = nB; ++ui;
        if constexpr (ALIGN_EPI) { if (wr == 1) PG8_BAR; }
    }
    PG8_WAIT_V(0);
    if constexpr (!ALIGN_EPI) { if (wr == 0) PG8_BAR; }
    PG8_BAR;
    if constexpr (Epi::AFTER_DRAIN) { E.fused(acc, cur, wr, wc, fr, fq, lds, wid, lane); S.done(cur); }
#undef PG8_SA
#undef PG8_SB
#undef PG8_STAGE
#undef PG8_LDA
#undef PG8_LDB
#undef PG8_MMA
#undef PG8_WAIT_V
#undef PG8_WAIT_L
#undef PG8_BAR
#undef PG8_SCHED
}
}
#define XB_TMO      128
#define XB_XCNT(j)  (256  + 64 * (j))
#define XB_XSUB(j)  (1280 + 64 * (j))
#define XB_XGEN(j)  (2304 + 64 * (j))
#define XB_TOP      3328
#define XB_TOPGEN   3392
#define XCD_BAR_WORDS 3456
#define XB_SPIN_CAP (1u << 18)

__device__ __forceinline__ unsigned xb_ld(unsigned* p)              { return __hip_atomic_load(p, __ATOMIC_RELAXED, __HIP_MEMORY_SCOPE_AGENT); }
__device__ __forceinline__ unsigned xb_add(unsigned* p, unsigned v) { return __hip_atomic_fetch_add(p, v, __ATOMIC_RELAXED, __HIP_MEMORY_SCOPE_AGENT); }
__device__ __forceinline__ unsigned xb_xcc_id() { return (unsigned)__builtin_amdgcn_s_getreg((3 << 11) | 20) & 0xFu; }
#define XB_SPIN(cond, bar) do { unsigned _sp = 0; while (cond) { __builtin_amdgcn_s_sleep(1); \
    if ((++_sp & 255u) == 0u) { if (xb_ld(&(bar)[XB_TMO])) break; if (_sp > XB_SPIN_CAP) { atomicAdd(&(bar)[XB_TMO], 1u); break; } } } } while (0)

struct XcdBarrier {
    unsigned* bar; unsigned x;
    volatile LAS unsigned* st;
};

__device__ __forceinline__ XcdBarrier xcd_barrier_post(unsigned* bar, volatile LAS unsigned* st) {
    XcdBarrier b; b.bar = bar; b.x = xb_xcc_id(); b.st = st;
    if (threadIdx.x == 0) (void)xb_add(&bar[XB_XCNT(b.x)], 1u);
    return b;
}
__device__ __forceinline__ void xcd_barrier_complete(unsigned* bar, unsigned x, unsigned& nloc, unsigned& nx) {
    const unsigned G = gridDim.x * gridDim.y * gridDim.z;
    unsigned sum, cnt, mine, sp = 0u;
    for (;;) {
        sum = 0u; cnt = 0u; mine = 0u;
#pragma unroll
        for (unsigned j = 0; j < 16; ++j) { const unsigned c = xb_ld(&bar[XB_XCNT(j)]); sum += c; cnt += (c > 0u) ? 1u : 0u; mine = (j == x) ? c : mine; }
        if (sum == G) break;
        __builtin_amdgcn_s_sleep(1);
        if ((++sp & 255u) == 0u) { if (xb_ld(&bar[XB_TMO])) break; if (sp > XB_SPIN_CAP) { atomicAdd(&bar[XB_TMO], 1u); break; } }
    }
    nloc = mine > 0u ? mine : 1u; nx = cnt > 0u ? cnt : 1u;
}

__device__ __forceinline__ void xcd_barrier(const XcdBarrier& b) {
    asm volatile("s_waitcnt vmcnt(0)" ::: "memory");
    __syncthreads();
    if (threadIdx.x == 0) {
        unsigned* bar = b.bar;
        __builtin_amdgcn_s_waitcnt(0);
        unsigned nloc = b.st[0], nx = b.st[1];
        if (nloc == 0u) { xcd_barrier_complete(bar, b.x, nloc, nx); b.st[0] = nloc; b.st[1] = nx; }
        const unsigned old = xb_add(&bar[XB_XSUB(b.x)], 1u);
        const unsigned gen = old / nloc;
        if (old + 1u == (gen + 1u) * nloc) {
            __builtin_amdgcn_fence(__ATOMIC_RELEASE, "agent");
            asm volatile("s_waitcnt vmcnt(0)" ::: "memory");
            const unsigned og = xb_add(&bar[XB_TOP], 1u);
            const unsigned tg = og / nx;
            if (og + 1u == (tg + 1u) * nx) xb_add(&bar[XB_TOPGEN], 1u);
            else XB_SPIN(xb_ld(&bar[XB_TOPGEN]) == tg, bar);
            __builtin_amdgcn_fence(__ATOMIC_ACQUIRE, "agent");
            xb_add(&bar[XB_XGEN(b.x)], 1u);
            asm volatile("s_waitcnt vmcnt(0)" ::: "memory");
        } else {
            XB_SPIN(xb_ld(&bar[XB_XGEN(b.x)]) == gen, bar);
            __builtin_amdgcn_fence(__ATOMIC_ACQUIRE, "agent");
            asm volatile("s_waitcnt vmcnt(0)" ::: "memory");
        }
    }
    __syncthreads();
}
struct Frame {
    LAS unsigned char* lds;
    volatile LAS unsigned* MISC;
    unsigned* ctl;
    unsigned char* ws;
    int tid, lane, wave;
    int G;
    const float* in[19];
    float* out;
};
enum { IN_X = 0, IN_MEM, IN_POS, IN_LNG, IN_LNB, IN_WGU, IN_WD, IN_WIN, IN_WOUT, IN_GCQ, IN_GCKV, IN_WUQ, IN_WUKV, IN_PE, IN_W1, IN_W2, IN_MWQ, IN_MWKV, IN_MWO };

__device__ __forceinline__ float wave_sum(float v) {
#pragma unroll
    for (int o = 1; o < 64; o <<= 1) v += __shfl_xor(v, o);
    return v;
}
__device__ __forceinline__ float wave_max(float v) {
#pragma unroll
    for (int o = 1; o < 64; o <<= 1) v = fmaxf(v, __shfl_xor(v, o));
    return v;
}
__device__ __forceinline__ half8 pack_h8(f32x4 a, f32x4 b) {
    half8 r; r[0] = (h16)a[0]; r[1] = (h16)a[1]; r[2] = (h16)a[2]; r[3] = (h16)a[3]; r[4] = (h16)b[0]; r[5] = (h16)b[1]; r[6] = (h16)b[2]; r[7] = (h16)b[3]; return r;
}

struct EpiSwiglu {
    static constexpr bool PERM = true, AFTER_DRAIN = false;
    h16* H;
    __device__ __forceinline__ void operator()(const f32x4 (&acc)[2][2][4][2], const pg8::Unit& u, int wr, int wc, int fr, int fq) const {
        const int row0 = u.pm * 256 + wr * 64 + fr, col0 = u.pn * 128 + wc * 32 + 8 * fq;
#pragma unroll
        for (int ai = 0; ai < 2; ++ai)
#pragma unroll
            for (int m = 0; m < 4; ++m) {
                f32x4 o[2];
#pragma unroll
                for (int n = 0; n < 2; ++n)
#pragma unroll
                    for (int j = 0; j < 4; ++j) { const float g = acc[ai][0][m][n][j], uu = acc[ai][1][m][n][j]; o[n][j] = g * __builtin_amdgcn_rcpf(1.0f + __expf(-g)) * uu; }
                *(half8*)(H + (size_t)(row0 + ai * 128 + m * 16) * DFF + col0) = pack_h8(o[0], o[1]);
            }
    }
};
struct EpiResid {
    static constexpr bool PERM = false, AFTER_DRAIN = false;
    const float* xf; float* z; float s;
    __device__ __forceinline__ void operator()(const f32x4 (&acc)[2][2][4][2], const pg8::Unit& u, int wr, int wc, int fr, int fq) const {
        const int row0 = u.pm * 256 + wr * 64 + fr, col0 = u.pn * 256 + wc * 32 + 4 * fq;
#pragma unroll
        for (int ai = 0; ai < 2; ++ai)
#pragma unroll
            for (int m = 0; m < 4; ++m) { const size_t off = (size_t)(row0 + ai * 128 + m * 16) * DM + col0;
#pragma unroll
                for (int bj = 0; bj < 2; ++bj)
#pragma unroll
                    for (int n = 0; n < 2; ++n) { const f32x4 xv = *(const f32x4*)(xf + off + bj * 128 + n * 16); *(f32x4*)(z + off + bj * 128 + n * 16) = xv * DN_ALPHA + acc[ai][bj][m][n] * s; } }
    }
};

enum { JOB_WIN = 0, JOB_UQ, JOB_UKV, JOB_Y, JOB_MQ, JOB_MKV };
struct WaveDst { h16* p0; h16* p1; int ld; int colA, colB; int rope; h16* raw; float* f32p; float* ssq; int ssq_part; bool none; };
template <int JOB> __device__ __forceinline__ WaveDst proj_dst(unsigned char* ws, int t, int wc, int fq, int aux) {
    WaveDst d; d.p0 = nullptr; d.p1 = nullptr; d.ld = 128; d.rope = 0; d.raw = nullptr; d.f32p = nullptr; d.ssq = nullptr; d.ssq_part = 0; d.none = false;
    const int cp = wc * 32 + 8 * fq;
    d.colA = cp & 63; d.colB = cp & 63;
    const int hs = wc >> 1;
    if constexpr (JOB == JOB_WIN) {
        if (t < 11) {
            d.rope = 1; d.colB = d.colA + 64;
            size_t base;
            if (t < 2) base = WS_AQ + (size_t)(2 * t + hs) * HEADBUF;
            else if (t < 4) base = WS_AK + (size_t)(2 * (t - 2) + hs) * HEADBUF;
            else if (t < 6) { base = WS_CQROPE + (size_t)(2 * (t - 4) + hs) * HEADBUF; d.raw = (h16*)(ws + WS_CQRAW + (size_t)(2 * (t - 4) + hs) * HEADBUF); }
            else if (t == 6) base = hs ? WS_KWIN : WS_KSLC;
            else if (t < 9) base = WS_DQ + (size_t)(2 * (t - 7) + hs) * HEADBUF;
            else base = WS_DK + (size_t)(2 * (t - 9) + hs) * HEADBUF;
            d.p0 = d.p1 = (h16*)(ws + base);
        } else if (t < 15) {
            d.rope = 2; d.colA = cp & 31; d.colB = d.colA + 32; d.ld = 1024;
            d.p0 = d.p1 = (h16*)(ws + WS_IQ) + (4 * (t - 11) + wc) * 64;
        } else if (t == 15) {
            d.colA = cp & 31; d.colB = d.colA + 32; d.ld = 64;
            if (wc == 0) { d.rope = 2; d.p0 = d.p1 = (h16*)(ws + WS_BKR); }
            else if (wc == 1) { d.rope = 2; d.p0 = d.p1 = (h16*)(ws + WS_IK); }
            else if (wc == 2) { d.f32p = (float*)(ws + WS_SMALL); d.ld = 32; }
            else d.none = true;
        } else {
            if (t < 18) { const int h0 = 2 * (t - 16); d.p0 = (h16*)(ws + WS_AV + (size_t)h0 * HEADBUF) + 64 * hs; d.p1 = (h16*)(ws + WS_AV + (size_t)(h0 + 1) * HEADBUF) + 64 * hs; }
            else if (t < 20) { d.ld = 512; d.p0 = (h16*)(ws + WS_BCQ) + 256 * (t - 18) + 64 * hs; d.p1 = d.p0 + 128; d.ssq = (float*)(ws + WS_SSQQ); d.ssq_part = (t - 18) * 4 + wc; }
            else if (t < 22) { d.ld = 512; d.p0 = (h16*)(ws + WS_BCKV) + 256 * (t - 20) + 64 * hs; d.p1 = d.p0 + 128; d.ssq = (float*)(ws + WS_SSQKV); d.ssq_part = (t - 20) * 4 + wc; }
            else if (t == 22) { d.p0 = (h16*)(ws + WS_KCMP) + 64 * hs; d.p1 = (h16*)(ws + WS_VCMP) + 64 * hs; }
            else if (t == 23) { d.p0 = (h16*)(ws + WS_VSLC) + 64 * hs; d.p1 = (h16*)(ws + WS_VWIN) + 64 * hs; }
            else { const int h0 = 2 * (t - 24); d.p0 = (h16*)(ws + WS_DV + (size_t)h0 * HEADBUF) + 64 * hs; d.p1 = (h16*)(ws + WS_DV + (size_t)(h0 + 1) * HEADBUF) + 64 * hs; }
        }
    } else if constexpr (JOB == JOB_UQ) {
        d.ld = 192;
        if (t < 2) { d.p0 = (h16*)(ws + WS_Q192) + (size_t)(2 * t) * S * 192 + 64 * hs; d.p1 = (h16*)(ws + WS_Q192) + (size_t)(2 * t + 1) * S * 192 + 64 * hs; }
        else { d.rope = 2; d.colA = cp & 31; d.colB = d.colA + 32; d.p0 = d.p1 = (h16*)(ws + WS_Q192) + (size_t)wc * S * 192 + 128; }
        d.ssq = (float*)(ws + WS_SSQQ);
    } else if constexpr (JOB == JOB_UKV) {
        d.p0 = (h16*)(ws + WS_KN + (size_t)t * HEADBUF) + 64 * hs; d.p1 = (h16*)(ws + WS_BV + (size_t)t * HEADBUF) + 64 * hs;
        d.ssq = (float*)(ws + WS_SSQKV);
    } else if constexpr (JOB == JOB_Y) {
        d.f32p = (float*)(ws + ((aux & 1) ? WS_YV : WS_YK)) + (size_t)(aux >> 1) * 512 * 256; d.ld = 256;
    } else if constexpr (JOB == JOB_MQ) {
        d.p0 = (h16*)(ws + WS_MQ + (size_t)(2 * t) * HEADBUF) + 64 * hs; d.p1 = (h16*)(ws + WS_MQ + (size_t)(2 * t + 1) * HEADBUF) + 64 * hs;
    } else {
        const int layer = t >> 2, tt = t & 3, h0 = 2 * (tt & 1);
        const size_t kb = (tt >> 1) ? WS_MV : WS_MK;
        d.p0 = (h16*)(ws + kb) + (size_t)((layer * 4 + h0) * MEMLEN) * 128 + 64 * hs; d.p1 = (h16*)(ws + kb) + (size_t)((layer * 4 + h0 + 1) * MEMLEN) * 128 + 64 * hs;
    }
    return d;
}
template <int JOB> struct EpiProj {
    static constexpr bool PERM = true, AFTER_DRAIN = false;
    unsigned char* ws; int aux;
    __device__ __forceinline__ void operator()(const f32x4 (&acc)[2][2][4][2], const pg8::Unit& u, int wr, int wc, int fr, int fq) const {
        const WaveDst d = proj_dst<JOB>(ws, u.pn, wc, fq, aux);
        if (d.none) return;
        const int row0 = u.pm * 256 + wr * 64 + fr;
        const float* tc = (const float*)(ws + (d.rope == 1 ? WS_T128C : WS_T64C)); const float* ts = (const float*)(ws + (d.rope == 1 ? WS_T128S : WS_T64S));
        const int tw = d.rope == 1 ? 64 : 32;
#pragma unroll
        for (int ai = 0; ai < 2; ++ai)
#pragma unroll
            for (int m = 0; m < 4; ++m) {
                const int row = row0 + ai * 128 + m * 16;
                f32x4 a0 = acc[ai][0][m][0], a1 = acc[ai][0][m][1], b0 = acc[ai][1][m][0], b1 = acc[ai][1][m][1];
                if constexpr (JOB == JOB_UQ || JOB == JOB_UKV) {
                    const f32x4 s0 = *(const f32x4*)(d.ssq + (size_t)row * 8), s1 = *(const f32x4*)(d.ssq + (size_t)row * 8 + 4);
                    const float ss = ((s0[0] + s0[1]) + (s0[2] + s0[3])) + ((s1[0] + s1[1]) + (s1[2] + s1[3]));
                    const float rs = 1.0f / sqrtf(ss * (1.0f / 512.0f) + RMS_EPS);
                    a0 = a0 * rs; a1 = a1 * rs; b0 = b0 * rs; b1 = b1 * rs;
                }
                if constexpr (JOB == JOB_WIN) {
                    if (d.ssq) {
                        float q = 0.f;
#pragma unroll
                        for (int j = 0; j < 4; ++j) q += a0[j] * a0[j] + a1[j] * a1[j] + b0[j] * b0[j] + b1[j] * b1[j];
                        q += __shfl_xor(q, 16); q += __shfl_xor(q, 32);
                        if (fq == 0) d.ssq[(size_t)row * 8 + d.ssq_part] = q;
                    }
                    if (d.raw) { *(half8*)(d.raw + (size_t)row * 128 + d.colA) = pack_h8(a0, a1); *(half8*)(d.raw + (size_t)row * 128 + d.colB) = pack_h8(b0, b1); }
                }
                if (d.f32p) {
                    if constexpr (JOB == JOB_Y) { float* p = d.f32p + (size_t)row * 256 + wc * 32 + 8 * fq; *(f32x4*)p = a0; *(f32x4*)(p + 4) = a1; *(f32x4*)(p + 128) = b0; *(f32x4*)(p + 132) = b1; }
                    else { float* p = d.f32p + (size_t)row * 32 + d.colA; *(f32x4*)p = a0; *(f32x4*)(p + 4) = a1; }
                    continue;
                }
                if (d.rope) {
                    const size_t ti = (size_t)row * tw + d.colA;
                    const f32x4 c0 = *(const f32x4*)(tc + ti), c1 = *(const f32x4*)(tc + ti + 4), s0 = *(const f32x4*)(ts + ti), s1 = *(const f32x4*)(ts + ti + 4);
                    const f32x4 o0 = a0 * c0 - b0 * s0, o1 = a1 * c1 - b1 * s1, q0 = a0 * s0 + b0 * c0, q1 = a1 * s1 + b1 * c1;
                    a0 = o0; a1 = o1; b0 = q0; b1 = q1;
                }
                *(half8*)(d.p0 + (size_t)row * d.ld + d.colA) = pack_h8(a0, a1);
                *(half8*)(d.p1 + (size_t)row * d.ld + d.colB) = pack_h8(b0, b1);
            }
    }
};
__device__ __forceinline__ int win_map(int np) {
    const int t = np >> 8, c = np & 255;
    if (t < 11) {
        const int slot = (c >> 6) & 1, d = (c & 63) + 64 * (c >> 7);
        int base;
        if (t < 2) base = 0 + 256 * t + 128 * slot;
        else if (t < 4) base = 512 + 256 * (t - 2) + 128 * slot;
        else if (t < 6) base = 2624 + 256 * (t - 4) + 128 * slot;
        else if (t == 6) base = slot ? 3648 : 3392;
        else if (t < 9) base = 3916 + 256 * (t - 7) + 128 * slot;
        else base = 4428 + 256 * (t - 9) + 128 * slot;
        return base + d;
    }
    if (t < 15) { const int head = (c >> 5) & 3, d = (c & 31) + 32 * (c >> 7); return 5452 + 64 * (4 * (t - 11) + head) + d; }
    if (t == 15) {
        const int head = (c >> 5) & 3, half = c >> 7, d = (c & 31) + 32 * half;
        if (head == 0) return 2560 + d;
        if (head == 1) return 6476 + d;
        if (head == 2) { if (half) return -1; if (d < 12) return 3904 + d; if (d < 28) return 6540 + (d - 12); return -1; }
        return -1;
    }
    if (t < 18) return 1024 + 256 * (t - 16) + c;
    if (t < 20) return 1536 + 256 * (t - 18) + c;
    if (t < 22) return 2048 + 256 * (t - 20) + c;
    if (t == 22) return 3136 + c;
    if (t == 23) return c < 128 ? 3520 + c : 3776 + (c - 128);
    return 4940 + 256 * (t - 24) + c;
}
__device__ __forceinline__ int uq_map(int np) {
    const int t = np >> 8, c = np & 255;
    if (t < 2) { const int slot = c >> 6, head = 2 * t + (slot >> 1), d = 64 * (slot & 1) + (c & 63); return head * 192 + d; }
    const int head = (c >> 5) & 3, d = (c & 31) + 32 * (c >> 7); return head * 192 + 128 + d;
}
enum { WK_GU0 = 0, WK_GU1, WK_D0, WK_D1, WK_IN, WK_OUT, WK_UQ, WK_UKV, WK_C1K, WK_C1V, WK_MQ, WK_MKV, WK_MO, WK_N };
struct WJob { const float* W; h16* dst; int K, NP, kind; const float* kscale; };
__device__ __forceinline__ long wsrc(int kind, int k, int np) {
    switch (kind) {
        case WK_GU0: case WK_GU1: { const int pn = np >> 8, c = np & 255; const int col = c < 128 ? 128 * pn + c : DFF + 128 * pn + (c - 128); return (long)k * (2 * DFF) + col; }
        case WK_D0: case WK_D1: return (long)k * DM + np;
        case WK_IN: { const int col = win_map(np); return col < 0 ? -1 : (long)k * D_IN + col; }
        case WK_OUT: return (long)k * DM + np;
        case WK_UQ: return (long)k * 768 + uq_map(np);
        case WK_UKV: return (long)k * 1024 + np;
        case WK_C1K: case WK_C1V: return (long)((np >> 7) * 2048 + k) * 128 + (np & 127);
        case WK_MQ: return (long)k * 512 + np;
        case WK_MKV: return (long)k * 1024 + np;
        default: return (long)k * DM + np;
    }
}
__device__ __forceinline__ void p0_transpose_item(const WJob& J, LAS unsigned* scr, int item, int lane) {
    const int nblk = J.NP / 64, kb = item / nblk, nb = item % nblk, k0 = 64 * kb, n0 = 64 * nb;
    const int kp = lane >> 4, nq = lane & 15;
    const long s0 = wsrc(J.kind, 0, n0 + 4 * nq); const long kstride = wsrc(J.kind, 1, n0 + 4 * nq) - s0;
    f32x4 v[16];
#pragma unroll
    for (int p = 0; p < 8; ++p) { const int k = k0 + 8 * p + 2 * kp;
        if (s0 >= 0) { v[2 * p] = *(const f32x4*)(J.W + s0 + (long)k * kstride); v[2 * p + 1] = *(const f32x4*)(J.W + s0 + (long)(k + 1) * kstride); }
        else { v[2 * p] = (f32x4){0.f, 0.f, 0.f, 0.f}; v[2 * p + 1] = (f32x4){0.f, 0.f, 0.f, 0.f}; } }
#pragma unroll
    for (int p = 0; p < 8; ++p) { const int k = 8 * p + 2 * kp; f32x4 x = v[2 * p], y = v[2 * p + 1];
        if (J.kscale) { const float sa = J.kscale[k0 + k], sb = J.kscale[k0 + k + 1]; x = x * sa; y = y * sb; }
#pragma unroll
        for (int i = 0; i < 4; ++i) { half2v h; h[0] = (h16)x[i]; h[1] = (h16)y[i]; scr[(4 * nq + i) * 33 + (k >> 1)] = __builtin_bit_cast(unsigned, h); } }
    LDS_WAIT(); asm volatile("" ::: "memory");
    const int c = lane & 7, nn = lane >> 3;
#pragma unroll
    for (int j = 0; j < 8; ++j) { const int n = nn + 8 * j; const LAS unsigned* s = scr + n * 33 + 4 * c;
        u32x4 o = {s[0], s[1], s[2], s[3]};
        *(u32x4*)(J.dst + (size_t)(n0 + n) * J.K + k0 + 8 * c) = o; }
    LDS_WAIT(); asm volatile("" ::: "memory");
}
constexpr int WK_ITEMS[WK_N] = { 2 * DFF * DM / 4096, 2 * DFF * DM / 4096, DM * DFF / 4096, DM * DFF / 4096, NIN * DM / 4096, DM * DM / 4096, 768 * 512 / 4096, 1024 * 512 / 4096,
                                 256 * 2048 / 4096, 256 * 2048 / 4096, 512 * DM / 4096, 1024 * DM / 4096, DM * 512 / 4096 };
constexpr int wk_items_per_layer() { int s = 0; for (int i = 0; i < WK_N; ++i) s += WK_ITEMS[i]; return s; }
constexpr int IPL = wk_items_per_layer();
__device__ __forceinline__ WJob wjob(Frame& F, int l, int kind) {
    WJob J; J.kind = kind; J.kscale = nullptr;
    unsigned char* ws = F.ws;
    switch (kind) {
        case WK_GU0: case WK_GU1: { const int f = kind - WK_GU0; J.W = F.in[IN_WGU] + (size_t)(l * 2 + f) * DM * 2 * DFF; J.dst = (h16*)(ws + WS_WGU) + (size_t)(l * 2 + f) * 2 * DFF * DM; J.K = DM; J.NP = 2 * DFF; break; }
        case WK_D0: case WK_D1: { const int f = kind - WK_D0; J.W = F.in[IN_WD] + (size_t)(l * 2 + f) * DFF * DM; J.dst = (h16*)(ws + WS_WD) + (size_t)(l * 2 + f) * DM * DFF; J.K = DFF; J.NP = DM; break; }
        case WK_IN: J.W = F.in[IN_WIN] + (size_t)l * DM * D_IN; J.dst = (h16*)(ws + WS_WIN) + (size_t)l * NIN * DM; J.K = DM; J.NP = NIN; break;
        case WK_OUT: J.W = F.in[IN_WOUT] + (size_t)l * DM * DM; J.dst = (h16*)(ws + WS_WOUT) + (size_t)l * DM * DM; J.K = DM; J.NP = DM; break;
        case WK_UQ: J.W = F.in[IN_WUQ] + (size_t)l * 512 * 768; J.dst = (h16*)(ws + WS_WUQ) + (size_t)l * 768 * 512; J.K = 512; J.NP = 768; J.kscale = F.in[IN_GCQ] + l * 512; break;
        case WK_UKV: J.W = F.in[IN_WUKV] + (size_t)l * 512 * 1024; J.dst = (h16*)(ws + WS_WUKV) + (size_t)l * 1024 * 512; J.K = 512; J.NP = 1024; J.kscale = F.in[IN_GCKV] + l * 512; break;
        case WK_C1K: case WK_C1V: { const int i = kind - WK_C1K; J.W = F.in[IN_W1] + (size_t)(l * 2 + i) * 4096 * 128; J.dst = (h16*)(ws + WS_WC1) + (size_t)(l * 2 + i) * 256 * 2048; J.K = 2048; J.NP = 256; break; }
        case WK_MQ: J.W = F.in[IN_MWQ] + (size_t)l * DM * 512; J.dst = (h16*)(ws + WS_WMQ) + (size_t)l * 512 * DM; J.K = DM; J.NP = 512; break;
        case WK_MKV: J.W = F.in[IN_MWKV] + (size_t)l * DM * 1024; J.dst = (h16*)(ws + WS_WMKV) + (size_t)l * 1024 * DM; J.K = DM; J.NP = 1024; break;
        default: J.W = F.in[IN_MWO] + (size_t)l * 512 * DM; J.dst = (h16*)(ws + WS_WMO) + (size_t)l * DM * 512; J.K = 512; J.NP = DM; break;
    }
    return J;
}
__device__ __forceinline__ void sincos_d(double a, float& sn, float& cs) {
    const double k = __builtin_rint(a * 0.63661977236758134308);
    double r = __builtin_fma(-k, 1.57079632679489655800e+00, a); r = __builtin_fma(-k, 6.12323399573676603587e-17, r);
    const double r2 = r * r;
    double s = -1.0 / 1307674368000.0; s = s * r2 + 1.0 / 6227020800.0; s = s * r2 - 1.0 / 39916800.0; s = s * r2 + 1.0 / 362880.0; s = s * r2 - 1.0 / 5040.0; s = s * r2 + 1.0 / 120.0; s = s * r2 - 1.0 / 6.0; s = s * r2 * r + r;
    double c = 1.0 / 20922789888000.0; c = c * r2 - 1.0 / 87178291200.0; c = c * r2 + 1.0 / 479001600.0; c = c * r2 - 1.0 / 3628800.0; c = c * r2 + 1.0 / 40320.0; c = c * r2 - 1.0 / 720.0; c = c * r2 + 1.0 / 24.0; c = c * r2 - 0.5; c = c * r2 + 1.0;
    const int q = ((int)k) & 3;
    const double ss = (q == 0) ? s : (q == 1) ? c : (q == 2) ? -s : -c;
    const double cc = (q == 0) ? c : (q == 1) ? -s : (q == 2) ? -c : s;
    sn = (float)ss; cs = (float)cc;
}
__device__ __forceinline__ void p0_prologue(Frame& F) { int lane = F.lane; asm volatile("" : "+v"(lane));
    LAS unsigned* scr = (LAS unsigned*)(F.lds + F.wave * 16384);
    const int gw = blockIdx.x * NWAVES + F.wave, NGW = F.G * NWAVES;
    for (int it = gw; it < DEPTH * IPL; it += NGW) {
        const int l = it / IPL; int r = it % IPL; int kind = 0;
#pragma unroll
        for (int k = 0; k < WK_N; ++k) { if (kind == k && r >= WK_ITEMS[k]) { r -= WK_ITEMS[k]; kind = k + 1; } }
        const WJob J = wjob(F, l, kind);
        p0_transpose_item(J, scr, r, lane);
    }
    const int* pos = (const int*)F.in[IN_POS];
    for (int m = gw; m < S; m += NGW) {
        const f32x4* xr = (const f32x4*)(F.in[IN_X] + (size_t)m * DM) + lane;
        f32x4* xo = (f32x4*)((float*)(F.ws + WS_XF) + (size_t)m * DM) + lane;
        half4* xh = (half4*)((h16*)(F.ws + WS_XH) + (size_t)m * DM) + lane;
#pragma unroll
        for (int j = 0; j < 8; ++j) { const f32x4 v = xr[64 * j]; xo[64 * j] = v; half4 h; h[0] = (h16)v[0]; h[1] = (h16)v[1]; h[2] = (h16)v[2]; h[3] = (h16)v[3]; xh[64 * j] = h; }
        const double p = (double)pos[m];
        float sn, cs; sincos_d(p * ROPE_INV[lane], sn, cs);
        ((float*)(F.ws + WS_T128C))[(size_t)m * 64 + lane] = cs; ((float*)(F.ws + WS_T128S))[(size_t)m * 64 + lane] = sn;
        if ((lane & 1) == 0) { ((float*)(F.ws + WS_T64C))[(size_t)m * 32 + (lane >> 1)] = cs; ((float*)(F.ws + WS_T64S))[(size_t)m * 32 + (lane >> 1)] = sn; }
    }
    for (int m = gw; m < MEMLEN; m += NGW) {
        const f32x4* xr = (const f32x4*)(F.in[IN_MEM] + (size_t)m * DM) + lane;
        half4* xh = (half4*)((h16*)(F.ws + WS_MEMH) + (size_t)m * DM) + lane;
#pragma unroll
        for (int j = 0; j < 8; ++j) { const f32x4 v = xr[64 * j]; half4 h; h[0] = (h16)v[0]; h[1] = (h16)v[1]; h[2] = (h16)v[2]; h[3] = (h16)v[3]; xh[64 * j] = h; }
    }
    for (int i = gw * 64 + lane; i < 16 * DM; i += NGW * 64) { ((float*)(F.ws + WS_LNG))[i] = F.in[IN_LNG][i]; ((float*)(F.ws + WS_LNB))[i] = F.in[IN_LNB][i]; }
    for (int i = gw * 64 + lane; i < 8 * 128 * 128; i += NGW * 64) ((float*)(F.ws + WS_W2C))[i] = F.in[IN_W2][i];
    for (int it = gw; it < DEPTH * 2 * 8; it += NGW) {
        const int li = it >> 3, n = (it & 7) * 16 + (lane & 15), kq = lane >> 4;
        const float* pe = F.in[IN_PE] + (size_t)li * 4096; const float* w1 = F.in[IN_W1] + (size_t)li * 4096 * 128;
        float a = 0.f;
        for (int k = kq; k < 4096; k += 4) a += pe[k] * w1[(size_t)k * 128 + n];
        a += __shfl_xor(a, 16); a += __shfl_xor(a, 32);
        if (kq == 0) ((float*)(F.ws + WS_CBIAS))[li * 128 + n] = a;
    }
}
__device__ __forceinline__ void ln_phase(Frame& F, const float* z, const float* g, const float* b, float* of, h16* oh) { int lane = F.lane; asm volatile("" : "+v"(lane));
    const int gw = blockIdx.x * NWAVES + F.wave, NGW = F.G * NWAVES;
    f32x4 gv[8], bv[8];
#pragma unroll
    for (int j = 0; j < 8; ++j) { gv[j] = ((const f32x4*)g)[lane + 64 * j]; bv[j] = ((const f32x4*)b)[lane + 64 * j]; }
    for (int m = gw; m < S; m += NGW) {
        const f32x4* zr = (const f32x4*)(z + (size_t)m * DM) + lane;
        f32x4 v[8]; float s = 0.f;
#pragma unroll
        for (int j = 0; j < 8; ++j) { v[j] = zr[64 * j]; s += (v[j][0] + v[j][1]) + (v[j][2] + v[j][3]); }
        const float mean = wave_sum(s) * (1.f / DM); float s2 = 0.f;
#pragma unroll
        for (int j = 0; j < 8; ++j) { v[j] = v[j] - mean; s2 += (v[j][0] * v[j][0] + v[j][1] * v[j][1]) + (v[j][2] * v[j][2] + v[j][3] * v[j][3]); }
        const float rstd = 1.f / sqrtf(wave_sum(s2) * (1.f / DM) + LN_EPS);
        f32x4* orow = (f32x4*)(of + (size_t)m * DM) + lane; half4* hrow = (half4*)(oh + (size_t)m * DM) + lane;
#pragma unroll
        for (int j = 0; j < 8; ++j) { const f32x4 o = v[j] * rstd * gv[j] + bv[j]; orow[64 * j] = o; half4 h; h[0] = (h16)o[0]; h[1] = (h16)o[1]; h[2] = (h16)o[2]; h[3] = (h16)o[3]; hrow[64 * j] = h; }
    }
}
struct AttnAcc { float m, l, o0, o1; };
__device__ __forceinline__ void attn_init(AttnAcc& a) { a.m = -1e30f; a.l = 0.f; a.o0 = 0.f; a.o1 = 0.f; }
__device__ __forceinline__ float dot_h(const LAS float* qs, const h16* krow, int n16) {
    float acc = 0.f;
#pragma unroll 4
    for (int j = 0; j < n16; ++j) { const half8 w = *(const half8*)(krow + 8 * j); const f32x4 qa = *(const LAS f32x4*)(qs + 8 * j), qb = *(const LAS f32x4*)(qs + 8 * j + 4);
        acc += (float)w[0] * qa[0] + (float)w[1] * qa[1] + (float)w[2] * qa[2] + (float)w[3] * qa[3] + (float)w[4] * qb[0] + (float)w[5] * qb[1] + (float)w[6] * qb[2] + (float)w[7] * qb[3]; }
    return acc;
}
__device__ __forceinline__ void attn_chunk(AttnAcc& a, int key, float logit, const h16* V, int ldv, int lane) {
    const bool valid = key >= 0;
    const float lg = valid ? logit : -__builtin_inff();
    const float cmax = wave_max(lg);
    if (cmax == -__builtin_inff()) return;
    const float mn = fmaxf(a.m, cmax), alpha = __expf(a.m - mn);
    const float p = valid ? __expf(lg - mn) : 0.f;
    a.l = a.l * alpha + wave_sum(p); a.o0 *= alpha; a.o1 *= alpha; a.m = mn;
    u64 mask = __ballot(valid);
    while (mask) { const int j = __builtin_ctzll(mask); mask &= mask - 1;
        const float pj = __builtin_bit_cast(float, __builtin_amdgcn_readlane(__builtin_bit_cast(int, p), j)); const int kj = __builtin_amdgcn_readlane(key, j);
        const half2v v = *(const half2v*)(V + (size_t)kj * ldv + 2 * lane);
        a.o0 += pj * (float)v[0]; a.o1 += pj * (float)v[1]; }
}
__device__ __forceinline__ void load_q(LAS float* qs, const h16* q, int nd, int lane) {
    for (int i = lane; i < nd / 2; i += 64) { const half2v v = *(const half2v*)(q + 2 * i); qs[2 * i] = (float)v[0]; qs[2 * i + 1] = (float)v[1]; }
    LDS_WAIT(); asm volatile("" ::: "memory");
}
__device__ __forceinline__ void store_o(h16* dst, const AttnAcc& a, int lane) {
    const float inv = a.l > 0.f ? 1.0f / a.l : 0.f; half2v o; o[0] = (h16)(a.o0 * inv); o[1] = (h16)(a.o1 * inv); *(half2v*)(dst + 2 * lane) = o;
}
#define WAVE_ITEMS(it, total) for (int it = blockIdx.x * NWAVES + F.wave; it < (total); it += F.G * NWAVES)
constexpr float SC128 = 0.08838834764831845f, SC192 = 0.07216878364870323f;

__device__ __forceinline__ void moba_kmean_phase(Frame& F, int slot) { int lane = F.lane; asm volatile("" : "+v"(lane));
    const int it = slot * 8 + F.wave, h = it >> 5, n = it & 31; const h16* k = (const h16*)(F.ws + WS_AK + (size_t)h * HEADBUF) + (size_t)n * 256 * 128 + 2 * lane;
    float s0 = 0.f, s1 = 0.f;
#pragma unroll 16
    for (int r = 0; r < 256; ++r) { const half2v v = *(const half2v*)(k + (size_t)r * 128); s0 += (float)v[0]; s1 += (float)v[1]; }
    const float m0 = s0 * (1.f / 256.f), m1 = s1 * (1.f / 256.f);
    float* o = (float*)(F.ws + WS_KMEAN) + (size_t)it * 128 + 2 * lane; o[0] = m0; o[1] = m1;
    half2v hh, hl; hh[0] = (h16)m0; hh[1] = (h16)m1; hl[0] = (h16)(m0 - (float)hh[0]); hl[1] = (h16)(m1 - (float)hh[1]);
    *(half2v*)((h16*)(F.ws + WS_KMH) + (size_t)it * 128 + 2 * lane) = hh; *(half2v*)((h16*)(F.ws + WS_KML) + (size_t)it * 128 + 2 * lane) = hl;
}
__device__ __forceinline__ float gelu_tanh(float x) { const float u = 0.7978845608028654f * (x + 0.044715f * x * x * x); return 0.5f * x * (1.0f + tanhf(u)); }
__device__ __forceinline__ void nsa_cmp2_phase(Frame& F, int l) { int lane = F.lane; asm volatile("" : "+v"(lane));
    LAS float* hs = (LAS float*)(F.lds + F.wave * 16384);
    WAVE_ITEMS(it, 2 * 511) { const int br = it / 511, i = it % 511;
        const float* Y = (const float*)(F.ws + (br ? WS_YV : WS_YK)); const float* cb = (const float*)(F.ws + WS_CBIAS) + (l * 2 + br) * 128;
        const float* w2 = (const float*)(F.ws + WS_W2C) + (size_t)(l * 2 + br) * 128 * 128;
#pragma unroll
        for (int e = 0; e < 2; ++e) { const int n = lane + 64 * e; float a = cb[n];
#pragma unroll
            for (int ks = 0; ks < 4; ++ks) a += Y[(size_t)ks * 512 * 256 + (size_t)i * 256 + n] + Y[(size_t)ks * 512 * 256 + (size_t)(i + 1) * 256 + 128 + n];
            hs[n] = gelu_tanh(a); }
        LDS_WAIT(); asm volatile("" ::: "memory");
        float o0 = 0.f, o1 = 0.f;
#pragma unroll 16
        for (int k = 0; k < 128; ++k) { const float hv = hs[k]; o0 += hv * w2[k * 128 + lane]; o1 += hv * w2[k * 128 + 64 + lane]; }
        float* o = (float*)(F.ws + (br ? WS_VC : WS_KC)) + (size_t)i * 128; o[lane] = o0; o[64 + lane] = o1;
        h16* o16 = (h16*)(F.ws + (br ? WS_VC16 : WS_KC16)) + (size_t)i * 128; o16[lane] = (h16)o0; o16[64 + lane] = (h16)o1;
        if (i == 510) { o16[128 + lane] = (h16)0.f; o16[192 + lane] = (h16)0.f; }
        LDS_WAIT(); asm volatile("" ::: "memory"); }
}
__device__ __forceinline__ void moba_gate_phase(Frame& F) { int lane = F.lane; asm volatile("" : "+v"(lane));
    WAVE_ITEMS(it, S * 4) { const int t = it >> 2, h = it & 3, cur = t >> 8;
        int* sel = (int*)(F.ws + WS_MOBASEL) + (size_t)t * 16 + h * 4;
        const int n = lane & 31; float g = -__builtin_inff();
        if (n < cur) { const h16* q = (const h16*)(F.ws + WS_AQ + (size_t)h * HEADBUF) + (size_t)t * 128; const float* km = (const float*)(F.ws + WS_KMEAN) + (size_t)(h * 32 + n) * 128;
            float a = 0.f;
            for (int d = 0; d < 128; d += 8) { const half8 qv = *(const half8*)(q + d); const f32x4 k0 = *(const f32x4*)(km + d), k1 = *(const f32x4*)(km + d + 4);
                a += (float)qv[0] * k0[0] + (float)qv[1] * k0[1] + (float)qv[2] * k0[2] + (float)qv[3] * k0[3] + (float)qv[4] * k1[0] + (float)qv[5] * k1[1] + (float)qv[6] * k1[2] + (float)qv[7] * k1[3]; }
            g = a; }
        if (lane >= 32) g = -__builtin_inff();
#pragma unroll
        for (int r = 0; r < 3; ++r) { const float mx = wave_max(g); int idx = -1;
            if (mx > -__builtin_inff()) { const u64 bm = __ballot(g == mx); idx = __builtin_ctzll(bm); if (lane == idx) g = -__builtin_inff(); }
            if (lane == 0) sel[r] = idx; }
    }
}
__device__ __forceinline__ void dsa_score_phase(Frame& F) { int lane = F.lane; asm volatile("" : "+v"(lane));
    LAS float* qs = (LAS float*)(F.lds + F.wave * 16384);
    WAVE_ITEMS(t, S) {
        const h16* iq = (const h16*)(F.ws + WS_IQ) + (size_t)t * 1024;
#pragma unroll
        for (int e = 0; e < 2; ++e) { const half8 v = *(const half8*)(iq + (lane + 64 * e) * 8);
#pragma unroll
            for (int j = 0; j < 8; ++j) qs[(lane + 64 * e) * 8 + j] = (float)v[j]; }
        if (lane < 16) qs[1024 + lane] = ((const float*)(F.ws + WS_SMALL))[(size_t)t * 32 + 12 + lane] * (0.25f * 0.125f);
        LDS_WAIT(); asm volatile("" ::: "memory");
        float* sc = (float*)(F.ws + WS_SCORES) + (size_t)t * S;
        for (int c = 0; c * 64 <= t; ++c) { const int s = c * 64 + lane; const h16* ik = (const h16*)(F.ws + WS_IK) + (size_t)s * 64;
            float kv[64];
#pragma unroll
            for (int j = 0; j < 8; ++j) { const half8 v = *(const half8*)(ik + 8 * j);
#pragma unroll
                for (int e = 0; e < 8; ++e) kv[8 * j + e] = (float)v[e]; }
            float score = 0.f;
#pragma unroll 1
            for (int h = 0; h < 16; ++h) { float a = 0.f; const LAS float* qh = qs + h * 64;
#pragma unroll
                for (int d = 0; d < 64; d += 4) { const f32x4 q4 = *(const LAS f32x4*)(qh + d); a += q4[0] * kv[d] + q4[1] * kv[d + 1] + q4[2] * kv[d + 2] + q4[3] * kv[d + 3]; }
                score += qs[1024 + h] * fmaxf(a, 0.f); }
            sc[s] = score; }
        LDS_WAIT(); asm volatile("" ::: "memory");
    }
}
__device__ __forceinline__ void nsa_cmp_select_phase(Frame& F) { int lane = F.lane; asm volatile("" : "+v"(lane));
    LAS float* qs = (LAS float*)(F.lds + F.wave * 16384);
    LAS float* pp = qs + 256;
    const float* kc = (const float*)(F.ws + WS_KC); const float* vc = (const float*)(F.ws + WS_VC);
    WAVE_ITEMS(t, S) {
        const int nvis = t >= 31 ? ((t - 31) >> 4) + 1 : 0;
        float P[8];
#pragma unroll
        for (int c = 0; c < 8; ++c) P[c] = 0.f;
        for (int h = 0; h < 4; ++h) {
            load_q(qs, (const h16*)(F.ws + WS_CQRAW + (size_t)h * HEADBUF) + (size_t)t * 128, 128, lane);
            float lg[8]; float mx = -__builtin_inff();
#pragma unroll
            for (int c = 0; c < 8; ++c) { const int n = c * 64 + lane; lg[c] = -__builtin_inff();
                if (c * 64 < nvis) { const bool ok = n < nvis; const float* kr = kc + (size_t)(ok ? n : 0) * 128; float a = 0.f;
#pragma unroll 4
                    for (int d = 0; d < 128; d += 4) { const f32x4 k4 = *(const f32x4*)(kr + d); const f32x4 q4 = *(const LAS f32x4*)(qs + d); a += k4[0] * q4[0] + k4[1] * q4[1] + k4[2] * q4[2] + k4[3] * q4[3]; }
                    if (ok) lg[c] = a * SC128; }
                mx = fmaxf(mx, lg[c]); }
            mx = wave_max(mx);
            float o0 = 0.f, o1 = 0.f;
            if (nvis > 0) {
                float p[8]; float sum = 0.f;
#pragma unroll
                for (int c = 0; c < 8; ++c) { p[c] = lg[c] > -__builtin_inff() ? __expf(lg[c] - mx) : 0.f; sum += p[c]; }
                sum = wave_sum(sum); const float inv = 1.0f / sum;
#pragma unroll
                for (int c = 0; c < 8; ++c) { p[c] *= inv; P[c] += p[c];
                    if (c * 64 < nvis) { const int lim = min(64, nvis - c * 64);
                        for (int j = 0; j < lim; ++j) { const float pj = __builtin_bit_cast(float, __builtin_amdgcn_readlane(__builtin_bit_cast(int, p[c]), j)); const float* vr = vc + (size_t)(c * 64 + j) * 128;
                            o0 += pj * vr[lane]; o1 += pj * vr[64 + lane]; } } }
            }
            float* oc = (float*)(F.ws + WS_OCMP) + ((size_t)t * 4 + h) * 128; oc[lane] = o0; oc[64 + lane] = o1;
            LDS_WAIT(); asm volatile("" ::: "memory");
        }
#pragma unroll
        for (int c = 0; c < 8; ++c) { const int n = c * 64 + lane; if (n < 511) pp[n + 1] = P[c]; }
        if (lane == 0) { pp[0] = 0.f; pp[512] = 0.f; }
        LDS_WAIT(); asm volatile("" ::: "memory");
        const int cur = t >> 6;
        float v0, v1;
        { const int b = lane; float im = 0.f;
#pragma unroll
          for (int r = 0; r < 5; ++r) im += pp[4 * b + r];
          v0 = (b > cur) ? -__builtin_inff() : ((b == 0 || b == cur || b == cur - 1) ? __builtin_inff() : im); }
        { const int b = lane + 64; float im = 0.f;
#pragma unroll
          for (int r = 0; r < 5; ++r) im += pp[4 * b + r];
          v1 = (b > cur) ? -__builtin_inff() : ((b == cur || b == cur - 1) ? __builtin_inff() : im); }
        int* sel = (int*)(F.ws + WS_NSASEL) + (size_t)t * 16; unsigned m0 = 0, m1 = 0, m2 = 0, m3 = 0;
        for (int r = 0; r < 16; ++r) { const float mx = wave_max(fmaxf(v0, v1)); int idx = -1;
            if (mx > -__builtin_inff()) { const u64 b0 = __ballot(v0 == mx), b1 = __ballot(v1 == mx);
                idx = b0 ? __builtin_ctzll(b0) : 64 + __builtin_ctzll(b1);
                if (idx < 64) { if (lane == idx) v0 = -__builtin_inff(); } else { if (lane == idx - 64) v1 = -__builtin_inff(); }
                if (idx < 32) m0 |= 1u << idx; else if (idx < 64) m1 |= 1u << (idx - 32); else if (idx < 96) m2 |= 1u << (idx - 64); else m3 |= 1u << (idx - 96); }
            if (lane == 0) sel[r] = idx; }
        if (lane == 0) { unsigned* mk = (unsigned*)(F.ws + WS_NSAMASK) + (size_t)t * 4; mk[0] = m0; mk[1] = m1; mk[2] = m2; mk[3] = m3; }
        LDS_WAIT(); asm volatile("" ::: "memory");
    }
}
__device__ __forceinline__ unsigned f2key(float f) { const unsigned u = __builtin_bit_cast(unsigned, f); return (u & 0x80000000u) ? ~u : (u | 0x80000000u); }
__device__ __forceinline__ int wave_sum_i(int v) {
#pragma unroll
    for (int o = 1; o < 64; o <<= 1) v += __shfl_xor(v, o);
    return v;
}
template <int NCH>
__device__ __forceinline__ void dsa_topk_query(unsigned char* ws, int t, int lane_in) {
    int lane = lane_in; asm volatile("" : "+v"(lane));
    const float* sc = (const float*)(ws + WS_SCORES) + (size_t)t * S + lane;
    int* list = (int*)(ws + WS_DSALIST) + (size_t)t * 256; u64* bm = (u64*)(ws + WS_DSAMASK) + (size_t)t * 128;
    unsigned u[NCH];
#pragma unroll
    for (int c = 0; c < NCH; ++c) { const bool ok = lane <= t - c * 64; const float v = ok ? sc[c * 64] : 0.f; u[c] = ok ? f2key(v) : 0u; }
    unsigned T = 1u; int need_eq = 0; bool ge = false;
    if (t >= 256) {
        T = 0u;
        for (int b = 31; b >= 0; --b) { const unsigned cand = T | (1u << b); int cnt = 0;
#pragma unroll
            for (int c = 0; c < NCH; ++c) asm volatile("v_cmp_ge_u32 vcc, %1, %2\n\tv_addc_co_u32 %0, vcc, 0, %0, vcc" : "+v"(cnt) : "v"(u[c]), "v"(cand) : "vcc");
            cnt = wave_sum_i(cnt);
            if (cnt >= 256) T = cand;
            if (cnt == 256) { ge = true; break; } }
        if (!ge) { int gt = 0;
#pragma unroll
            for (int c = 0; c < NCH; ++c) asm volatile("v_cmp_gt_u32 vcc, %1, %2\n\tv_addc_co_u32 %0, vcc, 0, %0, vcc" : "+v"(gt) : "v"(u[c]), "v"(T) : "vcc");
            need_eq = 256 - wave_sum_i(gt); }
    }
    int base = 0;
#pragma unroll
    for (int c = 0; c < NCH; ++c) {
        bool selv = ge ? (u[c] >= T) : (u[c] > T);
        if (need_eq > 0) { const u64 eq = __ballot(u[c] == T);
            if (eq) { const int rank = __builtin_popcountll(eq & ((1ull << lane) - 1ull)); selv = selv || (u[c] == T && rank < need_eq); need_eq -= min(need_eq, (int)__builtin_popcountll(eq)); } }
        const u64 sm = __ballot(selv);
        if (lane == 0) bm[c] = sm;
        if (selv) list[base + __builtin_popcountll(sm & ((1ull << lane) - 1ull))] = c * 64 + lane;
        base += __builtin_popcountll(sm);
        __builtin_amdgcn_sched_barrier(0);
    }
    for (int i = NCH + lane; i < 128; i += 64) bm[i] = 0ull;
    for (int i = base + lane; i < 256; i += 64) list[i] = -1;
}
__device__ __forceinline__ void dsa_topk_phase(Frame& F) {
    WAVE_ITEMS(t, S) {
        if (t < 2048) dsa_topk_query<32>(F.ws, t, F.lane);
        else if (t < 4096) dsa_topk_query<64>(F.ws, t, F.lane);
        else if (t < 6144) dsa_topk_query<96>(F.ws, t, F.lane);
        else dsa_topk_query<128>(F.ws, t, F.lane);
    }
}
__device__ __forceinline__ void moba_attn_phase(Frame& F) { int lane = F.lane; asm volatile("" : "+v"(lane));
    LAS float* qs = (LAS float*)(F.lds + F.wave * 16384);
    WAVE_ITEMS(it, S * 4) { const int t = it >> 2, h = it & 3, cur = t >> 8;
        const h16* K = (const h16*)(F.ws + WS_AK + (size_t)h * HEADBUF); const h16* V = (const h16*)(F.ws + WS_AV + (size_t)h * HEADBUF);
        load_q(qs, (const h16*)(F.ws + WS_AQ + (size_t)h * HEADBUF) + (size_t)t * 128, 128, lane);
        const int* sel = (const int*)(F.ws + WS_MOBASEL) + (size_t)t * 16 + h * 4;
        AttnAcc a; attn_init(a);
        for (int bi = 0; bi < 4; ++bi) { const int blk = bi == 0 ? cur : sel[bi - 1]; if (blk < 0) continue;
            for (int c = 0; c < 4; ++c) { const int s = blk * 256 + c * 64 + lane; const int key = (s <= t) ? s : -1;
                if (blk * 256 + c * 64 > t) break;
                const float lg = dot_h(qs, K + (size_t)(key < 0 ? 0 : key) * 128, 16) * SC128;
                attn_chunk(a, key, lg, V, 128, lane); } }
        store_o((h16*)(F.ws + WS_OMIX) + (size_t)t * DM + h * 128, a, lane);
        LDS_WAIT(); asm volatile("" ::: "memory"); }
}
__device__ __forceinline__ void mla_attn_phase(Frame& F) { int lane = F.lane; asm volatile("" : "+v"(lane));
    LAS float* qs = (LAS float*)(F.lds + F.wave * 16384);
    WAVE_ITEMS(it, S * 4) { const int t = it >> 2, h = it & 3;
        const h16* K = (const h16*)(F.ws + WS_KN + (size_t)h * HEADBUF); const h16* KR = (const h16*)(F.ws + WS_BKR); const h16* V = (const h16*)(F.ws + WS_BV + (size_t)h * HEADBUF);
        load_q(qs, (const h16*)(F.ws + WS_Q192) + ((size_t)h * S + t) * 192, 192, lane);
        AttnAcc a; attn_init(a);
        for (int c = 0; c * 64 <= t; ++c) { const int s = c * 64 + lane; const int key = (s <= t) ? s : -1; const int ks = key < 0 ? 0 : key;
            const float lg = (dot_h(qs, K + (size_t)ks * 128, 16) + dot_h(qs + 128, KR + (size_t)ks * 64, 8)) * SC192;
            attn_chunk(a, key, lg, V, 128, lane); }
        store_o((h16*)(F.ws + WS_OMIX) + (size_t)t * DM + 512 + h * 128, a, lane);
        LDS_WAIT(); asm volatile("" ::: "memory"); }
}
__device__ __forceinline__ void nsa_attn_phase(Frame& F) { int lane = F.lane; asm volatile("" : "+v"(lane));
    LAS float* qs = (LAS float*)(F.lds + F.wave * 16384);
    WAVE_ITEMS(it, S * 4) { const int t = it >> 2, h = it & 3, cur = t >> 6;
        load_q(qs, (const h16*)(F.ws + WS_CQROPE + (size_t)h * HEADBUF) + (size_t)t * 128, 128, lane);
        const h16* KS = (const h16*)(F.ws + WS_KSLC); const h16* VS = (const h16*)(F.ws + WS_VSLC); const h16* KW = (const h16*)(F.ws + WS_KWIN); const h16* VW = (const h16*)(F.ws + WS_VWIN);
        const int* sel = (const int*)(F.ws + WS_NSASEL) + (size_t)t * 16;
        AttnAcc a; attn_init(a);
        for (int r = 0; r < 16; ++r) { const int blk = sel[r]; if (blk < 0 || blk > cur) continue;
            const int s = blk * 64 + lane; const int key = (s <= t) ? s : -1;
            const float lg = dot_h(qs, KS + (size_t)(key < 0 ? 0 : key) * 128, 16) * SC128;
            attn_chunk(a, key, lg, VS, 128, lane); }
        AttnAcc w; attn_init(w);
        const int lo = t >= 511 ? t - 511 : 0;
        for (int c = lo >> 6; c * 64 <= t; ++c) { const int s = c * 64 + lane; const int key = (s <= t && s >= lo) ? s : -1;
            const float lg = dot_h(qs, KW + (size_t)(key < 0 ? 0 : key) * 128, 16) * SC128;
            attn_chunk(w, key, lg, VW, 128, lane); }
        const float* gl = (const float*)(F.ws + WS_SMALL) + (size_t)t * 32 + h * 3;
        const float g0 = 1.0f / (1.0f + __expf(-gl[0])), g1 = 1.0f / (1.0f + __expf(-gl[1])), g2 = 1.0f / (1.0f + __expf(-gl[2]));
        const float* oc = (const float*)(F.ws + WS_OCMP) + ((size_t)t * 4 + h) * 128 + 2 * lane;
        const float ia = a.l > 0.f ? 1.0f / a.l : 0.f, iw = w.l > 0.f ? 1.0f / w.l : 0.f;
        half2v o; o[0] = (h16)(g0 * oc[0] + g1 * a.o0 * ia + g2 * w.o0 * iw); o[1] = (h16)(g0 * oc[1] + g1 * a.o1 * ia + g2 * w.o1 * iw);
        *(half2v*)((h16*)(F.ws + WS_OMIX) + (size_t)t * DM + 1024 + h * 128 + 2 * lane) = o;
        LDS_WAIT(); asm volatile("" ::: "memory"); }
}
__device__ __forceinline__ void dsa_attn_phase(Frame& F) { int lane = F.lane; asm volatile("" : "+v"(lane));
    LAS float* qs = (LAS float*)(F.lds + F.wave * 16384);
    WAVE_ITEMS(it, S * 4) { const int t = it >> 2, h = it & 3;
        const h16* K = (const h16*)(F.ws + WS_DK + (size_t)h * HEADBUF); const h16* V = (const h16*)(F.ws + WS_DV + (size_t)h * HEADBUF);
        load_q(qs, (const h16*)(F.ws + WS_DQ + (size_t)h * HEADBUF) + (size_t)t * 128, 128, lane);
        const int* list = (const int*)(F.ws + WS_DSALIST) + (size_t)t * 256;
        AttnAcc a; attn_init(a);
        for (int c = 0; c < 4; ++c) { int key = list[c * 64 + lane]; if (key > t) key = -1;
            const float lg = dot_h(qs, K + (size_t)(key < 0 ? 0 : key) * 128, 16) * SC128;
            attn_chunk(a, key, lg, V, 128, lane); }
        store_o((h16*)(F.ws + WS_OMIX) + (size_t)t * DM + 1536 + h * 128, a, lane);
        LDS_WAIT(); asm volatile("" ::: "memory"); }
}
__device__ __forceinline__ void mem_attn_phase(Frame& F, int l) { int lane = F.lane; asm volatile("" : "+v"(lane));
    LAS float* qs = (LAS float*)(F.lds + F.wave * 16384);
    WAVE_ITEMS(it, S * 4) { const int t = it >> 2, h = it & 3;
        const h16* K = (const h16*)(F.ws + WS_MK) + (size_t)((l * 4 + h) * MEMLEN) * 128; const h16* V = (const h16*)(F.ws + WS_MV) + (size_t)((l * 4 + h) * MEMLEN) * 128;
        load_q(qs, (const h16*)(F.ws + WS_MQ + (size_t)h * HEADBUF) + (size_t)t * 128, 128, lane);
        AttnAcc a; attn_init(a);
        for (int c = 0; c < 4; ++c) { const int key = c * 64 + lane;
            const float lg = dot_h(qs, K + (size_t)key * 128, 16) * SC128;
            attn_chunk(a, key, lg, V, 128, lane); }
        store_o((h16*)(F.ws + WS_MO) + (size_t)t * 512 + h * 128, a, lane);
        LDS_WAIT(); asm volatile("" ::: "memory"); }
}
namespace fa {
typedef short s16x4 __attribute__((ext_vector_type(4)));
typedef float f32x16 __attribute__((ext_vector_type(16)));
constexpr int SHM_K = 16384, SHM_V = 16384, SHM_KR = 8192;
constexpr int OFF_V = 0, OFF_K = 2 * SHM_V, OFF_KR = OFF_K + 2 * SHM_K, OFF_WS = OFF_KR + 2 * SHM_KR, OFF_TICKET = OFF_WS + NWAVES * 96 * 4;
enum { K_MLA = 0, K_MOBA, K_SLC, K_WIN, K_DSA, K_MEM, K_CMP };
#define FA_KSWZ(row, colB) ((row) * 256 + ((colB) ^ (((row) & 7) << 4)))
#define FA_KRSWZ(row, colB) ((row) * 128 + ((colB) ^ (((row) & 7) << 4)))
#define FA_SBAR() __builtin_amdgcn_sched_barrier(0)
__device__ __forceinline__ int v_st(int k, int c) { const int kk = (k & ~0xC) | ((k & 4) << 1) | ((k & 8) >> 1); return ((kk >> 3) * 4 + (c >> 5)) * 512 + ((kk & 7) * 32 + (c & 31)) * 2; }
__device__ __forceinline__ int v_rd_base(int lane) { return ((lane & 3) << 3) | (((lane >> 2) & 3) << 6) | (((lane >> 4) & 1) << 5) | (((lane >> 5) & 1) << 8); }
constexpr int v_rd_off(int d0, int ks, int half) { return d0 * 512 + ks * 4096 + half * 2048; }
__device__ __forceinline__ int crow(int r, int hi) { return (r & 3) + 8 * (r >> 2) + 4 * hi; }
__device__ __forceinline__ unsigned cvtpk(float lo, float hi) { half2v h; h[0] = (h16)lo; h[1] = (h16)hi; return __builtin_bit_cast(unsigned, h); }

__device__ __forceinline__ void mask_tile(f32x16& p0, f32x16& p1, int dq, unsigned W) {
    const float NEG = -__builtin_inff();
#pragma unroll
    for (int r = 0; r < 16; ++r) { const int c = (r & 3) + 8 * (r >> 2);
        if ((unsigned)(dq - c) >= W) p0[r] = NEG;
        if ((unsigned)(dq - c - 32) >= W) p1[r] = NEG; }
}
__device__ __forceinline__ void mask_all(f32x16& p0, f32x16& p1, bool keep) {
    const float NEG = -__builtin_inff();
#pragma unroll
    for (int r = 0; r < 16; ++r) { p0[r] = keep ? p0[r] : NEG; p1[r] = keep ? p1[r] : NEG; }
}
__device__ __forceinline__ void mask_bits(f32x16& p0, f32x16& p1, unsigned lo, unsigned hi_w, int hi) {
    const unsigned a = lo >> (4 * hi), b = hi_w >> (4 * hi); const unsigned NEGB = 0xFF800000u;
#pragma unroll
    for (int r = 0; r < 16; ++r) { const int c = (r & 3) + 8 * (r >> 2);
        const unsigned ma = (unsigned)__builtin_amdgcn_sbfe((int)a, c, 1), mb = (unsigned)__builtin_amdgcn_sbfe((int)b, c, 1);
        const float x0 = p0[r], x1 = p1[r];
        p0[r] = __uint_as_float((__float_as_uint(x0) & ma) | (NEGB & ~ma));
        p1[r] = __uint_as_float((__float_as_uint(x1) & mb) | (NEGB & ~mb)); }
}
__device__ __forceinline__ void partialSM(f32x16& p0, f32x16& p1, float& m_reg, float& mn, float& alpha, const float sc, const float C2) {
    float pmax = p0[0];
#pragma unroll
    for (int r = 1; r < 16; ++r) pmax = fmaxf(pmax, p0[r]);
#pragma unroll
    for (int r = 0; r < 16; ++r) pmax = fmaxf(pmax, p1[r]);
    { auto rr = __builtin_amdgcn_permlane32_swap(__float_as_uint(pmax), __float_as_uint(pmax), false, false);
      pmax = fmaxf(__uint_as_float(rr[0]), __uint_as_float(rr[1])); }
    if (__builtin_expect(__all((pmax - m_reg) * sc <= 8.0f), 1)) { mn = m_reg; alpha = 1.f; }
    else { mn = fmaxf(m_reg, pmax); alpha = __builtin_amdgcn_exp2f((m_reg - mn) * C2); m_reg = mn; }
    const float mnL = -mn * C2;
#pragma unroll
    for (int r = 0; r < 16; ++r) p0[r] = __builtin_amdgcn_exp2f(fmaf(p0[r], C2, mnL));
#pragma unroll
    for (int r = 0; r < 16; ++r) p1[r] = __builtin_amdgcn_exp2f(fmaf(p1[r], C2, mnL));
}
__device__ __forceinline__ void finishSM(const f32x16& p0, const f32x16& p1, float alpha, float& l_reg, half8& pa0, half8& pa1, half8& pa2, half8& pa3) {
    float ps = 0;
#pragma unroll
    for (int r = 0; r < 16; ++r) ps += p0[r];
#pragma unroll
    for (int r = 0; r < 16; ++r) ps += p1[r];
    { auto rr = __builtin_amdgcn_permlane32_swap(__float_as_uint(ps), __float_as_uint(ps), false, false);
      ps = __uint_as_float(rr[0]) + __uint_as_float(rr[1]); }
    l_reg = l_reg * alpha + ps;
#define FA_PK4(P, B_, OUT) do { unsigned a0 = cvtpk(P[B_ + 0], P[B_ + 1]), a1 = cvtpk(P[B_ + 2], P[B_ + 3]); unsigned b0 = cvtpk(P[B_ + 4], P[B_ + 5]), b1 = cvtpk(P[B_ + 6], P[B_ + 7]); \
        auto r0 = __builtin_amdgcn_permlane32_swap(a0, b0, false, false); auto r1 = __builtin_amdgcn_permlane32_swap(a1, b1, false, false); \
        u32x4 w = {r0[0], r1[0], r0[1], r1[1]}; OUT = __builtin_bit_cast(half8, w); } while (0)
    FA_PK4(p0, 0, pa0); FA_PK4(p0, 8, pa1); FA_PK4(p1, 0, pa2); FA_PK4(p1, 8, pa3);
#undef FA_PK4
}
template <bool MLA>
__device__ __forceinline__ void qkt(f32x16& p0, f32x16& p1, const LAS char* lds, int kboff, int kroff, int r32, int hi, const half8* qr, bool act) {
    if (!act) { const float NEG = -__builtin_inff();
#pragma unroll
        for (int r = 0; r < 16; ++r) { p0[r] = NEG; p1[r] = NEG; } return; }
#pragma unroll
    for (int r = 0; r < 16; ++r) { p0[r] = 0.f; p1[r] = 0.f; }
    const LAS char* kb[4];
#pragma unroll
    for (int dd = 0; dd < 4; ++dd) kb[dd] = lds + OFF_K + kboff + FA_KSWZ(r32, (dd * 16 + hi * 8) * 2);
#pragma unroll
    for (int d0 = 0; d0 < 8; ++d0) { const LAS char* a = kb[d0 & 3] + (d0 >> 2) * 128;
        const half8 b0 = *(const LAS half8*)a; const half8 b1 = *(const LAS half8*)(a + 32 * 256);
        p0 = __builtin_amdgcn_mfma_f32_32x32x16_f16(b0, qr[d0], p0, 0, 0, 0);
        p1 = __builtin_amdgcn_mfma_f32_32x32x16_f16(b1, qr[d0], p1, 0, 0, 0); }
    if constexpr (MLA) {
#pragma unroll
        for (int d0 = 0; d0 < 4; ++d0) { const LAS char* a = lds + OFF_KR + kroff + FA_KRSWZ(r32, (d0 * 16 + hi * 8) * 2);
            const half8 b0 = *(const LAS half8*)a; const half8 b1 = *(const LAS half8*)(a + 32 * 128);
            p0 = __builtin_amdgcn_mfma_f32_32x32x16_f16(b0, qr[8 + d0], p0, 0, 0, 0);
            p1 = __builtin_amdgcn_mfma_f32_32x32x16_f16(b1, qr[8 + d0], p1, 0, 0, 0); }
    }
}
__device__ __forceinline__ void pv_tile(f32x16* o, int vb0, half8 pa0, half8 pa1, half8 pa2, half8 pa3, bool act) {
    if (!act) return;
#define FA_TRRD(dst, off) asm volatile("ds_read_b64_tr_b16 %0, %1 offset:%2" : "=&v"(dst) : "v"(vb0), "i"(off) : "memory")
#define FA_H8(l, h) __builtin_bit_cast(half8, (short __attribute__((ext_vector_type(8)))){l[0], l[1], l[2], l[3], h[0], h[1], h[2], h[3]})
#define FA_PV_D0(d0) do { s16x4 l0, l1, l2, l3, h0, h1, h2, h3; constexpr int b_ = v_rd_off(d0, 0, 0); \
        FA_TRRD(l0, b_); FA_TRRD(h0, b_ + 2048); FA_TRRD(l1, b_ + 4096); FA_TRRD(h1, b_ + 6144); FA_TRRD(l2, b_ + 8192); FA_TRRD(h2, b_ + 10240); FA_TRRD(l3, b_ + 12288); FA_TRRD(h3, b_ + 14336); \
        asm volatile("s_waitcnt lgkmcnt(0)" ::: "memory"); FA_SBAR(); \
        o[d0] = __builtin_amdgcn_mfma_f32_32x32x16_f16(pa0, FA_H8(l0, h0), o[d0], 0, 0, 0); \
        o[d0] = __builtin_amdgcn_mfma_f32_32x32x16_f16(pa1, FA_H8(l1, h1), o[d0], 0, 0, 0); \
        o[d0] = __builtin_amdgcn_mfma_f32_32x32x16_f16(pa2, FA_H8(l2, h2), o[d0], 0, 0, 0); \
        o[d0] = __builtin_amdgcn_mfma_f32_32x32x16_f16(pa3, FA_H8(l3, h3), o[d0], 0, 0, 0); } while (0)
    FA_PV_D0(0); FA_PV_D0(1); FA_PV_D0(2); FA_PV_D0(3);
#undef FA_PV_D0
#undef FA_H8
#undef FA_TRRD
}
struct UnitArgs {
    const h16* Q; int qld;
    const h16* K; const h16* KR; const h16* V;
    h16* O; int old;
    int P0, j_lo, j_hi;
    const void* mk;
    const float* gate; int gidx;
    const float* ocmp;
    int epi;
};
template <int KIND>
__device__ __forceinline__ void run_unit(LAS char* lds, const UnitArgs& U, int tid_in) {
    constexpr bool MLA = KIND == K_MLA;
    int tid = tid_in; asm volatile("" : "+v"(tid));
    const int wid = __builtin_amdgcn_readfirstlane(tid >> 6), lane = tid & 63, r32 = lane & 31, hi = lane >> 5;
    const int sr = tid >> 4, sc = (tid & 15) * 8;
    const int qlo = U.P0 + wid * 32, rowpos = qlo + r32;
    const float sc_ = MLA ? SC192 : SC128; const float C2 = 1.4426950408889634f * sc_;
    LAS float* wsf = (LAS float*)(lds + OFF_WS) + wid * 96; LAS float* li_l = wsf; LAS float* al_l = wsf + 32; LAS float* g_l = wsf + 64;
    half8 qr[MLA ? 12 : 8];
    { const h16* qp = U.Q + (size_t)(wid * 32 + r32) * U.qld + hi * 8;
#pragma unroll
      for (int d0 = 0; d0 < (MLA ? 12 : 8); ++d0) qr[d0] = *(const half8*)(qp + d0 * 16); }
    unsigned mb0 = 0, mb1 = 0, mb2 = 0, mb3 = 0;
    if constexpr (KIND == K_MOBA) { const int* s = (const int*)U.mk + (size_t)rowpos * 16;
#pragma unroll
        for (int i = 0; i < 3; ++i) { const int b = s[i]; if (b >= 0) mb0 |= 1u << b; } }
    if constexpr (KIND == K_SLC) { const u32x4 m = *(const u32x4*)((const unsigned*)U.mk + (size_t)rowpos * 4); mb0 = m[0]; mb1 = m[1]; mb2 = m[2]; mb3 = m[3]; }
    const int nvis_row = rowpos >= 31 ? ((rowpos - 31) >> 4) + 1 : 0;
    const int NT = U.j_hi - U.j_lo;
    half8 st_k0, st_k1, st_v0, st_v1, st_kr; unsigned dm_lo = 0, dm_hi = 0, dn_lo = 0, dn_hi = 0;
    const int kws = FA_KSWZ(sr, sc * 2), vst0 = v_st(sr, sc), vst1 = v_st(32 + sr, sc), krw = FA_KRSWZ(tid >> 3, (tid & 7) * 16);
    const int vb0 = (int)(unsigned)(size_t)(lds + OFF_V) + v_rd_base(lane);
#define FA_LOADT(j) do { const int k0_ = (j) * 64; st_k0 = *(const half8*)(U.K + (size_t)(k0_ + sr) * 128 + sc); st_k1 = *(const half8*)(U.K + (size_t)(k0_ + 32 + sr) * 128 + sc); \
        st_v0 = *(const half8*)(U.V + (size_t)(k0_ + sr) * 128 + sc); st_v1 = *(const half8*)(U.V + (size_t)(k0_ + 32 + sr) * 128 + sc); \
        if constexpr (MLA) st_kr = *(const half8*)(U.KR + (size_t)(k0_ + (tid >> 3)) * 64 + (tid & 7) * 8); \
        if constexpr (KIND == K_DSA) { const unsigned long long w_ = ((const unsigned long long*)U.mk)[(size_t)rowpos * 128 + (j)]; dn_lo = (unsigned)w_; dn_hi = (unsigned)(w_ >> 32); } } while (0)
#define FA_WRITET(bf) do { *(LAS half8*)(lds + OFF_K + (bf) * SHM_K + kws) = st_k0; *(LAS half8*)(lds + OFF_K + (bf) * SHM_K + kws + 32 * 256) = st_k1; \
        *(LAS half8*)(lds + OFF_V + (bf) * SHM_V + vst0) = st_v0; *(LAS half8*)(lds + OFF_V + (bf) * SHM_V + vst1) = st_v1; \
        if constexpr (MLA) *(LAS half8*)(lds + OFF_KR + (bf) * SHM_KR + krw) = st_kr; } while (0)
    float m_reg = -1e30f, l_reg = 0.f; f32x16 o[4];
#pragma unroll
    for (int d = 0; d < 4; ++d)
#pragma unroll
        for (int r = 0; r < 16; ++r) o[d][r] = 0.f;
    FA_LOADT(U.j_lo); asm volatile("s_waitcnt vmcnt(0)" ::: "memory"); FA_WRITET(0); dm_lo = dn_lo; dm_hi = dn_hi;
    __syncthreads();
    f32x16 pA0, pA1; float mnA, alA; half8 pa0, pa1, pa2, pa3;
#define FA_STEP(t) do { const int kb_ = (U.j_lo + (t)) * 64; int bsel_ = (t) & 1; asm volatile("" : "+v"(bsel_)); \
        bool act_ = kb_ <= qlo + 31; if constexpr (KIND == K_WIN) act_ = act_ && (kb_ + 63 >= qlo - 511); if constexpr (KIND == K_MEM) act_ = true; if constexpr (KIND == K_CMP) act_ = kb_ < (qlo >> 4) + 1; \
        qkt<MLA>(pA0, pA1, lds, bsel_ * SHM_K, bsel_ * SHM_KR, r32, hi, qr, act_); \
        if (act_) { \
            if constexpr (KIND == K_MLA) { if (kb_ + 63 > qlo) mask_tile(pA0, pA1, rowpos - kb_ - 4 * hi, 0x40000000u); } \
            if constexpr (KIND == K_WIN) { if (kb_ + 63 > qlo || kb_ <= qlo + 31 - 512) mask_tile(pA0, pA1, rowpos - kb_ - 4 * hi, 512u); } \
            if constexpr (KIND == K_MOBA) { const int blk_ = kb_ >> 8; if (blk_ == (U.P0 >> 8)) { if (kb_ + 63 > qlo) mask_tile(pA0, pA1, rowpos - kb_ - 4 * hi, 0x40000000u); } else mask_all(pA0, pA1, (mb0 >> blk_) & 1u); } \
            if constexpr (KIND == K_SLC) { const int b_ = kb_ >> 6; const unsigned w_ = (b_ < 32) ? mb0 : (b_ < 64) ? mb1 : (b_ < 96) ? mb2 : mb3; mask_all(pA0, pA1, (w_ >> (b_ & 31)) & 1u); \
                if (kb_ + 63 > qlo) mask_tile(pA0, pA1, rowpos - kb_ - 4 * hi, 0x40000000u); } \
            if constexpr (KIND == K_DSA) mask_bits(pA0, pA1, dm_lo, dm_hi, hi); \
            if constexpr (KIND == K_CMP) mask_tile(pA0, pA1, nvis_row - 1 - kb_ - 4 * hi, 0x40000000u); \
            partialSM(pA0, pA1, m_reg, mnA, alA, sc_, C2); \
            if (__any(alA < 1.f)) { if (hi == 0) al_l[r32] = alA; asm volatile("s_waitcnt lgkmcnt(0)" ::: "memory"); \
                _Pragma("unroll") for (int d_ = 0; d_ < 4; ++d_) _Pragma("unroll") for (int r = 0; r < 16; ++r) o[d_][r] *= al_l[crow(r, hi)]; } \
            finishSM(pA0, pA1, alA, l_reg, pa0, pa1, pa2, pa3); FA_SBAR(); \
            pv_tile(o, vb0 + bsel_ * SHM_V, pa0, pa1, pa2, pa3, true); } } while (0)
    for (int t = 0; t < NT; ++t) {
        if (t + 1 < NT) FA_LOADT(U.j_lo + t + 1);
        FA_SBAR();
        FA_STEP(t);
        FA_SBAR();
        if (t + 1 < NT) { asm volatile("s_waitcnt vmcnt(0)" ::: "memory"); FA_WRITET((t + 1) & 1); dm_lo = dn_lo; dm_hi = dn_hi; }
        __syncthreads();
    }
    float rs = l_reg > 0.f ? 1.0f / l_reg : 0.f;
    if (U.epi != 0) { const float gl = U.gate[(size_t)rowpos * 32 + U.gidx]; rs *= 1.0f / (1.0f + __expf(-gl));
        if (U.epi == 1) { const float g0 = U.gate[(size_t)rowpos * 32 + U.gidx - 1]; if (hi == 0) g_l[r32] = 1.0f / (1.0f + __expf(-g0)); } }
    if (hi == 0) li_l[r32] = rs;
    asm volatile("s_waitcnt lgkmcnt(0)" ::: "memory");
#pragma unroll
    for (int r = 0; r < 16; ++r) { const int orow = wid * 32 + crow(r, hi); const float rli = li_l[crow(r, hi)]; const float g0 = (U.epi == 1) ? g_l[crow(r, hi)] : 0.f;
#pragma unroll
        for (int d0 = 0; d0 < 4; ++d0) { float v = o[d0][r] * rli;
            if (U.epi == 1) v += g0 * U.ocmp[(size_t)(U.P0 + orow) * 512 + d0 * 32 + r32];
            const float vn = __shfl_xor(v, 1);
            if ((r32 & 1) == 0) { unsigned* op = (unsigned*)(U.O + (size_t)orow * U.old + d0 * 32 + r32);
                if (U.epi == 2) { const half2v pv = __builtin_bit_cast(half2v, *op); *op = cvtpk(v + (float)pv[0], vn + (float)pv[1]); }
                else *op = cvtpk(v, vn); } } }
    __syncthreads();
#undef FA_LOADT
#undef FA_WRITET
#undef FA_STEP
}
}

namespace dsx {
constexpr int IK_STAGE = 256;
__device__ __forceinline__ void score_phase(Frame& F) {
    int lane = F.lane; asm volatile("" : "+v"(lane));
    LAS char* lds = (LAS char*)F.lds; unsigned char* ws = F.ws;
    const int wid = F.wave, r32 = lane & 31, hi = lane >> 5;
    const int tid = wid * 64 + lane;
    for (int n = blockIdx.x; n < 1152; n += F.G) {
        int g = 0;
#pragma unroll
        for (int k = 1; k < 8; ++k) if (n >= 16 * k * (k + 1)) g = k;
        const int r = n - 16 * g * (g + 1), qt = 32 * g + r / (g + 1), kc = r % (g + 1);
        const int t0 = 32 * qt + 4 * wid;
        const int kend = min(kc * 1024 + 1024, 32 * qt + 32);
        half8 a[2][4]; float wv[2][16];
#pragma unroll
        for (int tl = 0; tl < 2; ++tl) { const int t = t0 + 2 * tl + (r32 >> 4); const h16* iq = (const h16*)(ws + WS_IQ) + (size_t)t * 1024 + (r32 & 15) * 64 + hi * 8;
#pragma unroll
            for (int d0 = 0; d0 < 4; ++d0) a[tl][d0] = *(const half8*)(iq + d0 * 16);
#pragma unroll
            for (int rr = 0; rr < 16; ++rr) { const int head = (rr & 3) + 8 * ((rr >> 2) & 1) + 4 * hi; wv[tl][rr] = ((const float*)(ws + WS_SMALL))[(size_t)(t0 + 2 * tl + (rr >> 3)) * 32 + 12 + head] * (0.25f * 0.125f); } }
        for (int ks = kc * 1024; ks < kend; ks += IK_STAGE) {
            const int nk = min(IK_STAGE, kend - ks);
            __syncthreads();
#pragma unroll
            for (int i = 0; i < 4; ++i) { const int idx = tid + 512 * i, row = idx >> 3, ch = idx & 7;
                if (row < nk) { const half8 v = *(const half8*)((const h16*)(ws + WS_IK) + (size_t)(ks + row) * 64 + ch * 8); *(LAS half8*)(lds + row * 128 + ((ch * 16) ^ ((row & 7) << 4))) = v; } }
            __syncthreads();
            for (int sub = 0; sub < nk; sub += 32) {
                const int row = sub + r32; half8 b[4];
#pragma unroll
                for (int d0 = 0; d0 < 4; ++d0) b[d0] = *(const LAS half8*)(lds + row * 128 + (((d0 * 2 + hi) * 16) ^ ((row & 7) << 4)));
#pragma unroll
                for (int tl = 0; tl < 2; ++tl) {
                    fa::f32x16 c;
#pragma unroll
                    for (int rr = 0; rr < 16; ++rr) c[rr] = 0.f;
#pragma unroll
                    for (int d0 = 0; d0 < 4; ++d0) c = __builtin_amdgcn_mfma_f32_32x32x16_f16(a[tl][d0], b[d0], c, 0, 0, 0);
                    float s0 = 0.f, s1 = 0.f;
#pragma unroll
                    for (int rr = 0; rr < 8; ++rr) { s0 += wv[tl][rr] * fmaxf(c[rr], 0.f); s1 += wv[tl][8 + rr] * fmaxf(c[8 + rr], 0.f); }
                    auto sw = __builtin_amdgcn_permlane32_swap(__float_as_uint(s0), __float_as_uint(s1), false, false);
                    const float tot = __uint_as_float(sw[0]) + __uint_as_float(sw[1]);
                    ((float*)(ws + WS_SCORES))[(size_t)(t0 + 2 * tl + hi) * S + ks + sub + r32] = tot;
                }
            }
        }
    }
    __syncthreads();
}
}

namespace nsx {
__device__ __forceinline__ void mask16(fa::f32x16& p, int dq) {
    const float NEG = -__builtin_inff();
#pragma unroll
    for (int r = 0; r < 16; ++r) { const int c = (r & 3) + 8 * (r >> 2); if (dq - c < 0) p[r] = NEG; }
}
__device__ __forceinline__ void imp_select_pair(unsigned char* ws, LAS float* uL, int unit, int sub  , int lane_in) {
    int lane = lane_in; asm volatile("" : "+v"(lane));
    const bool live = unit >= 0;
    const int r32 = lane & 31, hi = lane >> 5, t0 = (live ? unit : 0) * 32, row = t0 + r32;
    const int nvis = row >= 31 ? ((row - 31) >> 4) + 1 : 0;
    const int NHT = (((t0 >> 4) + 1) + 31) >> 5, hA = (NHT + 1) >> 1;
    const int h_lo = sub ? hA : 0, h_hi = live ? (sub ? NHT : hA) : 0;
    const float C2 = 1.4426950408889634f * SC128;
    const h16* kc = (const h16*)(ws + WS_KC16);
    LAS float* impL = uL; LAS float* stL = uL + 64 * 64; LAS float* carL = stL + 2 * 8 * 64;
    half8 qf[4][8];
    if (live) {
#pragma unroll
        for (int h = 0; h < 4; ++h) { const h16* qp = (const h16*)(ws + WS_CQRAW + (size_t)h * HEADBUF) + (size_t)row * 128 + hi * 8;
#pragma unroll
            for (int d0 = 0; d0 < 8; ++d0) qf[h][d0] = *(const half8*)(qp + d0 * 16); }
    }
    float m[4], l[4];
#pragma unroll
    for (int h = 0; h < 4; ++h) { m[h] = -1e30f; l[h] = 0.f; }
    fa::f32x16 p; half8 kf[8];
#define NSX_LOADK(ht) do { const h16* kp_ = kc + (size_t)((ht) * 32 + r32) * 128 + hi * 8; _Pragma("unroll") for (int d0 = 0; d0 < 8; ++d0) kf[d0] = *(const half8*)(kp_ + d0 * 16); } while (0)
#define NSX_QK(h) do { _Pragma("unroll") for (int r = 0; r < 16; ++r) p[r] = 0.f; \
        _Pragma("unroll") for (int d0 = 0; d0 < 8; ++d0) p = __builtin_amdgcn_mfma_f32_32x32x16_f16(kf[d0], qf[h][d0], p, 0, 0, 0); } while (0)
    for (int ht = h_lo; ht < h_hi; ++ht) {
        NSX_LOADK(ht);
#pragma unroll
        for (int h = 0; h < 4; ++h) {
            NSX_QK(h);
            mask16(p, nvis - 1 - ht * 32 - 4 * hi);
            float pmax = p[0];
#pragma unroll
            for (int r = 1; r < 16; ++r) pmax = fmaxf(pmax, p[r]);
            { auto rr = __builtin_amdgcn_permlane32_swap(__float_as_uint(pmax), __float_as_uint(pmax), false, false); pmax = fmaxf(__uint_as_float(rr[0]), __uint_as_float(rr[1])); }
            const float mn = fmaxf(m[h], pmax), al = __builtin_amdgcn_exp2f((m[h] - mn) * C2), mnL = -mn * C2;
            float ps = 0.f;
#pragma unroll
            for (int r = 0; r < 16; ++r) ps += __builtin_amdgcn_exp2f(fmaf(p[r], C2, mnL));
            { auto rr = __builtin_amdgcn_permlane32_swap(__float_as_uint(ps), __float_as_uint(ps), false, false); ps = __uint_as_float(rr[0]) + __uint_as_float(rr[1]); }
            l[h] = l[h] * al + ps; m[h] = mn;
        }
    }
    if (live) {
#pragma unroll
        for (int h = 0; h < 4; ++h) { stL[(sub * 8 + h) * 64 + lane] = m[h]; stL[(sub * 8 + 4 + h) * 64 + lane] = l[h]; }
#pragma unroll
        for (int i = 0; i < 32; ++i) impL[(32 * sub + i) * 64 + lane] = 0.f;
        if (sub == 0) carL[lane] = 0.f;
    }
    __syncthreads();
    float mL[4], il[4];
#pragma unroll
    for (int h = 0; h < 4; ++h) { const float ma = stL[h * 64 + lane], la = stL[(4 + h) * 64 + lane], mb = stL[(8 + h) * 64 + lane], lb = stL[(12 + h) * 64 + lane];
        const float mm = fmaxf(ma, mb), ll = la * __builtin_amdgcn_exp2f((ma - mm) * C2) + lb * __builtin_amdgcn_exp2f((mb - mm) * C2);
        mL[h] = -mm * C2; il[h] = ll > 0.f ? 1.0f / ll : 0.f; }
    float carry = 0.f;
    for (int ht = h_lo; ht < h_hi; ++ht) {
        NSX_LOADK(ht);
        float G[4], L[4];
#pragma unroll
        for (int g = 0; g < 4; ++g) { G[g] = 0.f; L[g] = 0.f; }
#pragma unroll
        for (int h = 0; h < 4; ++h) {
            NSX_QK(h);
            mask16(p, nvis - 1 - ht * 32 - 4 * hi);
#pragma unroll
            for (int g = 0; g < 4; ++g) {
                const float a0 = __builtin_amdgcn_exp2f(fmaf(p[4 * g], C2, mL[h])), a1 = __builtin_amdgcn_exp2f(fmaf(p[4 * g + 1], C2, mL[h])), a2 = __builtin_amdgcn_exp2f(fmaf(p[4 * g + 2], C2, mL[h])), a3 = __builtin_amdgcn_exp2f(fmaf(p[4 * g + 3], C2, mL[h]));
                G[g] += ((a0 + a1) + (a2 + a3)) * il[h]; L[g] += a3 * il[h];
            }
        }
#pragma unroll
        for (int g = 0; g < 4; ++g) {
            const float A = g == 0 ? carry : L[g - 1], B = L[g];
            auto rr = __builtin_amdgcn_permlane32_swap(__float_as_uint(A), __float_as_uint(B), false, false);
            const float prev = hi ? __uint_as_float(rr[0]) : __uint_as_float(rr[1]);
            impL[(4 * ht + g) * 64 + lane] = G[g] + prev;
        }
        carry = L[3];
    }
#undef NSX_LOADK
#undef NSX_QK
    if (live && sub == 0) carL[lane] = carry;
    __syncthreads();
    if (!live || sub != 0) return;
    const int cur = row >> 6;
    const float cA = (hi == 0 && hA < NHT) ? carL[lane + 32] : 0.f;
    unsigned key[64];
#pragma unroll
    for (int i = 0; i < 64; ++i) { const int b = 8 * (i >> 2) + 2 * (i & 3) + hi;
        float iv = impL[i * 64 + lane]; if (i == 4 * hA) iv += cA;
        const unsigned vb = (__float_as_uint(iv) & 0xFFFFFF80u) | (unsigned)(127 - b);
        const bool forced = (b == 0) || (b == cur) || (b == cur - 1);
        key[i] = b > cur ? 0u : (forced ? (0x7F800000u | (unsigned)(127 - b)) : vb); }
    unsigned prev = 0xFFFFFFFFu, m0 = 0u, m1 = 0u, m2 = 0u, m3 = 0u;
    for (int rnd = 0; rnd < 16; ++rnd) {
        unsigned best = 0u;
#pragma unroll
        for (int i = 0; i < 64; ++i) { const unsigned c = key[i] < prev ? key[i] : 0u; best = best > c ? best : c; }
        { auto rr = __builtin_amdgcn_permlane32_swap(best, best, false, false); best = rr[0] > rr[1] ? rr[0] : rr[1]; }
        if (best != 0u) { const unsigned b = 127u - (best & 127u), bit = 1u << (b & 31u);
            m0 |= (b < 32u) ? bit : 0u; m1 |= (b >= 32u && b < 64u) ? bit : 0u; m2 |= (b >= 64u && b < 96u) ? bit : 0u; m3 |= (b >= 96u) ? bit : 0u; }
        prev = best;
    }
    if (hi == 0) { u32x4 mk = {m0, m1, m2, m3}; *(u32x4*)((unsigned*)(ws + WS_NSAMASK) + (size_t)row * 4) = mk; }
}
}

__device__ __forceinline__ void moba_gate_mfma_phase(Frame& F) { int lane = F.lane; asm volatile("" : "+v"(lane));
    const int r32 = lane & 31, hi = lane >> 5; unsigned char* ws = F.ws;
    WAVE_ITEMS(it, 4 * 256) { const int h = it >> 8, t0 = (it & 255) * 32, row = t0 + r32, cur = t0 >> 8;
        int* sel = (int*)(ws + WS_MOBASEL) + (size_t)row * 16 + h * 4;
        if (cur == 0) { if (hi == 0) { sel[0] = -1; sel[1] = -1; sel[2] = -1; } continue; }
        const h16* qp = (const h16*)(ws + WS_AQ + (size_t)h * HEADBUF) + (size_t)row * 128 + hi * 8;
        const h16* kh = (const h16*)(ws + WS_KMH) + (size_t)(h * 32 + r32) * 128 + hi * 8; const h16* kl = (const h16*)(ws + WS_KML) + (size_t)(h * 32 + r32) * 128 + hi * 8;
        fa::f32x16 c;
#pragma unroll
        for (int r = 0; r < 16; ++r) c[r] = 0.f;
#pragma unroll
        for (int d0 = 0; d0 < 8; ++d0) { const half8 q = *(const half8*)(qp + d0 * 16);
            c = __builtin_amdgcn_mfma_f32_32x32x16_f16(*(const half8*)(kh + d0 * 16), q, c, 0, 0, 0);
            c = __builtin_amdgcn_mfma_f32_32x32x16_f16(*(const half8*)(kl + d0 * 16), q, c, 0, 0, 0); }
        unsigned key[16];
#pragma unroll
        for (int r = 0; r < 16; ++r) { const int n = fa::crow(r, hi); const float v = c[r]; key[r] = n < cur ? ((f2key(v) & ~31u) | (unsigned)(31 - n)) : 0u; }
        unsigned prev = 0xFFFFFFFFu;
#pragma unroll
        for (int rnd = 0; rnd < 3; ++rnd) { unsigned best = 0u;
#pragma unroll
            for (int r = 0; r < 16; ++r) { const unsigned x = key[r] < prev ? key[r] : 0u; best = best > x ? best : x; }
            { auto rr = __builtin_amdgcn_permlane32_swap(best, best, false, false); best = rr[0] > rr[1] ? rr[0] : rr[1]; }
            if (hi == 0) sel[rnd] = best ? 31 - (int)(best & 31u) : -1;
            prev = best; }
    }
}

constexpr int CW_QUEUE = 8192;
__device__ __forceinline__ int fa_ticket(Frame& F, unsigned* head) {
    LAS int* tk = (LAS int*)(F.lds + fa::OFF_TICKET);
    if (F.tid == 0) *tk = (int)__hip_atomic_fetch_add(head, 1u, __ATOMIC_RELAXED, __HIP_MEMORY_SCOPE_AGENT);
    __syncthreads();
    const int u = *tk;
    __syncthreads();
    return u;
}
__device__ __forceinline__ void fa_mixer_phase(Frame& F, int l) {
    LAS char* lds = (LAS char*)F.lds; unsigned char* ws = F.ws;
    for (;;) {
        const int u = fa_ticket(F, F.ctl + CW_QUEUE + 64 * l);
        if (u >= 512) break;
        const int qb = 31 - (u >> 4), type = (u >> 2) & 3, h = u & 3, P0 = qb * 256;
        if (!((FA_MASK >> type) & 1)) continue;
        fa::UnitArgs U; U.P0 = P0; U.j_lo = 0; U.j_hi = (P0 + 255) / 64 + 1; U.KR = nullptr; U.mk = nullptr; U.gate = nullptr; U.gidx = 0; U.ocmp = nullptr; U.epi = 0; U.old = DM;
        if (type == 0) {
            U.Q = (const h16*)(ws + WS_Q192) + ((size_t)h * S + P0) * 192; U.qld = 192; U.K = (const h16*)(ws + WS_KN + (size_t)h * HEADBUF); U.KR = (const h16*)(ws + WS_BKR); U.V = (const h16*)(ws + WS_BV + (size_t)h * HEADBUF);
            U.O = (h16*)(ws + WS_OMIX) + (size_t)P0 * DM + 512 + h * 128;
            fa::run_unit<fa::K_MLA>(lds, U, F.tid);
        } else if (type == 1) {
            U.Q = (const h16*)(ws + WS_CQROPE + (size_t)h * HEADBUF) + (size_t)P0 * 128; U.qld = 128; U.K = (const h16*)(ws + WS_KSLC); U.V = (const h16*)(ws + WS_VSLC);
            U.O = (h16*)(ws + WS_OMIX) + (size_t)P0 * DM + 1024 + h * 128; U.mk = ws + WS_NSAMASK; U.gate = (const float*)(ws + WS_SMALL); U.gidx = h * 3 + 1; U.epi = 2;
            fa::run_unit<fa::K_SLC>(lds, U, F.tid);
            U.K = (const h16*)(ws + WS_KWIN); U.V = (const h16*)(ws + WS_VWIN); U.j_lo = P0 >= 511 ? (P0 - 511) / 64 : 0; U.gidx = h * 3 + 2; U.epi = 2;
            fa::run_unit<fa::K_WIN>(lds, U, F.tid);
        } else if (type == 2) {
            U.Q = (const h16*)(ws + WS_AQ + (size_t)h * HEADBUF) + (size_t)P0 * 128; U.qld = 128; U.K = (const h16*)(ws + WS_AK + (size_t)h * HEADBUF); U.V = (const h16*)(ws + WS_AV + (size_t)h * HEADBUF);
            U.O = (h16*)(ws + WS_OMIX) + (size_t)P0 * DM + h * 128; U.mk = (const int*)(ws + WS_MOBASEL) + h * 4;
            fa::run_unit<fa::K_MOBA>(lds, U, F.tid);
        } else {
            U.Q = (const h16*)(ws + WS_DQ + (size_t)h * HEADBUF) + (size_t)P0 * 128; U.qld = 128; U.K = (const h16*)(ws + WS_DK + (size_t)h * HEADBUF); U.V = (const h16*)(ws + WS_DV + (size_t)h * HEADBUF);
            U.O = (h16*)(ws + WS_OMIX) + (size_t)P0 * DM + 1536 + h * 128; U.mk = ws + WS_DSAMASK;
            fa::run_unit<fa::K_DSA>(lds, U, F.tid);
        }
    }
}
__device__ __forceinline__ void fa_cmp_phase(Frame& F) {
    LAS char* lds = (LAS char*)F.lds; unsigned char* ws = F.ws;
    for (int u = blockIdx.x; u < 128; u += F.G) {
        const int qb = 31 - (u >> 2), h = u & 3, P0 = qb * 256;
        fa::UnitArgs U; U.P0 = P0; U.j_lo = 0; U.j_hi = ((((P0 + 224) >> 4) + 1) + 63) >> 6; U.KR = nullptr; U.mk = nullptr; U.ocmp = nullptr; U.old = DM;
        U.Q = (const h16*)(ws + WS_CQRAW + (size_t)h * HEADBUF) + (size_t)P0 * 128; U.qld = 128; U.K = (const h16*)(ws + WS_KC16); U.V = (const h16*)(ws + WS_VC16);
        U.O = (h16*)(ws + WS_OMIX) + (size_t)P0 * DM + 1024 + h * 128; U.gate = (const float*)(ws + WS_SMALL); U.gidx = h * 3; U.epi = 3;
        fa::run_unit<fa::K_CMP>(lds, U, F.tid);
    }
}
__device__ __forceinline__ void nsa_imp_phase(Frame& F) {
    const int G = F.G, first = G >= 192 ? 128 : 0, nb = G >= 192 ? 64 : G;
    const int bi = (int)blockIdx.x - first;
    if (bi < 0 || bi >= nb) return;
    for (int u0 = bi * 4; u0 < 256; u0 += nb * 4) {
        const int pair = F.wave >> 1, unit = u0 + pair;
        nsx::imp_select_pair(F.ws, (LAS float*)F.lds + pair * 5376, unit < 256 ? unit : -1, F.wave & 1, F.lane);
        __syncthreads();
    }
}
__device__ __forceinline__ void fa_mem_phase(Frame& F, int l) {
    LAS char* lds = (LAS char*)F.lds; unsigned char* ws = F.ws;
    for (int u = blockIdx.x; u < 128; u += F.G) {
        const int qb = u >> 2, h = u & 3, P0 = qb * 256;
        fa::UnitArgs U; U.P0 = P0; U.j_lo = 0; U.j_hi = 4; U.KR = nullptr; U.mk = nullptr; U.gate = nullptr; U.gidx = 0; U.ocmp = nullptr; U.epi = 0;
        U.Q = (const h16*)(ws + WS_MQ + (size_t)h * HEADBUF) + (size_t)P0 * 128; U.qld = 128;
        U.K = (const h16*)(ws + WS_MK) + (size_t)((l * 4 + h) * MEMLEN) * 128; U.V = (const h16*)(ws + WS_MV) + (size_t)((l * 4 + h) * MEMLEN) * 128;
        U.O = (h16*)(ws + WS_MO) + (size_t)P0 * 512 + h * 128; U.old = 512;
        fa::run_unit<fa::K_MEM>(lds, U, F.tid);
    }
}

enum { PHB_P0, PHB_KMEAN, PHB_CMP2, PHB_GATE, PHB_SCORE, PHB_CMPSEL, PHB_TOPK, PHB_MOBA, PHB_MLA, PHB_NSA, PHB_DSA, PHB_MEMA, PHB_LN, PHB_GMKV, PHB_GSWIGLU, PHB_GWIN, PHB_GUQ, PHB_GUKV, PHB_GY, PHB_GMQ, PHB_GRESID };
#ifndef SKIPMASK
#define SKIPMASK 0u
#endif
constexpr int SLOTS = 7, NSTEPS = 2 + 16 * SLOTS;
struct Args { const float* in[19]; float* out; unsigned char* ws; int lo, hi; };
__global__ void __launch_bounds__(NTHREADS, 2) mk_fwd(Args args) {
    extern __shared__ __attribute__((aligned(16))) unsigned char lds_raw[];
    Frame F;
    F.lds = (LAS unsigned char*)lds_raw;
    F.MISC = (volatile LAS unsigned*)(F.lds + MISC_OFF);
    F.tid = threadIdx.x; F.lane = F.tid & 63; F.wave = __builtin_amdgcn_readfirstlane(F.tid >> 6);
    F.G = gridDim.x; F.ws = args.ws; F.ctl = (unsigned*)(args.ws + WS_CTL); F.out = args.out;
#pragma unroll
    for (int i = 0; i < 19; ++i) F.in[i] = args.in[i];
    for (int u = F.tid; u < (LDS_BYTES - LDSCTL_OFF) / 4; u += NTHREADS) ((LAS unsigned*)(F.lds + LDSCTL_OFF))[u] = 0u;
    __syncthreads();
    const int lo = args.lo, hi = args.hi;
    XcdBarrier bar; bar.bar = F.ctl + CW_BAR; bar.x = 0; bar.st = nullptr;
    if (hi - lo > 1) bar = xcd_barrier_post(F.ctl + CW_BAR, F.MISC + 8);
#define PH(name, call) do { if (!(SKIPMASK & (1u << PHB_##name))) { call; } } while (0)
#define IN(k) (lo <= (k) && (k) < hi)
#define END(k) do { if (hi > (k) + 1) xcd_barrier(bar); } while (0)
    unsigned char* ws = args.ws;
    const float* xf = (const float*)(ws + WS_XF); float* z = (float*)(ws + WS_Z); const h16* xh = (const h16*)(ws + WS_XH);

    for (int rep_ = 0; rep_ < PROBE_P0; ++rep_) if (IN(0)) { PH(P0, p0_prologue(F)); END(0); }
    if (IN(1)) {
        pg8::Gemm g{(const h16*)(ws + WS_MEMH), (const h16*)(ws + WS_WMKV), MEMLEN, DEPTH * 1024, DM}; pg8::StaticOrder So; So.init(MEMLEN, DEPTH * 1024, F.G, (int)blockIdx.x);
        EpiProj<JOB_MKV> E{ws, 0};
        PH(GMKV, (pg8::gemm_phase<EpiProj<JOB_MKV>, pg8::StaticOrder, true, true>(F.lds, g, So, E)));
        END(1);
    }
    for (int sb = 0; sb < 16; ++sb) {
        const int l = sb >> 2, kind = sb & 3, base = 2 + sb * SLOTS;
        if (hi <= base || lo >= base + SLOTS) continue;
        const h16* resA; const h16* resB; int resK; float resS; int lnidx;
        if (kind == 0 || kind == 3) {
            const int f = kind == 0 ? 0 : 1;
            resA = (const h16*)(ws + WS_HB); resB = (const h16*)(ws + WS_WD) + (size_t)(l * 2 + f) * DM * DFF; resK = DFF; resS = 0.5f; lnidx = kind;
            if (IN(base)) {
                pg8::Gemm g{xh, (const h16*)(ws + WS_WGU) + (size_t)(l * 2 + f) * 2 * DFF * DM, S, 2 * DFF, DM}; pg8::StaticOrder So; So.init(S, 2 * DFF, F.G, (int)blockIdx.x);
                EpiSwiglu E{(h16*)(ws + WS_HB)};
                PH(GSWIGLU, (pg8::gemm_phase<EpiSwiglu, pg8::StaticOrder, true, true>(F.lds, g, So, E)));
                END(base);
            }
        } else if (kind == 1) {
            resA = (const h16*)(ws + WS_OMIX); resB = (const h16*)(ws + WS_WOUT) + (size_t)l * DM * DM; resK = DM; resS = 1.0f; lnidx = 1;
            if (IN(base)) {
                pg8::Gemm g{xh, (const h16*)(ws + WS_WIN) + (size_t)l * NIN * DM, S, NIN, DM}; pg8::StaticOrder So; So.init(S, NIN, F.G, (int)blockIdx.x);
                EpiProj<JOB_WIN> E{ws, 0};
                PH(GWIN, (pg8::gemm_phase<EpiProj<JOB_WIN>, pg8::StaticOrder, true, true>(F.lds, g, So, E)));
                END(base);
            }
            if (IN(base + 1)) {
                const int nb = (int)blockIdx.x, Gn = F.G;
                for (int it = nb; it < 256; it += Gn) {
                    if (it < 96) { pg8::Gemm g{(const h16*)(ws + WS_BCQ), (const h16*)(ws + WS_WUQ) + (size_t)l * 768 * 512, S, 768, 512}; pg8::OneUnit So{it / 3, it % 3, true};
                        EpiProj<JOB_UQ> E{ws, 0}; pg8::gemm_phase<EpiProj<JOB_UQ>, pg8::OneUnit, true, true>(F.lds, g, So, E); }
                    else if (it < 224) { const int i2 = it - 96; pg8::Gemm g{(const h16*)(ws + WS_BCKV), (const h16*)(ws + WS_WUKV) + (size_t)l * 1024 * 512, S, 1024, 512}; pg8::OneUnit So{i2 >> 2, i2 & 3, true};
                        EpiProj<JOB_UKV> E{ws, 0}; pg8::gemm_phase<EpiProj<JOB_UKV>, pg8::OneUnit, true, true>(F.lds, g, So, E); }
                    else if (it < 240) { const int i3 = it - 224, br = i3 & 1, pm = (i3 >> 1) & 1, ks = i3 >> 2;
                        pg8::Gemm g{(const h16*)(ws + (br ? WS_VCMP : WS_KCMP)) + ks * 512, (const h16*)(ws + WS_WC1) + (size_t)(l * 2 + br) * 256 * 2048 + ks * 512, 512, 256, 512, 2048, 2048}; pg8::OneUnit So{pm, 0, true};
                        EpiProj<JOB_Y> E{ws, br + 2 * ks}; pg8::gemm_phase<EpiProj<JOB_Y>, pg8::OneUnit, true, true>(F.lds, g, So, E); }
                    else PH(KMEAN, moba_kmean_phase(F, it - 240));
                }
                __syncthreads();
                dsx::score_phase(F);
                END(base + 1);
            }
            if (IN(base + 2)) { PH(CMP2, nsa_cmp2_phase(F, l)); moba_gate_mfma_phase(F); END(base + 2); }
            if (IN(base + 3)) {
#if USE_FA
                fa_cmp_phase(F); nsa_imp_phase(F);
#else
                PH(CMPSEL, nsa_cmp_select_phase(F));
#endif
                for (int rp_ = 0; rp_ < PROBE_TOPK_N; ++rp_) PH(TOPK, dsa_topk_phase(F));
                for (int rp_ = 1; rp_ < PROBE_IMP_N; ++rp_) { fa_cmp_phase(F); nsa_imp_phase(F); }
                END(base + 3); }
            if (IN(base + 4)) {
#if USE_FA
                fa_mixer_phase(F, l);
                if (!(FA_MASK & 1)) mla_attn_phase(F);
                if (!(FA_MASK & 2)) nsa_attn_phase(F);
                if (!(FA_MASK & 4)) moba_attn_phase(F);
                if (!(FA_MASK & 8)) dsa_attn_phase(F);
#else
                PH(MOBA, moba_attn_phase(F)); PH(MLA, mla_attn_phase(F)); PH(NSA, nsa_attn_phase(F)); PH(DSA, dsa_attn_phase(F));
#endif
                END(base + 4); }
        } else {
            resA = (const h16*)(ws + WS_MO); resB = (const h16*)(ws + WS_WMO) + (size_t)l * DM * 512; resK = 512; resS = 1.0f; lnidx = 2;
            if (IN(base)) {
                pg8::Gemm g{xh, (const h16*)(ws + WS_WMQ) + (size_t)l * 512 * DM, S, 512, DM}; pg8::StaticOrder So; So.init(S, 512, F.G, (int)blockIdx.x);
                EpiProj<JOB_MQ> E{ws, 0};
                PH(GMQ, (pg8::gemm_phase<EpiProj<JOB_MQ>, pg8::StaticOrder, true, true>(F.lds, g, So, E)));
                END(base);
            }
            if (IN(base + 1)) {
#if USE_FA
                if (FA_MASK & 16) fa_mem_phase(F, l); else mem_attn_phase(F, l);
#else
                PH(MEMA, mem_attn_phase(F, l));
#endif
                END(base + 1); }
        }
        if (IN(base + 5)) {
            pg8::Gemm g{resA, resB, S, DM, resK}; pg8::StaticOrder So; So.init(S, DM, F.G, (int)blockIdx.x);
            EpiResid E{xf, z, resS};
            PH(GRESID, (pg8::gemm_phase<EpiResid, pg8::StaticOrder, true, true>(F.lds, g, So, E)));
            END(base + 5);
        }
        if (IN(base + 6)) {
            const float* g = (const float*)(ws + WS_LNG) + (size_t)(l * 4 + lnidx) * DM; const float* b = (const float*)(ws + WS_LNB) + (size_t)(l * 4 + lnidx) * DM;
            PH(LN, ln_phase(F, z, g, b, sb == 15 ? F.out : (float*)(ws + WS_XF), (h16*)(ws + WS_XH)));
            END(base + 6);
        }
    }
#undef IN
#undef END
}

extern "C" void kernel_launch(void* const* d_in, const int* in_sizes, int n_in, void* d_out, int out_size, void* d_ws, size_t ws_size, hipStream_t stream) {
    static int grid = 0;
    if (grid == 0) {
        if (n_in != 19 || out_size != S * DM || ws_size < WS_END) { fprintf(stderr, "kernel_launch: unexpected shapes (n_in %d, out %d, ws %zu < %zu)\n", n_in, out_size, ws_size, (size_t)WS_END); grid = -1; return; }
        int dev = 0, cus = 0, per_cu = 0;
        if (hipGetDevice(&dev) != hipSuccess || hipDeviceGetAttribute(&cus, hipDeviceAttributeMultiprocessorCount, dev) != hipSuccess) { grid = -1; return; }
        if (hipFuncSetAttribute((const void*)mk_fwd, hipFuncAttributeMaxDynamicSharedMemorySize, LDS_BYTES) != hipSuccess) { fprintf(stderr, "kernel_launch: hipFuncSetAttribute failed\n"); grid = -1; return; }
        if (hipOccupancyMaxActiveBlocksPerMultiprocessor(&per_cu, (const void*)mk_fwd, NTHREADS, LDS_BYTES) != hipSuccess || per_cu < 1) { fprintf(stderr, "kernel_launch: occupancy query says %d\n", per_cu); }
        (void)hipGetLastError();
        grid = cus;
    }
    if (grid < 0) return;
    if (hipMemsetAsync((char*)d_ws + WS_CTL, 0, CTL_BYTES, stream) != hipSuccess) return;
    Args a{};
    for (int i = 0; i < 19; ++i) a.in[i] = (const float*)d_in[i];
    a.out = (float*)d_out; a.ws = (unsigned char*)d_ws;
#if MK_STEP_LAUNCHES
    for (int st = 0; st < NSTEPS; ++st) {
        if (st >= 2) { const int sb = (st - 2) / SLOTS, slot = (st - 2) % SLOTS, kind = sb & 3;
            const bool live = slot >= 5 || slot == 0 || (kind == 1 && slot <= 4) || (kind == 2 && slot == 1);
            if (!live) continue; }
        a.lo = st; a.hi = st + 1;
        hipLaunchKernelGGL(mk_fwd, dim3(grid), dim3(NTHREADS), LDS_BYTES, stream, a);
    }
#else
    a.lo = 0; a.hi = NSTEPS;
    hipLaunchKernelGGL(mk_fwd, dim3(grid), dim3(NTHREADS), LDS_BYTES, stream, a);
#endif
}
```
